# Optimizing an MI355X kernel written in HIP

```python
import math
import jax, jax.numpy as jnp
from jax import lax
import numpy as np


D_MODEL = 2048
BATCH = 4
SEQ = 2048
DEPTH = 1

D_MIX = D_MODEL
ATTN_WIDTH = D_MIX // 2
SSD_WIDTH = D_MIX - ATTN_WIDTH
ATTN_HEADS = 8
ATTN_DH = ATTN_WIDTH // (2 * ATTN_HEADS)
ATTN_DV = 2 * ATTN_DH
ROT_DIM = ATTN_DH // 4
ROPE_THETA = 500000.0
Q_BLOCK = 128
SSD_HEADDIM = 64
SSD_HEADS = SSD_WIDTH // SSD_HEADDIM
SSD_GROUPS = 2
SSD_STATE = 128
CONV_W = 4
CONV_DIM = SSD_WIDTH + 2 * SSD_GROUPS * SSD_STATE
CHUNK = 128
N_EXPERTS = 32
TOP_K = 4
D_FF = D_MODEL
SWIGLU_ALPHA = 1.702
SWIGLU_LIMIT = 7.0
EPS = 1e-5
IN_SIZES = (ATTN_WIDTH, ATTN_WIDTH, ATTN_HEADS * ATTN_DV, SSD_WIDTH, CONV_DIM, SSD_HEADS)
IN_TOTAL = sum(IN_SIZES)

kernel_name = "hybrid_diffattn_ssd_moe_layer"


def rms_norm(x, w):
    xf = x.astype(jnp.float32)
    xf = xf * lax.rsqrt(jnp.mean(xf * xf, axis=-1, keepdims=True) + EPS)
    return (xf * w.astype(jnp.float32)).astype(x.dtype)


def lambda_init(layer):
    return 0.8 - 0.6 * math.exp(-0.3 * layer)


def rope_tables(positions, dtype):
    inv_freq = ROPE_THETA ** (-jnp.arange(0, ROT_DIM, 2, dtype=jnp.float32) / ROT_DIM)
    ang = positions.astype(jnp.float32)[..., None] * inv_freq
    cos = jnp.cos(ang)[:, :, None, None, :].astype(dtype)
    sin = jnp.sin(ang)[:, :, None, None, :].astype(dtype)
    return cos, sin


def rope_partial(t, cos, sin):
    half = ROT_DIM // 2
    t1 = t[..., :half]
    t2 = t[..., half:ROT_DIM]
    return jnp.concatenate([t1 * cos - t2 * sin, t2 * cos + t1 * sin, t[..., ROT_DIM:]], axis=-1)


def diff_attention(q, k, v, lam):
    s = q.shape[1]
    scale = ATTN_DH ** -0.5
    outs = []
    for i0 in range(0, s, Q_BLOCK):
        i1 = i0 + Q_BLOCK
        sc = jnp.einsum('bqhcd,bkhcd->bhcqk', q[:, i0:i1], k[:, :i1]).astype(jnp.float32) * scale
        causal = jnp.arange(i1)[None, :] <= jnp.arange(i0, i1)[:, None]
        p = jax.nn.softmax(jnp.where(causal, sc, -jnp.inf), axis=-1)
        a = p[:, :, 0] - lam * p[:, :, 1]
        outs.append(jnp.einsum('bhqk,bkhe->bqhe', a.astype(v.dtype), v[:, :i1]))
    return jnp.concatenate(outs, axis=1)


def causal_dwconv(u, w, b):
    ch = u.shape[-1]
    y = lax.conv_general_dilated(u, w[:, None, :].astype(u.dtype), window_strides=(1,),
                                 padding=[(CONV_W - 1, 0)],
                                 dimension_numbers=('NWC', 'WIO', 'NWC'),
                                 feature_group_count=ch)
    return y + b.astype(u.dtype)


def ssd_chunked(x, dt, a, bmat, cmat):
    bsz, l, h, p = x.shape
    g, n = bmat.shape[2], bmat.shape[3]
    r = h // g
    c = l // CHUNK
    xdt = (x.astype(jnp.float32) * dt[..., None]).reshape(bsz, c, CHUNK, g, r, p)
    bc = bmat.astype(jnp.float32).reshape(bsz, c, CHUNK, g, n)
    cc = cmat.astype(jnp.float32).reshape(bsz, c, CHUNK, g, n)
    da = (dt * a).reshape(bsz, c, CHUNK, g, r).transpose(0, 3, 4, 1, 2)
    cs = jnp.cumsum(da, axis=-1)
    causal = jnp.tril(jnp.ones((CHUNK, CHUNK), dtype=bool))
    seg = cs[..., :, None] - cs[..., None, :]
    decay = jnp.exp(jnp.where(causal, seg, -jnp.inf))
    cb = jnp.einsum('bclgn,bcsgn->bgcls', cc, bc)
    y_diag = jnp.einsum('bgrcls,bcsgrp->bclgrp', cb[:, :, None] * decay, xdt)
    decay_states = jnp.exp(cs[..., -1:] - cs)
    states = jnp.einsum('bcsgn,bgrcs,bcsgrp->bcgrpn', bc, decay_states, xdt)
    chunk_decay = jnp.exp(cs[..., -1])

    def step(hs, inp):
        s_c, d_c = inp
        return d_c[..., None, None] * hs + s_c, hs

    init = jnp.zeros((bsz, g, r, p, n), jnp.float32)
    _, prev = lax.scan(step, init, (jnp.moveaxis(states, 1, 0), jnp.moveaxis(chunk_decay, 3, 0)))
    prev = jnp.moveaxis(prev, 0, 1)
    y_off = jnp.einsum('bclgn,bcgrpn,bgrcl->bclgrp', cc, prev, jnp.exp(cs))
    return (y_diag + y_off).reshape(bsz, l, h, p)


def moe_ffn(h, router_w, router_b, w_gate_up, b_gate_up, w_down, b_down):
    bsz, s, d = h.shape
    t = h.reshape(bsz * s, d)
    logits = (t @ router_w + router_b).astype(jnp.float32)
    top_vals, top_idx = lax.top_k(logits, TOP_K)
    gates = jax.nn.softmax(top_vals, axis=-1)
    combine = jnp.einsum('tk,tke->te', gates, jax.nn.one_hot(top_idx, N_EXPERTS, dtype=jnp.float32))
    combine = combine.astype(h.dtype)
    out = jnp.zeros_like(t)
    for e in range(N_EXPERTS):
        gu = t @ w_gate_up[e] + b_gate_up[e]
        gate = jnp.minimum(gu[:, :D_FF], SWIGLU_LIMIT)
        up = jnp.clip(gu[:, D_FF:], -SWIGLU_LIMIT, SWIGLU_LIMIT)
        act = gate * jax.nn.sigmoid(SWIGLU_ALPHA * gate) * (up + 1.0)
        out = out + combine[:, e:e + 1] * (act @ w_down[e] + b_down[e])
    return out.reshape(bsz, s, d)


def setup_inputs(seed: int = 0) -> dict:
    key = jax.random.key(seed)
    ks = jax.random.split(key, 24)
    f32 = jnp.float32
    nrm = lambda k, shape, scale: jax.random.normal(k, shape, f32) * scale
    x = jax.random.normal(ks[0], (BATCH, SEQ, D_MODEL), f32)
    offsets = jax.random.randint(ks[1], (BATCH, 1), 0, 4096, dtype=jnp.int32)
    positions = offsets + jnp.arange(SEQ, dtype=jnp.int32)[None, :]
    dt0 = jnp.exp(jax.random.uniform(ks[10], (DEPTH, SSD_HEADS), f32)
                  * (math.log(0.1) - math.log(0.001)) + math.log(0.001))
    return {
        "x": x,
        "positions": positions,
        "norm1_w": 1.0 + nrm(ks[2], (DEPTH, D_MODEL), 0.02),
        "w_in": nrm(ks[3], (DEPTH, D_MODEL, IN_TOTAL), D_MODEL ** -0.5),
        "lambda_q1": nrm(ks[4], (DEPTH, ATTN_DH), 0.1),
        "lambda_k1": nrm(ks[5], (DEPTH, ATTN_DH), 0.1),
        "lambda_q2": nrm(ks[6], (DEPTH, ATTN_DH), 0.1),
        "lambda_k2": nrm(ks[7], (DEPTH, ATTN_DH), 0.1),
        "attn_subln_w": 1.0 + nrm(ks[8], (DEPTH, ATTN_DV), 0.02),
        "conv_w": nrm(ks[9], (DEPTH, CONV_W, CONV_DIM), CONV_W ** -0.5),
        "conv_b": nrm(ks[11], (DEPTH, CONV_DIM), 0.02),
        "dt_bias": dt0 + jnp.log(-jnp.expm1(-dt0)),
        "a_log": jnp.log(jax.random.uniform(ks[12], (DEPTH, SSD_HEADS), f32, 1.0, 16.0)),
        "d_skip": 1.0 + nrm(ks[13], (DEPTH, SSD_HEADS), 0.02),
        "ssd_norm_w": 1.0 + nrm(ks[14], (DEPTH, SSD_WIDTH), 0.02),
        "w_out": nrm(ks[15], (DEPTH, D_MIX, D_MODEL), D_MIX ** -0.5),
        "norm2_w": 1.0 + nrm(ks[16], (DEPTH, D_MODEL), 0.02),
        "router_w": nrm(ks[17], (DEPTH, D_MODEL, N_EXPERTS), D_MODEL ** -0.5),
        "router_b": nrm(ks[18], (DEPTH, N_EXPERTS), 0.01),
        "w_gate_up": nrm(ks[19], (DEPTH, N_EXPERTS, D_MODEL, 2 * D_FF), D_MODEL ** -0.5),
        "b_gate_up": nrm(ks[20], (DEPTH, N_EXPERTS, 2 * D_FF), 0.02),
        "w_down": nrm(ks[21], (DEPTH, N_EXPERTS, D_FF, D_MODEL), D_FF ** -0.5),
        "b_down": nrm(ks[22], (DEPTH, N_EXPERTS, D_MODEL), 0.02),
        "norm_f_w": 1.0 + nrm(ks[23], (D_MODEL,), 0.02),
    }


def reference(x, positions, norm1_w, w_in, lambda_q1, lambda_k1, lambda_q2, lambda_k2,
              attn_subln_w, conv_w, conv_b, dt_bias, a_log, d_skip, ssd_norm_w, w_out,
              norm2_w, router_w, router_b, w_gate_up, b_gate_up, w_down, b_down, norm_f_w):
    bsz, s, _ = x.shape
    cos, sin = rope_tables(positions, x.dtype)
    offs = np.cumsum(IN_SIZES)[:-1].tolist()
    for layer in range(DEPTH):
        h = rms_norm(x, norm1_w[layer])
        proj = h @ w_in[layer]
        q, k, v, z, xbc, dt_raw = jnp.split(proj, offs, axis=-1)

        q = rope_partial(q.reshape(bsz, s, ATTN_HEADS, 2, ATTN_DH), cos, sin)
        k = rope_partial(k.reshape(bsz, s, ATTN_HEADS, 2, ATTN_DH), cos, sin)
        v = v.reshape(bsz, s, ATTN_HEADS, ATTN_DV)
        lam_init = lambda_init(layer)
        lam = (jnp.exp(jnp.sum(lambda_q1[layer].astype(jnp.float32) * lambda_k1[layer].astype(jnp.float32)))
               - jnp.exp(jnp.sum(lambda_q2[layer].astype(jnp.float32) * lambda_k2[layer].astype(jnp.float32)))
               + lam_init)
        attn = diff_attention(q, k, v, lam)
        attn = rms_norm(attn, attn_subln_w[layer]) * (1.0 - lam_init)
        attn = attn.reshape(bsz, s, ATTN_HEADS * ATTN_DV)

        xbc = jax.nn.silu(causal_dwconv(xbc, conv_w[layer], conv_b[layer]))
        xs, bmat, cmat = jnp.split(xbc, [SSD_WIDTH, SSD_WIDTH + SSD_GROUPS * SSD_STATE], axis=-1)
        xs = xs.reshape(bsz, s, SSD_HEADS, SSD_HEADDIM)
        bmat = bmat.reshape(bsz, s, SSD_GROUPS, SSD_STATE)
        cmat = cmat.reshape(bsz, s, SSD_GROUPS, SSD_STATE)
        dt = jax.nn.softplus(dt_raw.astype(jnp.float32) + dt_bias[layer].astype(jnp.float32))
        a = -jnp.exp(a_log[layer].astype(jnp.float32))
        y = ssd_chunked(xs, dt, a, bmat, cmat)
        y = y + d_skip[layer].astype(jnp.float32)[:, None] * xs.astype(jnp.float32)
        y = y.reshape(bsz, s, SSD_WIDTH) * jax.nn.silu(z.astype(jnp.float32))
        yg = y.reshape(bsz, s, SSD_GROUPS, SSD_WIDTH // SSD_GROUPS)
        yg = yg * lax.rsqrt(jnp.mean(yg * yg, axis=-1, keepdims=True) + EPS)
        ssd = (yg.reshape(bsz, s, SSD_WIDTH) * ssd_norm_w[layer].astype(jnp.float32)).astype(x.dtype)

        x = x + jnp.concatenate([attn, ssd], axis=-1) @ w_out[layer]

        x = x + moe_ffn(rms_norm(x, norm2_w[layer]), router_w[layer], router_b[layer],
                        w_gate_up[layer], b_gate_up[layer], w_down[layer], b_down[layer])
    return rms_norm(x, norm_f_w)
```

```cpp
#include <hip/hip_runtime.h>
#include <hip/hip_bf16.h>
#include <cstdio>
#include <cstdint>
#include <cmath>

#ifndef MK_N_LAUNCHES
#define MK_N_LAUNCHES 1
#endif

#define LAS __attribute__((address_space(3)))
#define GAS __attribute__((address_space(1)))
typedef unsigned short bf16_t;
typedef short bf16x8 __attribute__((ext_vector_type(8)));
typedef float f32x2 __attribute__((ext_vector_type(2)));
typedef float f32x4 __attribute__((ext_vector_type(4)));
typedef float f32x16 __attribute__((ext_vector_type(16)));
typedef unsigned u32x2 __attribute__((ext_vector_type(2)));
typedef unsigned u32x4 __attribute__((ext_vector_type(4)));

constexpr int NB = 4, SEQ = 2048, NTOK = NB * SEQ, DM = 2048;
constexpr int NPROJ = 5648, NPROJP = 5888;
constexpr int C_Q = 0, C_K = 1024, C_V = 2048, C_Z = 3072, C_XBC = 4096, C_DT = 5632;
constexpr int NEXP = 32, FFD = 2048, MAXROWS = 40960, MAXTILES = 160;
constexpr float EPS = 1e-5f;
constexpr float ATT_C2 = 0.125f * 1.4426950408889634f;
constexpr float LAM_INIT = 0.2f;

constexpr size_t MiB = 1u << 20;
constexpr size_t WS_CTL = 0, CTL_ZERO_BYTES = 1 * MiB;
constexpr size_t WS_WIN = 2 * MiB;
constexpr size_t WS_WOUT = 26 * MiB;
constexpr size_t WS_ROPE = 34 * MiB;
constexpr size_t WS_DTRAW = 34 * MiB + 512 * 1024;
constexpr size_t WS_CS = 35 * MiB;
constexpr size_t WS_ROUTE = 36 * MiB;
constexpr size_t WS_XN = 40 * MiB;
constexpr size_t WS_PROJ = 72 * MiB;
constexpr size_t WS_ATT = 164 * MiB;
constexpr size_t WS_YDIAG = 196 * MiB;
constexpr size_t WS_STATES = 228 * MiB;
constexpr size_t WS_XCONV = 260 * MiB;
constexpr size_t WS_CCONV = 276 * MiB;
constexpr size_t WS_CAT = 280 * MiB;
constexpr size_t WS_X1 = 312 * MiB;
constexpr size_t WS_H2 = 376 * MiB;
constexpr size_t WS_ACT = 408 * MiB;
constexpr size_t WS_YS = 568 * MiB;
constexpr size_t WS_WGU = 728 * MiB;
constexpr size_t WS_WD = 1240 * MiB;
constexpr size_t WS_END = 1496 * MiB;
constexpr size_t RT_TOPE = 0, RT_TOPG = 128 * 1024, RT_LRANK = 256 * 1024, RT_TOKPOS = 384 * 1024, RT_HIST = 512 * 1024, RT_META = 544 * 1024, RT_ROWTOK = 576 * 1024;
constexpr int META_SEG = 0, META_NT = 40, META_TILE_E = 48;
constexpr int CW_BAR = 4096;
constexpr int CW_TCNT = 16384;

constexpr int RING_BYTES = 131072;
constexpr int LDSCTL_OFF = RING_BYTES, MISC_OFF = LDSCTL_OFF + 320;
constexpr int LHIST_OFF = LDSCTL_OFF + 1024;
constexpr int BIAS_OFF = LDSCTL_OFF + 2048 + 8192;
constexpr int VAN_OFF = LDSCTL_OFF + 2048;
constexpr int LDS_BYTES = 147456;
constexpr int NWAVES = 8;

__device__ __forceinline__ unsigned cvt_pk_bf16(float lo, float hi) { unsigned r; asm volatile("v_cvt_pk_bf16_f32 %0, %1, %2" : "=v"(r) : "v"(lo), "v"(hi)); return r; }
__device__ __forceinline__ float bf_lo(unsigned w) { return __uint_as_float(w << 16); }
__device__ __forceinline__ float bf_hi(unsigned w) { return __uint_as_float(w & 0xffff0000u); }
__device__ __forceinline__ float bf2f(bf16_t h) { return __uint_as_float((unsigned)h << 16); }
__device__ __forceinline__ bf16_t f2bf(float f) { return (bf16_t)(cvt_pk_bf16(f, 0.f) & 0xffffu); }
__device__ __forceinline__ float wave_sum(float v) {
#pragma unroll
    for (int o = 1; o < 64; o <<= 1) v += __shfl_xor(v, o);
    return v;
}
__device__ __forceinline__ float sigmoidf_(float x) { return __builtin_amdgcn_rcpf(1.f + __builtin_amdgcn_exp2f(-1.4426950408889634f * x)); }
__device__ __forceinline__ float rsqrtf_(float x) { return __builtin_amdgcn_rsqf(x); }
__device__ __forceinline__ float fexp(float x) { return __builtin_amdgcn_exp2f(1.4426950408889634f * x); }
#define LDS_WAIT() asm volatile("s_waitcnt lgkmcnt(0)" ::: "memory")
#define VM_WAIT() asm volatile("s_waitcnt vmcnt(0)" ::: "memory")

__device__ __forceinline__ const char* uni(const char* p) { const unsigned long long v = (unsigned long long)p; const unsigned lo = __builtin_amdgcn_readfirstlane((unsigned)v), hi = __builtin_amdgcn_readfirstlane((unsigned)(v >> 32)); return (const char*)(((unsigned long long)hi << 32) | lo); }
namespace pg8 {
constexpr int BM = 256, BK = 64, HALF = 128, HTB = HALF * BK * 2, STAGE_BYTES = 8 * HTB, NXCD = 8, WGM = 8, KD = 2048, NKT = KD / BK;
__host__ __device__ __forceinline__ int lds_byte(int r, int c) { const int st = (r >> 4) * 2 + (c >> 5), rr = r & 15, cc = c & 31, ob = rr * 64 + cc * 2; return st * 1024 + (ob ^ (((ob >> 9) & 1) << 5)); }
__host__ __device__ __forceinline__ void stage_rc(int b, int& R, int& C) { const int st = b / 1024, sb = b % 1024, swz = sb ^ (((sb >> 9) & 1) << 5); R = (st >> 1) * 16 + swz / 64; C = (st & 1) * 32 + (swz % 64) / 2; }
__host__ __device__ __forceinline__ int perm32(int rho) { const int n = rho >> 4, i = rho & 15; return 8 * (i >> 2) + 4 * n + (i & 3); }

struct Unit { const char* a; const char* b0; const char* b1; int pm, pn, e; };
struct UnitF { const char* a; const char* b; int pm, pn, e; };

struct SchedDense {
    const char* A; const char* Bt; int nM, nN, nwg, G, c;
    __device__ __forceinline__ void init(const void* A_, const void* Bt_, int M, int N, int G_, int c_) { A = (const char*)A_; Bt = (const char*)Bt_; nM = M / BM; nN = N / BM; nwg = nM * nN; G = G_; c = c_; }
    __device__ __forceinline__ bool get(int i, Unit& u) const {
        const long L = (long)i * G + c; if (L >= nwg) return false;
        int wgid = (int)L; { const int q = nwg / NXCD, r = nwg % NXCD, xcd = wgid % NXCD, off = wgid / NXCD; wgid = (xcd < r ? xcd * (q + 1) : r * (q + 1) + (xcd - r) * q) + off; }
        const int nig = WGM * nN, gid = wgid / nig, fm = gid * WGM, gsz = (nM - fm) < WGM ? (nM - fm) : WGM;
        u.pm = fm + ((wgid % nig) % gsz); u.pn = (wgid % nig) / gsz; u.e = 0;
        u.a = A; u.b0 = Bt + (size_t)u.pn * BM * KD * 2; u.b1 = u.b0 + (size_t)HALF * KD * 2; return true;
    }
    __device__ __forceinline__ unsigned aoff(const Unit& u, int h, int R, int C) const { return (unsigned)(((u.pm * BM + h * HALF + R) * KD + C) * 2); }
};
struct SchedMoe {
    const char* A; const char* Bt; const int* tile_e; const int* rowtok; int nT, nN, G, c; bool gu;
    __device__ __forceinline__ bool get(int i, Unit& u) const {
        const long L = (long)i * G + c; const int NU = nT * nN; if (L >= NU) return false;
        const int nTb = nT >> 2, full = nTb * 4 * nN; int T, nt;
        if ((int)L < full) { const int blk = (int)L >> 5, w = (int)L & 31, nb = nN >> 3, tb = blk / nb, nbk = blk % nb; T = tb * 4 + (w & 3); nt = nbk * 8 + (w >> 2); }
        else { const int Lp = (int)L - full, rT = nT & 3; T = nTb * 4 + Lp % rT; nt = Lp / rT; }
        const int e = tile_e[T]; u.pm = T; u.pn = nt; u.e = e; u.a = A;
        if (gu) { u.b0 = Bt + ((size_t)e * 4096 + (size_t)nt * 128) * KD * 2; u.b1 = u.b0 + (size_t)2048 * KD * 2; }
        else    { u.b0 = Bt + ((size_t)e * 2048 + (size_t)nt * 256) * KD * 2; u.b1 = u.b0 + (size_t)HALF * KD * 2; }
        return true;
    }
    __device__ __forceinline__ unsigned aoff(const Unit& u, int h, int R, int C) const { int row = u.pm * BM + h * HALF + R; if (rowtok) row = rowtok[row]; return (unsigned)((row * KD + C) * 2); }
};

struct EpiProj {
    static constexpr bool PERM = true;
    bf16_t* P; float* dtraw; const float* rope;
    __device__ __forceinline__ void operator()(const f32x4 (&acc)[2][2][4][2], const Unit& u, int wr, int wc, int fr, int fq) const {
        const int row0 = u.pm * BM + wr * 64 + fr;
        if (u.pn == 22) {
            if (wc == 0 && fq < 2) {
#pragma unroll
                for (int ai = 0; ai < 2; ++ai)
#pragma unroll
                    for (int m = 0; m < 4; ++m) { float* d = dtraw + (size_t)(row0 + ai * HALF + m * 16) * 16 + 8 * fq; *(f32x4*)d = acc[ai][0][m][0]; *(f32x4*)(d + 4) = acc[ai][0][m][1]; }
            }
            return;
        }
        const bool ropet = (u.pn < 8) && ((wc & 1) == 0);
        const float qs = (u.pn < 4) ? ATT_C2 : 1.f;
        const int col0 = u.pn * BM + wc * 32 + 8 * fq;
#pragma unroll
        for (int ai = 0; ai < 2; ++ai)
#pragma unroll
            for (int m = 0; m < 4; ++m) {
                const int row = row0 + ai * HALF + m * 16;
                f32x4 v[2][2];
#pragma unroll
                for (int bj = 0; bj < 2; ++bj)
#pragma unroll
                    for (int n = 0; n < 2; ++n) v[bj][n] = acc[ai][bj][m][n];
                if (ropet) {
                    const float* rp = rope + (size_t)row * 16;
                    const f32x4 c0 = *(const f32x4*)rp, c1 = *(const f32x4*)(rp + 4), s0 = *(const f32x4*)(rp + 8), s1 = *(const f32x4*)(rp + 12);
#pragma unroll
                    for (int bj = 0; bj < 2; ++bj)
#pragma unroll
                        for (int n = 0; n < 2; ++n)
#pragma unroll
                            for (int j = 0; j < 4; ++j) {
                                const float x = v[bj][n][j], o = __shfl_xor(x, 16);
                                const float cc = n ? c1[j] : c0[j], ss = n ? s1[j] : s0[j];
                                const float r = (fq == 0) ? (x * cc - o * ss) : (x * cc + o * ss);
                                v[bj][n][j] = (fq < 2) ? r : x;
                            }
                }
                bf16_t* rowp = P + (size_t)row * NPROJP + col0;
#pragma unroll
                for (int bj = 0; bj < 2; ++bj) {
                    const f32x4 v0 = v[bj][0] * qs, v1 = v[bj][1] * qs; u32x4 w;
                    w.x = cvt_pk_bf16(v0[0], v0[1]); w.y = cvt_pk_bf16(v0[2], v0[3]); w.z = cvt_pk_bf16(v1[0], v1[1]); w.w = cvt_pk_bf16(v1[2], v1[3]);
                    *(u32x4*)(rowp + bj * HALF) = w;
                }
            }
    }
};
struct EpiRes {
    static constexpr bool PERM = false;
    const float* base; bf16_t* out; int ldc;
    __device__ __forceinline__ void operator()(const f32x4 (&acc)[2][2][4][2], const Unit& u, int wr, int wc, int fr, int fq) const {
        const int row0 = u.pm * BM + wr * 64 + fr, col0 = u.pn * BM + wc * 32 + 4 * fq;
#pragma unroll
        for (int ai = 0; ai < 2; ++ai)
#pragma unroll
            for (int m = 0; m < 4; ++m) { const size_t off = (size_t)(row0 + ai * HALF + m * 16) * ldc + col0;
#pragma unroll
                for (int bj = 0; bj < 2; ++bj)
#pragma unroll
                    for (int n = 0; n < 2; ++n) { const f32x4 v = *(const f32x4*)(base + off + bj * HALF + n * 16) + acc[ai][bj][m][n]; u32x2 w; w.x = cvt_pk_bf16(v[0], v[1]); w.y = cvt_pk_bf16(v[2], v[3]); *(u32x2*)(out + off + bj * HALF + n * 16) = w; } }
    }
};
struct EpiGate {
    static constexpr bool PERM = true;
    bf16_t* O; const float* bgu;
    unsigned* cnt;
    __device__ __forceinline__ unsigned bias_off(const UnitF& u, int wc, int idx) const { const int fq = idx >> 4, k = (idx >> 2) & 3, cp = idx & 3; return (unsigned)((u.e * 4096 + (k >> 1) * 2048 + u.pn * 128 + wc * 32 + 8 * fq + 4 * (k & 1) + cp) * 4); }
    __device__ __forceinline__ const char* bias_base() const { return (const char*)bgu; }
    __device__ __forceinline__ void operator()(const f32x4 (&acc)[2][2][4][2], const Unit& u, int wr, int wc, int fr, int fq, const LAS float* bl = nullptr) const {
        const int row0 = u.pm * BM + wr * 64 + fr, colg = u.pn * 128 + wc * 32 + 8 * fq;
        f32x4 bg[2], bu[2];
        if (bl) { const LAS f32x4* q = (const LAS f32x4*)bl + fq * 4; bg[0] = q[0]; bg[1] = q[1]; bu[0] = q[2]; bu[1] = q[3]; }
        else { const float* bp = bgu + (size_t)u.e * 4096 + colg;
#pragma unroll
            for (int n = 0; n < 2; ++n) { bg[n] = *(const f32x4*)(bp + 4 * n); bu[n] = *(const f32x4*)(bp + 2048 + 4 * n); } }
        const __amdgpu_buffer_rsrc_t rsrc = __builtin_amdgcn_make_buffer_rsrc((void*)O, 0, MAXROWS * FFD * 2, 0x00020000);
#pragma unroll
        for (int ai = 0; ai < 2; ++ai)
#pragma unroll
            for (int m = 0; m < 4; ++m) {
                float a[8];
#pragma unroll
                for (int n = 0; n < 2; ++n)
#pragma unroll
                    for (int j = 0; j < 4; ++j) {
                        float g = acc[ai][0][m][n][j] + bg[n][j], up = acc[ai][1][m][n][j] + bu[n][j];
                        g = fminf(g, 7.0f); up = fminf(fmaxf(up, -7.0f), 7.0f);
                        a[4 * n + j] = g * sigmoidf_(1.702f * g) * (up + 1.0f);
                    }
                u32x4 w; w.x = cvt_pk_bf16(a[0], a[1]); w.y = cvt_pk_bf16(a[2], a[3]); w.z = cvt_pk_bf16(a[4], a[5]); w.w = cvt_pk_bf16(a[6], a[7]);
                __builtin_amdgcn_raw_buffer_store_b128(w, rsrc, (int)(((unsigned)(row0 + ai * HALF + m * 16) * FFD + colg) * 2u), 0, 16);
            }
        asm volatile("s_waitcnt vmcnt(0)" ::: "memory");
        if (fr == 0 && fq == 0) __hip_atomic_fetch_add(cnt + 64 * u.pm, 1u, __ATOMIC_RELAXED, __HIP_MEMORY_SCOPE_AGENT);
    }
};
struct EpiDown {
    static constexpr bool PERM = true;
    bf16_t* O; const float* bd;
    __device__ __forceinline__ unsigned bias_off(const UnitF& u, int wc, int idx) const { const int fq = idx >> 4, k = (idx >> 2) & 3, cp = idx & 3; return (unsigned)((u.e * DM + u.pn * BM + wc * 32 + 8 * fq + (k >> 1) * HALF + 4 * (k & 1) + cp) * 4); }
    __device__ __forceinline__ const char* bias_base() const { return (const char*)bd; }
    __device__ __forceinline__ void operator()(const f32x4 (&acc)[2][2][4][2], const Unit& u, int wr, int wc, int fr, int fq, const LAS float* bl = nullptr) const {
        const int row0 = u.pm * BM + wr * 64 + fr, col0 = u.pn * BM + wc * 32 + 8 * fq;
        f32x4 bv[2][2];
        if (bl) { const LAS f32x4* q = (const LAS f32x4*)bl + fq * 4; bv[0][0] = q[0]; bv[0][1] = q[1]; bv[1][0] = q[2]; bv[1][1] = q[3]; }
        else { const float* bp = bd + (size_t)u.e * DM + col0;
#pragma unroll
            for (int bj = 0; bj < 2; ++bj)
#pragma unroll
                for (int n = 0; n < 2; ++n) bv[bj][n] = *(const f32x4*)(bp + bj * HALF + 4 * n); }
#pragma unroll
        for (int ai = 0; ai < 2; ++ai)
#pragma unroll
            for (int m = 0; m < 4; ++m) { bf16_t* rowp = O + (size_t)(row0 + ai * HALF + m * 16) * DM + col0;
#pragma unroll
                for (int bj = 0; bj < 2; ++bj) { const f32x4 v0 = acc[ai][bj][m][0] + bv[bj][0], v1 = acc[ai][bj][m][1] + bv[bj][1]; u32x4 w;
                    w.x = cvt_pk_bf16(v0[0], v0[1]); w.y = cvt_pk_bf16(v0[2], v0[3]); w.z = cvt_pk_bf16(v1[0], v1[1]); w.w = cvt_pk_bf16(v1[2], v1[3]);
                    *(u32x4*)(rowp + bj * HALF) = w; } }
    }
};

template <class Epi, class Sched>
__device__ __forceinline__ void gemm_phase(LAS unsigned char* lds, const Sched& S, const Epi& E) {
    const int tid = threadIdx.x, wid = __builtin_amdgcn_readfirstlane(tid >> 6), lane = tid & 63, wr = wid >> 2, wc = wid & 3, fr = lane & 15, fq = lane >> 4;
    constexpr int nt = NKT;
    int Rr[2], Cc[2]; unsigned voffB[2];
#pragma unroll
    for (int i = 0; i < 2; ++i) { stage_rc(tid * 16 + i * 8192, Rr[i], Cc[i]); const int Rb = Epi::PERM ? ((Rr[i] & ~31) + perm32(Rr[i] & 31)) : Rr[i]; voffB[i] = (unsigned)(Rb * KD + Cc[i]) * 2u; }
    const size_t kstep = (size_t)(BK * 2);
    const unsigned ldsw = (unsigned)wid * 1024u;
    const int aoff = lds_byte(wr * 64 + fr, fq * 8), boff = lds_byte(wc * 32 + fr, fq * 8);
#define PG8_SA(b, h) (((b) * 2 + (h)) * HTB)
#define PG8_SB(b, h) ((4 + (b) * 2 + (h)) * HTB)
#define PG8_STAGE(bufoff, gbase, voff) do { _Pragma("unroll") for (int _i = 0; _i < 2; ++_i) \
        __builtin_amdgcn_global_load_lds((const unsigned*)((const char*)(gbase) + (voff)[_i]), (LAS unsigned*)(lds + (bufoff) + ldsw + _i * 8192), 16, 0, 0); } while (0)
#define PG8_LDA(dst, b, h) do { _Pragma("unroll") for (int m = 0; m < 4; ++m) _Pragma("unroll") for (int k = 0; k < 2; ++k) dst[m][k] = *(const LAS bf16x8*)(lds + PG8_SA(b, h) + aoff + m * 2048 + k * 1024); } while (0)
#define PG8_LDB(dst, b, h) do { _Pragma("unroll") for (int n = 0; n < 2; ++n) _Pragma("unroll") for (int k = 0; k < 2; ++k) dst[n][k] = *(const LAS bf16x8*)(lds + PG8_SB(b, h) + boff + n * 2048 + k * 1024); } while (0)
#define PG8_MMA(ai, bj, At, Bt) do { __builtin_amdgcn_s_setprio(1); _Pragma("unroll") for (int m = 0; m < 4; ++m) _Pragma("unroll") for (int n = 0; n < 2; ++n) _Pragma("unroll") for (int k = 0; k < 2; ++k) \
        acc[ai][bj][m][n] = __builtin_amdgcn_mfma_f32_16x16x32_bf16(Bt[n][k], At[m][k], acc[ai][bj][m][n], 0, 0, 0); __builtin_amdgcn_s_setprio(0); } while (0)
#define PG8_WAIT_V(n) asm volatile("s_waitcnt vmcnt(" #n ")" ::: "memory")
#define PG8_WAIT_L(n) asm volatile("s_waitcnt lgkmcnt(" #n ")" ::: "memory")
#define PG8_BAR __builtin_amdgcn_s_barrier()
#define PG8_SCHED __builtin_amdgcn_sched_barrier(0)
    Unit cur, nxt; int ui = 0;
    if (!S.get(0, cur)) return;
    unsigned vaC[2][2], vaN[2][2];
#pragma unroll
    for (int h = 0; h < 2; ++h)
#pragma unroll
        for (int i = 0; i < 2; ++i) vaC[h][i] = S.aoff(cur, h, Rr[i], Cc[i]);
    f32x4 acc[2][2][4][2];
#pragma unroll
    for (int a = 0; a < 2; ++a)
#pragma unroll
        for (int b = 0; b < 2; ++b)
#pragma unroll
            for (int m = 0; m < 4; ++m)
#pragma unroll
                for (int n = 0; n < 2; ++n) acc[a][b][m][n] = (f32x4){0.f, 0.f, 0.f, 0.f};
    bf16x8 At[4][2], B0[2][2], B1[2][2];
    PG8_STAGE(PG8_SB(0, 0), cur.b0, voffB); PG8_STAGE(PG8_SB(0, 1), cur.b1, voffB); PG8_STAGE(PG8_SA(0, 0), cur.a, vaC[0]); PG8_STAGE(PG8_SA(0, 1), cur.a, vaC[1]);
    if (wr == 1) PG8_BAR;
    PG8_WAIT_V(2); PG8_BAR;
    PG8_STAGE(PG8_SB(1, 0), cur.b0 + kstep, voffB); PG8_STAGE(PG8_SA(1, 0), cur.a + kstep, vaC[0]); PG8_STAGE(PG8_SB(1, 1), cur.b1 + kstep, voffB);
    PG8_WAIT_V(6); PG8_BAR;
    for (;;) {
        const bool has_next = S.get(ui + 1, nxt);
        if (has_next) {
#pragma unroll
            for (int h = 0; h < 2; ++h)
#pragma unroll
                for (int i = 0; i < 2; ++i) vaN[h][i] = S.aoff(nxt, h, Rr[i], Cc[i]);
        } else {
            nxt = cur;
#pragma unroll
            for (int h = 0; h < 2; ++h)
#pragma unroll
                for (int i = 0; i < 2; ++i) vaN[h][i] = vaC[h][i];
        }
        for (int t = 0; t < nt; t += 2) {
            const bool last = (t == nt - 2);
            const char* a1 = cur.a + (size_t)(t + 1) * kstep;
            const char* a2 = last ? nxt.a : cur.a + (size_t)(t + 2) * kstep;
            const char* b20 = last ? nxt.b0 : cur.b0 + (size_t)(t + 2) * kstep;
            const char* b21 = last ? nxt.b1 : cur.b1 + (size_t)(t + 2) * kstep;
            const char* a3 = a2 + kstep; const char* b30 = b20 + kstep; const char* b31 = b21 + kstep;
            unsigned v2[2][2];
#pragma unroll
            for (int h = 0; h < 2; ++h)
#pragma unroll
                for (int i = 0; i < 2; ++i) v2[h][i] = last ? vaN[h][i] : vaC[h][i];
            PG8_LDB(B0, 0, 0); PG8_LDB(B1, 0, 1); PG8_SCHED; PG8_LDA(At, 0, 0); PG8_STAGE(PG8_SA(1, 1), a1, vaC[1]);
            PG8_WAIT_V(8); PG8_WAIT_L(0); PG8_BAR; PG8_MMA(0, 0, At, B0); PG8_MMA(0, 1, At, B1); PG8_BAR; PG8_SCHED;
            PG8_LDA(At, 0, 1); PG8_STAGE(PG8_SB(0, 0), b20, voffB); PG8_STAGE(PG8_SB(0, 1), b21, voffB); PG8_STAGE(PG8_SA(0, 0), a2, v2[0]);
            PG8_WAIT_V(8); PG8_WAIT_L(0); PG8_BAR; PG8_MMA(1, 0, At, B0); PG8_MMA(1, 1, At, B1); PG8_BAR; PG8_SCHED;
            PG8_LDB(B0, 1, 0); PG8_LDB(B1, 1, 1); PG8_SCHED; PG8_LDA(At, 1, 0); PG8_STAGE(PG8_SA(0, 1), a2, v2[1]);
            PG8_WAIT_V(8); PG8_WAIT_L(0); PG8_BAR; PG8_MMA(0, 0, At, B0); PG8_MMA(0, 1, At, B1); PG8_BAR; PG8_SCHED;
            PG8_LDA(At, 1, 1); PG8_STAGE(PG8_SB(1, 0), b30, voffB); PG8_STAGE(PG8_SB(1, 1), b31, voffB); PG8_STAGE(PG8_SA(1, 0), a3, v2[0]);
            PG8_WAIT_V(8); PG8_WAIT_L(0); PG8_BAR; PG8_MMA(1, 0, At, B0); PG8_MMA(1, 1, At, B1); PG8_BAR; PG8_SCHED;
        }
        if (wr == 0) PG8_BAR;
        E(acc, cur, wr, wc, fr, fq);
        if (!has_next) break;
#pragma unroll
        for (int a = 0; a < 2; ++a)
#pragma unroll
            for (int b = 0; b < 2; ++b)
#pragma unroll
                for (int m = 0; m < 4; ++m)
#pragma unroll
                    for (int n = 0; n < 2; ++n) acc[a][b][m][n] = (f32x4){0.f, 0.f, 0.f, 0.f};
        cur = nxt; ++ui;
#pragma unroll
        for (int h = 0; h < 2; ++h)
#pragma unroll
            for (int i = 0; i < 2; ++i) vaC[h][i] = vaN[h][i];
        if (wr == 1) PG8_BAR;
    }
    PG8_WAIT_V(0);
    PG8_BAR;
#undef PG8_SA
#undef PG8_SB
#undef PG8_STAGE
#undef PG8_LDA
#undef PG8_LDB
#undef PG8_MMA
#undef PG8_WAIT_V
#undef PG8_WAIT_L
#undef PG8_BAR
#undef PG8_SCHED
}

template <int NP  , int HDELTA  , bool GATHER>
struct SchedMoeF {
    const char* A; const float* W; const int* tile_e; const int* rowtok; int nT, nN, G, c;
    __device__ __forceinline__ bool get(int i, UnitF& u) const {
        const long L = (long)i * G + c; const int NU = nT * nN; if (L >= NU) return false;
        const int nTb = nT >> 2, full = nTb * 4 * nN; int T, nt;
        if ((int)L < full) { const int blk = (int)L >> 5, w = (int)L & 31, nb = nN >> 3, tb = blk / nb, nbk = blk % nb; T = tb * 4 + (w & 3); nt = nbk * 8 + (w >> 2); }
        else { const int Lp = (int)L - full, rT = nT & 3; T = nTb * 4 + Lp % rT; nt = Lp / rT; }
        T = __builtin_amdgcn_readfirstlane(T); nt = __builtin_amdgcn_readfirstlane(nt);
        const int e = __builtin_amdgcn_readfirstlane(tile_e[T]); u.pm = T; u.pn = nt; u.e = e;
        u.a = GATHER ? A : A + (size_t)T * BM * KD * 2;
        u.b = (const char*)(W + (size_t)e * 2048 * NP + (size_t)nt * (HDELTA == 512 ? 256 : 128));
        return true;
    }
    __device__ __forceinline__ unsigned aoff(const UnitF& u, int h, int R, int C) const { const int row = GATHER ? rowtok[u.pm * BM + h * HALF + R] : h * HALF + R; return (unsigned)((row * KD + C) * 2); }
};
typedef short s16x4_t __attribute__((ext_vector_type(4)));
__device__ __forceinline__ s16x4_t tr16(const LAS unsigned char* p) { return __builtin_bit_cast(s16x4_t, __builtin_amdgcn_ds_read_tr16_b64_v4i16((LAS s16x4_t*)p)); }
__device__ __forceinline__ void glds16s(const char* sbase, unsigned voff, unsigned lds_dst) { unsigned keep;
    asm volatile("s_mov_b32 %0, m0\n\ts_mov_b32 m0, %2\n\ts_nop 2\n\tglobal_load_lds_dwordx4 %1, %3\n\ts_mov_b32 m0, %0" : "=&s"(keep) : "v"(voff), "s"(lds_dst), "s"(sbase) : "memory"); }

__device__ __forceinline__ void glds4s(const char* sbase, unsigned voff, unsigned lds_dst) { unsigned keep;
    asm volatile("s_mov_b32 %0, m0\n\ts_mov_b32 m0, %2\n\ts_nop 2\n\tglobal_load_lds_dword %1, %3\n\ts_mov_b32 m0, %0" : "=&s"(keep) : "v"(voff), "s"(lds_dst), "s"(sbase) : "memory"); }

template <class Epi, class Sched, int NP, int HDELTA, bool GATHER, bool WAITA = false>
__device__ __forceinline__ void gemm_phase_fb(LAS unsigned char* lds, const Sched& S, const Epi& E, const unsigned* ready = nullptr, unsigned need = 0u) {
    static_assert(Epi::PERM, "the B image's column-slot permutation assumes a PERM epilogue");
    const int tid = threadIdx.x, wid = __builtin_amdgcn_readfirstlane(tid >> 6), lane = tid & 63, wr = wid >> 2, wc = wid & 3;
    constexpr int nt = NKT;
    constexpr size_t kstep = (size_t)(BK * 2);
    constexpr size_t BKT = (size_t)64 * NP * 4;
    constexpr size_t BR8 = (size_t)8 * NP * 4;
    const unsigned lds0 = (unsigned)__builtin_amdgcn_readfirstlane((unsigned)(size_t)lds);
    const unsigned ldsw = lds0 + (unsigned)wid * 1024u;
    const int aoff = lds_byte(wr * 64 + (lane & 15), (lane >> 4) * 8);
    const int bh = lane >> 5, c4 = lane & 31;
    const unsigned blane = (unsigned)(bh * HDELTA + wid * NP * 4 + c4 * 16);
    const int s4 = (c4 & ~7) + 4 * (c4 & 1) + ((c4 & 7) >> 1), ch16 = s4 >> 1, sub = s4 & 1;
    const int X0 = ((wid & 3) << 2) | (wid >> 2);
    const unsigned bw0 = (unsigned)(4 * HTB + bh * HTB + 256 * wid + 16 * (ch16 ^ X0) + 8 * sub);
    unsigned radr[2];
    { const int g = lane >> 4, q = (lane & 15) >> 2, p = lane & 3;
#pragma unroll
      for (int t = 0; t < 2; ++t) { const int row = 8 * g + 4 * t + q, X = ((row & 3) << 2) | ((row >> 2) & 3), ch = 2 * (2 * wc) + (p >> 1); radr[t] = (unsigned)(4 * HTB + 256 * row + 16 * (ch ^ X) + 8 * (p & 1)); } }
#define FB_SA(b, h) (((b) * 2 + (h)) * HTB)
#define FB_SB(b, h) (((b) * 2 + (h)) * HTB)
#define FB_STAGE(bufoff, sbase, voff) do { _Pragma("unroll") for (int _i = 0; _i < 2; ++_i) glds16s((sbase), (voff)[_i], ldsw + (unsigned)(bufoff) + _i * 8192u); } while (0)
#define FB_STAGEH(bufoff, sbase, vv, h) do { if constexpr (GATHER) { FB_STAGE(bufoff, sbase, (vv)[h]); } else { FB_STAGE(bufoff, (sbase) + (size_t)(h) * HALF * KD * 2, (vv)[0]); } } while (0)
#define FB_LDA(dst, b, h) do { _Pragma("unroll") for (int m = 0; m < 4; ++m) _Pragma("unroll") for (int k = 0; k < 2; ++k) dst[m][k] = *(const LAS bf16x8*)(lds + FB_SA(b, h) + aoff + m * 2048 + k * 1024); } while (0)
#define FB_LDB(dst, b, h) do { _Pragma("unroll") for (int n = 0; n < 2; ++n) _Pragma("unroll") for (int k = 0; k < 2; ++k) { \
        const s16x4_t lo_ = tr16(lds + FB_SB(b, h) + (radr[0] ^ (n ? 32u : 0u)) + k * 8192), hi_ = tr16(lds + FB_SB(b, h) + (radr[1] ^ (n ? 32u : 0u)) + k * 8192); \
        dst[n][k] = (bf16x8){lo_[0], lo_[1], lo_[2], lo_[3], hi_[0], hi_[1], hi_[2], hi_[3]}; } } while (0)
#define FB_BLOAD(LD, bsrc, hr, rj) do { _Pragma("unroll") for (int _i = 0; _i < 4; ++_i) { const char* sb_ = (const char*)(bsrc) + (size_t)((4 * (hr) + _i + (rj)) & 7) * BR8; \
        asm volatile("s_nop 0\n\tglobal_load_dwordx4 %0, %1, %2 sc0" : "=v"(LD[_i]) : "v"(blane), "s"(sb_) : "memory"); } } while (0)
#define FB_BWAIT(LD, n) asm volatile("s_waitcnt vmcnt(" #n ")" : "+v"(LD[0]), "+v"(LD[1]), "+v"(LD[2]), "+v"(LD[3]) :: "memory")
#define FB_BCW(LD, b, hr, rj) do { _Pragma("unroll") for (int _i = 0; _i < 4; ++_i) { u32x2 w_; w_.x = cvt_pk_bf16(LD[_i].x, LD[_i].y); w_.y = cvt_pk_bf16(LD[_i].z, LD[_i].w); \
        *(LAS u32x2*)(lds + FB_SB(b, 0) + ((_i & 1) ? (bw0 ^ 32u) : bw0) + 2048 * ((4 * (hr) + _i + (rj)) & 7)) = w_; } } while (0)
#define FB_BSTEP(LD, wb, whr, wrj, nsrc, nhr, nrj, nw) do { FB_BWAIT(LD, nw); FB_BCW(LD, wb, whr, wrj); FB_BLOAD(LD, nsrc, nhr, nrj); } while (0)
#define FB_BCONS(LD, wb, whr, wrj, nw) do { FB_BWAIT(LD, nw); FB_BCW(LD, wb, whr, wrj); } while (0)
#define FB_MMA(ai, bj, At, Bt) do { __builtin_amdgcn_s_setprio(1); _Pragma("unroll") for (int m = 0; m < 4; ++m) _Pragma("unroll") for (int n = 0; n < 2; ++n) _Pragma("unroll") for (int k = 0; k < 2; ++k) \
        acc[ai][bj][m][n] = __builtin_amdgcn_mfma_f32_16x16x32_bf16(Bt[n][k], At[m][k], acc[ai][bj][m][n], 0, 0, 0); __builtin_amdgcn_s_setprio(0); } while (0)
#define FB_WAIT_V(n) asm volatile("s_waitcnt vmcnt(" #n ")" ::: "memory")
#define FB_WAIT_L(n) asm volatile("s_waitcnt lgkmcnt(" #n ")" ::: "memory")
#define FB_BAR __builtin_amdgcn_s_barrier()
#define FB_SCHED __builtin_amdgcn_sched_barrier(0)
#define FB_AWAIT(T) do { if constexpr (WAITA) { if (wid == 0) { unsigned sp_ = 0; \
        while ((unsigned)__builtin_amdgcn_readfirstlane(__hip_atomic_load(ready + 64 * (T), __ATOMIC_RELAXED, __HIP_MEMORY_SCOPE_AGENT)) < need) { __builtin_amdgcn_s_sleep(2); if (++sp_ > (1u << 22)) break; } \
        __builtin_amdgcn_fence(__ATOMIC_ACQUIRE, "agent"); asm volatile("s_waitcnt vmcnt(0)" ::: "memory"); } \
        asm volatile("" ::: "memory"); __builtin_amdgcn_s_barrier(); asm volatile("" ::: "memory"); } } while (0)
#define FB_BIAS(u) do { int tq_ = threadIdx.x; asm volatile("" : "+v"(tq_)); glds4s(uni(E.bias_base()), E.bias_off((u), wc, tq_ & 63), lds0 + (unsigned)BIAS_OFF + (unsigned)wid * 256u); } while (0)
    UnitF cur, nxt; int ui = 0;
    if (!S.get(0, cur)) return;
    FB_AWAIT(cur.pm);
    FB_BIAS(cur);
    unsigned vaC[2][2];
    { int tq = threadIdx.x; asm volatile("" : "+v"(tq));
#pragma unroll
      for (int i = 0; i < 2; ++i) { int R_, C_; stage_rc(tq * 16 + i * 8192, R_, C_);
#pragma unroll
        for (int h = 0; h < 2; ++h) vaC[h][i] = S.aoff(cur, h, R_, C_); } }
    f32x4 acc[2][2][4][2];
#pragma unroll
    for (int a = 0; a < 2; ++a)
#pragma unroll
        for (int b = 0; b < 2; ++b)
#pragma unroll
            for (int m = 0; m < 4; ++m)
#pragma unroll
                for (int n = 0; n < 2; ++n) acc[a][b][m][n] = (f32x4){0.f, 0.f, 0.f, 0.f};
    bf16x8 At[4][2], B0[2][2], B1[2][2];
    f32x4 ldX[4], ldY[4];
    { const char* a0 = uni(cur.a); const char* bb = uni(cur.b);
    FB_STAGEH(FB_SA(0, 0), a0, vaC, 0); FB_STAGEH(FB_SA(0, 1), a0, vaC, 1); FB_STAGEH(FB_SA(1, 0), a0 + kstep, vaC, 0);
    const int j0 = 2 * (cur.pm & 3);
    FB_BLOAD(ldY, bb, 0, j0); FB_BLOAD(ldX, bb, 1, j0);
    FB_BSTEP(ldY, 0, 0, j0, bb + BKT, 0, j0, 4);
    FB_BSTEP(ldX, 0, 1, j0, bb + BKT, 1, j0, 4);
    FB_BSTEP(ldY, 1, 0, j0, bb + 2 * BKT, 0, j0, 4); }
    FB_WAIT_V(0); FB_WAIT_L(0);
    if (wr == 1) FB_BAR;
    FB_BAR;
    for (;;) {
        const bool has_next = S.get(ui + 1, nxt);
        if (!has_next) nxt = cur;
        if (ui > 0) FB_BIAS(cur);
        if constexpr (GATHER) {
            if (has_next) { int tq = threadIdx.x; asm volatile("" : "+v"(tq));
                int R0, C0, R1, C1; stage_rc(tq * 16, R0, C0); stage_rc(tq * 16 + 8192, R1, C1);
                const char* rtb = uni((const char*)(S.rowtok + nxt.pm * BM)); const unsigned sd = lds0 + (unsigned)VAN_OFF + (unsigned)wid * 1024u;
                glds4s(rtb, (unsigned)(R0 * 4), sd); glds4s(rtb, (unsigned)(R1 * 4), sd + 256u); glds4s(rtb, (unsigned)((HALF + R0) * 4), sd + 512u); glds4s(rtb, (unsigned)((HALF + R1) * 4), sd + 768u); }
        }
        const char* ca = uni(cur.a); const char* cb = uni(cur.b); const char* na = uni(nxt.a); const char* nb = uni(nxt.b);
        const int jc = 2 * (cur.pm & 3), jn = 2 * (nxt.pm & 3);
        for (int t = 0; t < nt; t += 2) {
            const bool last = (t == nt - 2);
            if (last && has_next) FB_AWAIT(nxt.pm);
            const char* a1 = ca + (size_t)(t + 1) * kstep;
            const char* a2 = last ? na : ca + (size_t)(t + 2) * kstep;
            const char* a3 = a2 + kstep;
            const char* b2 = last ? nb : cb + (size_t)(t + 2) * BKT;
            const char* b3 = b2 + BKT;
            const char* b4 = (t + 4 < nt) ? cb + (size_t)(t + 4) * BKT : nb + (size_t)(t + 4 - nt) * BKT;
            const int j2 = last ? jn : jc, j4 = (t + 4 < nt) ? jc : jn;
            FB_BCONS(ldX, 1, 1, jc, 6);
            FB_LDB(B0, 0, 0); FB_LDB(B1, 0, 1); FB_SCHED; FB_LDA(At, 0, 0); FB_STAGEH(FB_SA(1, 1), a1, vaC, 1);
            if constexpr (GATHER) { if (last && has_next) { int tq = threadIdx.x; asm volatile("" : "+v"(tq));
                int R0, C0, R1, C1; stage_rc(tq * 16, R0, C0); stage_rc(tq * 16 + 8192, R1, C1);
                const LAS unsigned* sp = (const LAS unsigned*)(lds + VAN_OFF + wid * 1024) + (tq & 63);
                vaC[0][0] = (sp[0] * KD + C0) * 2u; vaC[0][1] = (sp[64] * KD + C1) * 2u; vaC[1][0] = (sp[128] * KD + C0) * 2u; vaC[1][1] = (sp[192] * KD + C1) * 2u; } }
            FB_WAIT_V(8); FB_WAIT_L(0); FB_BAR; FB_MMA(0, 0, At, B0); FB_BLOAD(ldX, b2, 1, j2); FB_MMA(0, 1, At, B1); FB_BAR; FB_SCHED;
            FB_BCONS(ldY, 0, 0, j2, 6);
            FB_LDA(At, 0, 1); FB_STAGEH(FB_SA(0, 0), a2, vaC, 0);
            FB_WAIT_V(8); FB_WAIT_L(0); FB_BAR; FB_MMA(1, 0, At, B0); FB_BLOAD(ldY, b3, 0, j2); FB_MMA(1, 1, At, B1); FB_BAR; FB_SCHED;
            FB_BCONS(ldX, 0, 1, j2, 6);
            FB_LDB(B0, 1, 0); FB_LDB(B1, 1, 1); FB_SCHED; FB_LDA(At, 1, 0); FB_STAGEH(FB_SA(0, 1), a2, vaC, 1);
            FB_WAIT_V(8); FB_WAIT_L(0); FB_BAR; FB_MMA(0, 0, At, B0); FB_BLOAD(ldX, b3, 1, j2); FB_MMA(0, 1, At, B1); FB_BAR; FB_SCHED;
            FB_BCONS(ldY, 1, 0, j2, 6);
            FB_LDA(At, 1, 1); FB_STAGEH(FB_SA(1, 0), a3, vaC, 0);
            FB_WAIT_V(8); FB_WAIT_L(0); FB_BAR; FB_MMA(1, 0, At, B0); FB_BLOAD(ldY, b4, 0, j4); FB_MMA(1, 1, At, B1); FB_BAR; FB_SCHED;
        }
        if (wr == 0) FB_BAR;
        { Unit ue; ue.a = nullptr; ue.b0 = nullptr; ue.b1 = nullptr; ue.pm = cur.pm; ue.pn = cur.pn; ue.e = cur.e;
          int tq = threadIdx.x; asm volatile("" : "+v"(tq)); E(acc, ue, wr, wc, tq & 15, (tq & 63) >> 4, (const LAS float*)(lds + BIAS_OFF + wid * 256)); }
        if (!has_next) break;
#pragma unroll
        for (int a = 0; a < 2; ++a)
#pragma unroll
            for (int b = 0; b < 2; ++b)
#pragma unroll
                for (int m = 0; m < 4; ++m)
#pragma unroll
                    for (int n = 0; n < 2; ++n) acc[a][b][m][n] = (f32x4){0.f, 0.f, 0.f, 0.f};
        cur = nxt; ++ui;
        if (wr == 1) FB_BAR;
    }
    FB_WAIT_V(0);
    FB_BAR;
#undef FB_SA
#undef FB_SB
#undef FB_STAGE
#undef FB_STAGEH
#undef FB_BIAS
#undef FB_LDA
#undef FB_LDB
#undef FB_BLOAD
#undef FB_BWRITE
#undef FB_BCW
#undef FB_BWAIT
#undef FB_BSTEP
#undef FB_BCONS
#undef FB_MMA
#undef FB_WAIT_V
#undef FB_WAIT_L
#undef FB_BAR
#undef FB_SCHED
#undef FB_AWAIT
}
}

namespace attn_body {
using bf16 = __hip_bfloat16;
using s16x4 = __attribute__((ext_vector_type(4))) short;
constexpr int PQ = NPROJP, PO = 2048;
constexpr int NW = 8, QBLK = 32, QB = QBLK * NW, KVBLK = 64;
__device__ __forceinline__ int crow(int r, int hi) { return (r & 3) + 8 * (r >> 2) + 4 * hi; }
#define SBAR() __builtin_amdgcn_sched_barrier(0)
__device__ __forceinline__ void cmask(f32x16& p0, f32x16& p1, int jb, int qrel, int hi) {
  const float NEG = -INFINITY; int d = qrel - (64 * jb + 4 * hi); asm volatile("" : "+v"(d));
  #pragma unroll
  for (int r = 0; r < 16; ++r) { const int cc = (r & 3) + 8 * (r >> 2); if (cc > d) p0[r] = NEG; if (cc + 32 > d) p1[r] = NEG; }
}
constexpr int NSLOT = 3, SLOTB = 8192;
constexpr int LDS_K = 0, LDS_V = NSLOT * SLOTB, LDS_WS = 2 * NSLOT * SLOTB, LDS_OST = LDS_WS + NW * 64 * 4, LDS_BYTES_A = LDS_OST + NW * 4096;
__device__ __forceinline__ void glds16(const void* sbase, unsigned voff, unsigned lds_dst) { unsigned keep;
  asm volatile("s_mov_b32 %0, m0\n\ts_mov_b32 m0, %2\n\ts_nop 0\n\tglobal_load_lds_dwordx4 %1, %3\n\ts_mov_b32 m0, %0" : "=&s"(keep) : "v"(voff), "s"(lds_dst), "s"(sbase) : "memory"); }
__device__ __forceinline__ float max3f(float a, float b, float c) { float r; asm("v_max3_f32 %0, %1, %2, %3" : "=v"(r) : "v"(a), "v"(b), "v"(c)); return r; }
__device__ __forceinline__ float max2f(float a, float b) { float r; asm("v_max_f32_e32 %0, %1, %2" : "=v"(r) : "v"(a), "v"(b)); return r; }
__device__ __forceinline__ float fadd_s(float a, float b) { float r; asm("v_add_f32_e32 %0, %1, %2" : "=v"(r) : "v"(a), "v"(b)); return r; }
__device__ __forceinline__ float fsub_s(float a, float b) { float r; asm("v_sub_f32_e32 %0, %1, %2" : "=v"(r) : "v"(a), "v"(b)); return r; }
typedef float f32x2_t __attribute__((ext_vector_type(2))); typedef __bf16 bf16x2_t __attribute__((ext_vector_type(2)));
__device__ __forceinline__ unsigned cvtpk_s(float lo, float hi) { f32x2_t v = {lo, hi}; bf16x2_t b = __builtin_convertvector(v, bf16x2_t); return __builtin_bit_cast(unsigned, b); }
#define WAIT_BAR(N) asm volatile("s_waitcnt vmcnt(" #N ") lgkmcnt(0)\n\ts_barrier" ::: "memory")
__device__ __forceinline__ void qkt(f32x16& p0, f32x16& p1, const char* Kslot, const bf16x8* qr, const f32x16& negm, int r32, int hi) {
  const char* kb = Kslot + hi * 1024 + r32 * 16;
  #pragma unroll
  for (int d0 = 0; d0 < 4; ++d0) {
    const bf16x8 b0 = *reinterpret_cast<const bf16x8*>(kb + d0 * 2048);
    const bf16x8 b1 = *reinterpret_cast<const bf16x8*>(kb + d0 * 2048 + 512);
    if (d0 == 0) { p0 = __builtin_amdgcn_mfma_f32_32x32x16_bf16(b0, qr[0], negm, 0, 0, 0); p1 = __builtin_amdgcn_mfma_f32_32x32x16_bf16(b1, qr[0], negm, 0, 0, 0); }
    else { p0 = __builtin_amdgcn_mfma_f32_32x32x16_bf16(b0, qr[d0], p0, 0, 0, 0); p1 = __builtin_amdgcn_mfma_f32_32x32x16_bf16(b1, qr[d0], p1, 0, 0, 0); } }
}
typedef __attribute__((address_space(3))) const char* lds_cptr;
typedef short v4i16_t __attribute__((ext_vector_type(4)));
__device__ __forceinline__ void kload8(bf16x8* kf, lds_cptr kp) {
  kf[0] = *(const __attribute__((address_space(3))) bf16x8*)(kp);        kf[1] = *(const __attribute__((address_space(3))) bf16x8*)(kp + 512);
  kf[2] = *(const __attribute__((address_space(3))) bf16x8*)(kp + 2048); kf[3] = *(const __attribute__((address_space(3))) bf16x8*)(kp + 2560);
  kf[4] = *(const __attribute__((address_space(3))) bf16x8*)(kp + 4096); kf[5] = *(const __attribute__((address_space(3))) bf16x8*)(kp + 4608);
  kf[6] = *(const __attribute__((address_space(3))) bf16x8*)(kp + 6144); kf[7] = *(const __attribute__((address_space(3))) bf16x8*)(kp + 6656);
}
__device__ __forceinline__ void kload2(bf16x8* kf, lds_cptr kp, int j) { kf[2 * j] = *(const __attribute__((address_space(3))) bf16x8*)(kp + j * 2048); kf[2 * j + 1] = *(const __attribute__((address_space(3))) bf16x8*)(kp + j * 2048 + 512); }
__device__ __forceinline__ s16x4 vtr(lds_cptr p) { return __builtin_bit_cast(s16x4, __builtin_amdgcn_ds_read_tr16_b64_v4i16((__attribute__((address_space(3))) v4i16_t*)p)); }
__device__ __forceinline__ float rowmax(const f32x16& p0, const f32x16& p1) {
  float a = max3f(p0[0], p0[1], p1[0]), b = max3f(p0[2], p0[3], p1[1]); a = max3f(a, p1[2], p1[3]);
  #pragma unroll
  for (int r = 4; r < 16; r += 4) { a = max3f(a, p0[r], p0[r + 1]); b = max3f(b, p0[r + 2], p0[r + 3]); a = max3f(a, p1[r], p1[r + 1]); b = max3f(b, p1[r + 2], p1[r + 3]); }
  const float m = max2f(a, b);
  auto rr = __builtin_amdgcn_permlane32_swap(__float_as_uint(m), __float_as_uint(m), false, false);
  return max2f(__uint_as_float(rr[0]), __uint_as_float(rr[1]));
}
__device__ __forceinline__ void pv(f32x16* o, int vb, bf16x8 pa0, bf16x8 pa1, bf16x8 pa2, bf16x8 pa3) {
  #pragma unroll
  for (int d0 = 0; d0 < 2; ++d0) { s16x4 lo[4], hi[4];
    #pragma unroll
    for (int ks = 0; ks < 4; ++ks) {
      asm volatile("ds_read_b64_tr_b16 %0,%1 offset:%c2" : "=&v"(lo[ks]) : "v"(vb), "i"(d0 * 4096 + ks * 1024) : "memory");
      asm volatile("ds_read_b64_tr_b16 %0,%1 offset:%c2" : "=&v"(hi[ks]) : "v"(vb), "i"(d0 * 4096 + ks * 1024 + 512) : "memory"); }
    asm volatile("s_waitcnt lgkmcnt(0)" ::: "memory"); SBAR();
    #define PK(k) (bf16x8){lo[k][0], lo[k][1], lo[k][2], lo[k][3], hi[k][0], hi[k][1], hi[k][2], hi[k][3]}
    o[d0] = __builtin_amdgcn_mfma_f32_32x32x16_bf16(pa0, PK(0), o[d0], 0, 0, 0);
    o[d0] = __builtin_amdgcn_mfma_f32_32x32x16_bf16(pa1, PK(1), o[d0], 0, 0, 0);
    o[d0] = __builtin_amdgcn_mfma_f32_32x32x16_bf16(pa2, PK(2), o[d0], 0, 0, 0);
    o[d0] = __builtin_amdgcn_mfma_f32_32x32x16_bf16(pa3, PK(3), o[d0], 0, 0, 0);
    #undef PK
  }
}
#define ATTN_STORE16(p, v) (*(u32x4*)(p) = (v))
template <int THRL> __device__ __forceinline__ void attn_unit(long rowbase, int qb, const bf16* Qh, const bf16* __restrict__ Kh0, const bf16* __restrict__ Vh0, bf16* Oh, char* shm) {
  const int tid = threadIdx.x, lane = tid & 63, r32 = lane & 31, hi = lane >> 5; const int wid = __builtin_amdgcn_readfirstlane(tid >> 6);
  const int q0 = qb * QB;
  const bf16* Qw = Qh + (rowbase + q0 + wid * QBLK) * PQ;
  const bf16* Kh = Kh0 + rowbase * PQ, *Vh = Vh0 + rowbase * PQ;
  const unsigned lds0 = (unsigned)(uintptr_t)shm;
  float* wsf = (float*)(shm + LDS_WS) + wid * 64;
  const unsigned koff = (unsigned)((lane * PQ + wid * 8) * 2);
  const unsigned voff = (unsigned)(((16 * (wid & 3) + (lane >> 2)) * PQ + (wid >> 2) * 32 + (lane & 3) * 8) * 2);
  const unsigned kdst = lds0 + LDS_K + wid * 1024, vdst = lds0 + LDS_V + wid * 1024;
  #define DMA_K(t, slot) glds16((const char*)Kh + (size_t)(t) * (KVBLK * PQ * 2), koff, (unsigned)__builtin_amdgcn_readfirstlane(kdst + (slot)))
  #define DMA_V(t, slot) glds16((const char*)Vh + (size_t)(t) * (KVBLK * PQ * 2), voff, (unsigned)__builtin_amdgcn_readfirstlane(vdst + (slot)))
  const int vb0 = (int)(lds0 + LDS_V) + ((lane >> 4) & 1) * 32 + (lane & 3) * 8 + (4 * hi + ((lane & 15) >> 2)) * 64;
  const char* Kbase = shm + LDS_K; bf16x8 kf[8];
  const lds_cptr shm3 = (lds_cptr)shm; const lds_cptr kp0 = shm3 + LDS_K + hi * 1024 + r32 * 16; const lds_cptr vp0 = shm3 + LDS_V + ((lane >> 4) & 1) * 32 + (lane & 3) * 8 + (4 * hi + ((lane & 15) >> 2)) * 64;
  const int NT = (q0 + QB) / KVBLK;
  DMA_K(0, 0); DMA_V(0, 0); DMA_K(1, SLOTB);
  bf16x8 qr[4];
  #pragma unroll
  for (int d0 = 0; d0 < 4; ++d0) qr[d0] = *reinterpret_cast<const bf16x8*>(&Qw[(long)r32 * PQ + d0 * 16 + hi * 8]);
  float mhat = 0.f, l_reg = 0.f; f32x16 o[2]; o[0] = f32x16{}; o[1] = f32x16{}; asm volatile("" : "+v"(o[0]), "+v"(o[1])); f32x16 negm = f32x16{}; asm volatile("" : "+v"(negm));
  const int qrel = wid * QBLK + r32;
  #define CMASK(P0, P1, t) do { int jb_ = (t) - (NT - 4); if (jb_ >= 0) cmask(P0, P1, jb_, qrel, hi); } while (0)
  bool resc = false;
  #define START(P0, P1) do { const float rm = rowmax(P0, P1); resc = false; \
    { const float dl = rm; mhat = fadd_s(mhat, dl); \
      _Pragma("unroll") for (int r = 0; r < 16; ++r) { P0[r] = fsub_s(P0[r], dl); P1[r] = fsub_s(P1[r], dl); } \
      _Pragma("unroll") for (int r = 0; r < 16; ++r) negm[r] = -mhat; asm volatile("" : "+v"(negm)); } \
    _Pragma("unroll") for (int r = 0; r < 16; ++r) P0[r] = __builtin_amdgcn_exp2f(P0[r]); } while (0)
  #define RESC() do { if (resc) { asm volatile("s_waitcnt lgkmcnt(0)" ::: "memory"); \
      _Pragma("unroll") for (int d_ = 0; d_ < 2; ++d_) _Pragma("unroll") for (int r = 0; r < 16; ++r) o[d_][r] *= wsf[crow(r, hi)]; } } while (0)
  f32x16 pA0, pA1, pB0, pB1;
  int sl_prev = 0, sl_cur = 0, sl_next = SLOTB;
  #define ROT() do { sl_prev = sl_cur; sl_cur = sl_next; sl_next = (sl_next == (NSLOT - 1) * SLOTB) ? 0 : sl_next + SLOTB; } while (0)
  DMA_K(2, 2 * SLOTB);
  WAIT_BAR(3);
  qkt(pA0, pA1, Kbase, qr, negm, r32, hi); asm volatile("s_nop 15\n\ts_nop 7" : "+v"(pA0), "+v"(pA1)); CMASK(pA0, pA1, 0);
  START(pA0, pA1);
  _Pragma("unroll") for (int r = 0; r < 16; ++r) pA1[r] = __builtin_amdgcn_exp2f(pA1[r]);
  WAIT_BAR(0);
  DMA_K(3, 0); DMA_V(1, SLOTB);
  ROT();
  kload8(kf, kp0 + sl_cur);
  WAIT_BAR(2);
  s16x4 vlo[8], vhi[8]; u32x4 pw0, pw1, pw2, pw3;
  #define PKW(P, B) cvtpk_s(P[B], P[B + 1])
  #define PAF(k) __builtin_bit_cast(bf16x8, pw##k)
  #define VFR(i) (bf16x8){vlo[i][0], vlo[i][1], vlo[i][2], vlo[i][3], vhi[i][0], vhi[i][1], vhi[i][2], vhi[i][3]}
  #define PIN(x) asm volatile("" : "+v"(x))
  #define MX3(a, b, c) __builtin_fmaxf(__builtin_fmaxf((a), (b)), (c))
  #define GAPA(MF, A0, A1, A2, A3, W0, W1, PW) do { MF; sacc += A0; sacc += A1; sacc += A2; sacc += A3; PIN(sacc); W0; W1; PIN(PW); SBAR(); } while (0)
  #define EX(v) __builtin_amdgcn_exp2f(v)
  #define GAPB(MF, X, B) do { MF; X[B] = EX(X[B]); X[B + 1] = EX(X[B + 1]); X[B + 2] = EX(X[B + 2]); X[B + 3] = EX(X[B + 3]); PIN(X); SBAR(); } while (0)
  #define VRD(i) do { vlo[i] = vtr(vp_ + (((i) >> 2) * 4096 + ((i) & 3) * 1024)); vhi[i] = vtr(vp_ + (((i) >> 2) * 4096 + ((i) & 3) * 1024 + 512)); } while (0)
  #define KRD(G, j) do { if (G) { kload2(kf, kp0 + sl_next, j); SBAR(); } } while (0)
  #define STEP(C0, C1, P0, P1, t, GK, GV, GL) do { SBAR(); \
    const lds_cptr vp_ = vp0 + sl_prev; \
    VRD(0); SBAR(); float sacc = (P0[0] + P0[1]); \
    GAPA(C0 = __builtin_amdgcn_mfma_f32_32x32x16_bf16(kf[0], qr[0], negm, 0, 0, 0), P0[2], P0[3], P0[4], P0[5],     pw0[0] = PKW(P0, 0), pw0[1] = PKW(P0, 2), pw0); \
    VRD(4); SBAR(); GAPA(C1 = __builtin_amdgcn_mfma_f32_32x32x16_bf16(kf[1], qr[0], negm, 0, 0, 0), P0[6], P0[7], P0[8], P0[9],     pw0[2] = PKW(P0, 4), pw0[3] = PKW(P0, 6), pw0); \
    VRD(1); SBAR(); GAPA(C0 = __builtin_amdgcn_mfma_f32_32x32x16_bf16(kf[2], qr[1], C0, 0, 0, 0),   P0[10], P0[11], P0[12], P0[13], pw1[0] = PKW(P0, 8), pw1[1] = PKW(P0, 10), pw1); \
    VRD(5); SBAR(); GAPA(C1 = __builtin_amdgcn_mfma_f32_32x32x16_bf16(kf[3], qr[1], C1, 0, 0, 0),   P0[14], P0[15], P1[0], P1[1],   pw1[2] = PKW(P0, 12), pw1[3] = PKW(P0, 14), pw1); \
    VRD(2); SBAR(); GAPA(C0 = __builtin_amdgcn_mfma_f32_32x32x16_bf16(kf[4], qr[2], C0, 0, 0, 0),   P1[2], P1[3], P1[4], P1[5],     pw2[0] = PKW(P1, 0), pw2[1] = PKW(P1, 2), pw2); \
    VRD(6); SBAR(); GAPA(C1 = __builtin_amdgcn_mfma_f32_32x32x16_bf16(kf[5], qr[2], C1, 0, 0, 0),   P1[6], P1[7], P1[8], P1[9],     pw2[2] = PKW(P1, 4), pw2[3] = PKW(P1, 6), pw2); \
    VRD(3); SBAR(); GAPA(C0 = __builtin_amdgcn_mfma_f32_32x32x16_bf16(kf[6], qr[3], C0, 0, 0, 0),   P1[10], P1[11], P1[12], P1[13], pw3[0] = PKW(P1, 8), pw3[1] = PKW(P1, 10), pw3); \
    VRD(7); SBAR(); GAPA(C1 = __builtin_amdgcn_mfma_f32_32x32x16_bf16(kf[7], qr[3], C1, 0, 0, 0),   P1[14], P1[15], 0.f, 0.f,       pw3[2] = PKW(P1, 12), pw3[3] = PKW(P1, 14), pw3); \
    l_reg += sacc; \
    if (GK) { DMA_K((t) + 3, sl_cur); } if (GV) { DMA_V((t) + 1, sl_next); } \
    CMASK(C0, C1, t); \
    { float a = MX3(C0[0], C0[1], C1[0]), b = MX3(C0[2], C0[3], C1[1]); a = MX3(a, C1[2], C1[3]); \
      _Pragma("unroll") for (int r = 4; r < 16; r += 4) { a = MX3(a, C0[r], C0[r + 1]); b = MX3(b, C0[r + 2], C0[r + 3]); a = MX3(a, C1[r], C1[r + 1]); b = MX3(b, C1[r + 2], C1[r + 3]); } \
      float rm = __builtin_fmaxf(a, b); { auto rr = __builtin_amdgcn_permlane32_swap(__float_as_uint(rm), __float_as_uint(rm), false, false); rm = __builtin_fmaxf(__uint_as_float(rr[0]), __uint_as_float(rr[1])); } \
      resc = false; \
      if (__builtin_expect(__any(rm > (float)THRL), 0)) { const float dl = __builtin_fmaxf(rm, 0.f); mhat += dl; \
        _Pragma("unroll") for (int r = 0; r < 16; ++r) { C0[r] -= dl; C1[r] -= dl; } \
        _Pragma("unroll") for (int r = 0; r < 16; ++r) negm[r] = -mhat; asm volatile("" : "+v"(negm)); \
        const float f = __builtin_amdgcn_exp2f(-dl); l_reg *= f; if (hi == 0) wsf[r32] = f; resc = true; } } \
    SBAR(); \
    GAPB(o[0] = __builtin_amdgcn_mfma_f32_32x32x16_bf16(PAF(0), VFR(0), o[0], 0, 0, 0), C0, 0); \
    GAPB(o[1] = __builtin_amdgcn_mfma_f32_32x32x16_bf16(PAF(0), VFR(4), o[1], 0, 0, 0), C0, 4); \
    KRD(GL, 0); GAPB(o[0] = __builtin_amdgcn_mfma_f32_32x32x16_bf16(PAF(1), VFR(1), o[0], 0, 0, 0), C0, 8); \
    KRD(GL, 1); GAPB(o[1] = __builtin_amdgcn_mfma_f32_32x32x16_bf16(PAF(1), VFR(5), o[1], 0, 0, 0), C0, 12); \
    KRD(GL, 2); GAPB(o[0] = __builtin_amdgcn_mfma_f32_32x32x16_bf16(PAF(2), VFR(2), o[0], 0, 0, 0), C1, 0); \
    KRD(GL, 3); GAPB(o[1] = __builtin_amdgcn_mfma_f32_32x32x16_bf16(PAF(2), VFR(6), o[1], 0, 0, 0), C1, 4); \
    GAPB(o[0] = __builtin_amdgcn_mfma_f32_32x32x16_bf16(PAF(3), VFR(3), o[0], 0, 0, 0), C1, 8); \
    GAPB(o[1] = __builtin_amdgcn_mfma_f32_32x32x16_bf16(PAF(3), VFR(7), o[1], 0, 0, 0), C1, 12); \
    } while (0)
  int t = 1;
  #undef CMASK
  #define CMASK(P0, P1, t) do {} while (0)
  for (; t + 5 < NT; t += 2) {
    STEP(pB0, pB1, pA0, pA1, t, true, true, true);     WAIT_BAR(2); RESC(); ROT();
    STEP(pA0, pA1, pB0, pB1, t + 1, true, true, true); WAIT_BAR(2); RESC(); ROT();
  }
  #undef CMASK
  #define CMASK(P0, P1, t) do { int jb_ = (t) - (NT - 4); if (jb_ >= 0) cmask(P0, P1, jb_, qrel, hi); } while (0)
  #define ENDW(tt) do { if ((tt) + 3 < NT) { WAIT_BAR(2); } else if ((tt) + 2 < NT) { WAIT_BAR(1); } else { WAIT_BAR(0); } } while (0)
  for (; t + 1 < NT; t += 2) {
    STEP(pB0, pB1, pA0, pA1, t, (t + 3 < NT), (t + 1 < NT), (t + 1 < NT));         ENDW(t);     RESC(); ROT();
    STEP(pA0, pA1, pB0, pB1, t + 1, (t + 4 < NT), (t + 2 < NT), (t + 2 < NT));     ENDW(t + 1); RESC(); ROT();
  }
  STEP(pB0, pB1, pA0, pA1, NT - 1, false, false, false); RESC();
  { float sacc = pB0[0] + pB0[1]; _Pragma("unroll") for (int r = 2; r < 16; ++r) sacc += pB0[r]; _Pragma("unroll") for (int r = 0; r < 16; ++r) sacc += pB1[r]; l_reg += sacc;
    pw0 = (u32x4){PKW(pB0, 0), PKW(pB0, 2), PKW(pB0, 4), PKW(pB0, 6)}; pw1 = (u32x4){PKW(pB0, 8), PKW(pB0, 10), PKW(pB0, 12), PKW(pB0, 14)}; pw2 = (u32x4){PKW(pB1, 0), PKW(pB1, 2), PKW(pB1, 4), PKW(pB1, 6)}; pw3 = (u32x4){PKW(pB1, 8), PKW(pB1, 10), PKW(pB1, 12), PKW(pB1, 14)};
    SBAR(); pv(o, vb0 + sl_cur, PAF(0), PAF(1), PAF(2), PAF(3)); }
  #undef PKW
  #undef PAF
  #undef VFR
  #undef PIN
  #undef MX3
  #undef GAPA
  #undef GAPB
  #undef EX
  #undef VRD
  #undef KRD
  #undef STEP
  #undef ENDW
  { auto rr = __builtin_amdgcn_permlane32_swap(__float_as_uint(l_reg), __float_as_uint(l_reg), false, false); l_reg = __uint_as_float(rr[0]) + __uint_as_float(rr[1]); }
  if (hi == 0) wsf[32 + r32] = l_reg; asm volatile("s_waitcnt lgkmcnt(0)" ::: "memory");
  float rli[16];
  #pragma unroll
  for (int r = 0; r < 16; ++r) rli[r] = __builtin_amdgcn_rcpf(wsf[32 + crow(r, hi)]);
  bf16* Ow = Oh + (rowbase + q0 + wid * QBLK) * PO;
  { bf16* stg = (bf16*)(shm + LDS_OST) + wid * 2048;
    #pragma unroll
    for (int r = 0; r < 16; ++r) { const int orow = crow(r, hi);
      #pragma unroll
      for (int d0 = 0; d0 < 2; ++d0) stg[orow * 64 + d0 * 32 + r32] = __float2bfloat16(o[d0][r] * rli[r]); }
    asm volatile("s_waitcnt lgkmcnt(0)" ::: "memory");
    #pragma unroll
    for (int i = 0; i < 4; ++i) { const int row = i * 8 + (lane >> 3), ch = lane & 7; const u32x4 v = *(const u32x4*)(stg + row * 64 + ch * 8); ATTN_STORE16(Ow + (long)row * PO + ch * 8, v); } }
  asm volatile("s_waitcnt lgkmcnt(0)\n\ts_barrier" ::: "memory");
  #undef DMA_K
  #undef DMA_V
  #undef CMASK
  #undef START
  #undef RESC
  #undef ROT
}
template <int THRL> __device__ __forceinline__ void attn_unit128(long rowbase, int qb, const bf16* Qh, const bf16* __restrict__ Kh0, const bf16* __restrict__ Vh0, bf16* Oh, char* shm) {
  int tid = threadIdx.x; asm volatile("" : "+v"(tid));
  const int lane = tid & 63, r32 = lane & 31, hi = lane >> 5; const int wid = __builtin_amdgcn_readfirstlane(tid >> 6);
  const int q0 = qb * QB;
  const bf16* Qw = Qh + (rowbase + q0 + wid * QBLK) * PQ;
  const bf16* Kh = Kh0 + rowbase * PQ, *Vh = Vh0 + rowbase * PQ;
  const unsigned lds0 = (unsigned)(uintptr_t)shm;
  constexpr int LDS_WS2 = LDS_V + NSLOT * 2 * SLOTB, LDS_OST2 = LDS_WS2 + NW * 64 * 4;
  float* wsf = (float*)(shm + LDS_WS2) + wid * 64;
  const unsigned koff = (unsigned)((lane * PQ + wid * 8) * 2);
  const unsigned voff = (unsigned)(((16 * (wid & 3) + (lane >> 2)) * PQ + (wid >> 2) * 32 + (lane & 3) * 8) * 2);
  const unsigned kdst = lds0 + LDS_K + wid * 1024, vdst = lds0 + LDS_V + wid * 1024;
  #define DMA_K(t, slot) glds16((const char*)Kh + (size_t)(t) * (KVBLK * PQ * 2), koff, (unsigned)__builtin_amdgcn_readfirstlane(kdst + (slot)))
  #define DMA_V(t, slot) do { glds16((const char*)Vh + (size_t)(t) * (KVBLK * PQ * 2), voff, (unsigned)__builtin_amdgcn_readfirstlane(vdst + 2 * (slot))); \
    glds16((const char*)Vh + (size_t)(t) * (KVBLK * PQ * 2) + 128, voff, (unsigned)__builtin_amdgcn_readfirstlane(vdst + 2 * (slot) + 8192)); } while (0)
  const int vb0 = (int)(lds0 + LDS_V) + ((lane >> 4) & 1) * 32 + (lane & 3) * 8 + (4 * hi + ((lane & 15) >> 2)) * 64;
  const char* Kbase = shm + LDS_K; bf16x8 kf[8];
  const lds_cptr shm3 = (lds_cptr)shm; const lds_cptr kp0 = shm3 + LDS_K + hi * 1024 + r32 * 16; const lds_cptr vp0 = shm3 + LDS_V + ((lane >> 4) & 1) * 32 + (lane & 3) * 8 + (4 * hi + ((lane & 15) >> 2)) * 64;
  const int NT = (q0 + QB) / KVBLK;
  DMA_K(0, 0); DMA_V(0, 0); DMA_K(1, SLOTB);
  const lds_cptr qp0 = shm3 + LDS_OST2 + wid * 4096 + lane * 16;
  {
  #pragma unroll
  for (int d0 = 0; d0 < 4; ++d0) { const bf16x8 qv = *reinterpret_cast<const bf16x8*>(&Qw[(long)r32 * PQ + d0 * 16 + hi * 8]); *(__attribute__((address_space(3))) bf16x8*)(shm3 + LDS_OST2 + wid * 4096 + d0 * 1024 + lane * 16) = qv; }
  asm volatile("s_waitcnt lgkmcnt(0)" ::: "memory");
  }
  #define QR(d0) (*(const __attribute__((address_space(3))) bf16x8*)(qp0 + (d0) * 1024))
  float mhat = 0.f, l_reg = 0.f; f32x16 o[4]; o[0] = f32x16{}; o[1] = f32x16{}; o[2] = f32x16{}; o[3] = f32x16{}; asm volatile("" : "+v"(o[0]), "+v"(o[1]), "+v"(o[2]), "+v"(o[3]));
  const int qrel = wid * QBLK + r32;
  #define CMASK(P0, P1, t) do { int jb_ = (t) - (NT - 4); if (jb_ >= 0) cmask(P0, P1, jb_, qrel, hi); } while (0)
  bool resc = false;
  #define START(P0, P1) do { const float rm = rowmax(P0, P1); resc = false; \
    { const float dl = rm; mhat = fadd_s(mhat, dl); \
      _Pragma("unroll") for (int r = 0; r < 16; ++r) { P0[r] = fsub_s(P0[r], dl); P1[r] = fsub_s(P1[r], dl); } } \
    _Pragma("unroll") for (int r = 0; r < 16; ++r) P0[r] = __builtin_amdgcn_exp2f(P0[r]); } while (0)
  #define RESC() do { if (resc) { asm volatile("s_waitcnt lgkmcnt(0)" ::: "memory"); \
      _Pragma("unroll") for (int d_ = 0; d_ < 4; ++d_) _Pragma("unroll") for (int r = 0; r < 16; ++r) o[d_][r] *= wsf[crow(r, hi)]; } } while (0)
  f32x16 pA0, pA1, pB0, pB1;
  int sl_prev = 0, sl_cur = 0, sl_next = SLOTB;
  #define ROT() do { sl_prev = sl_cur; sl_cur = sl_next; sl_next = (sl_next == (NSLOT - 1) * SLOTB) ? 0 : sl_next + SLOTB; } while (0)
  DMA_K(2, 2 * SLOTB);
  WAIT_BAR(4);
  { bf16x8 qr_[4] = {QR(0), QR(1), QR(2), QR(3)}; qkt(pA0, pA1, Kbase, qr_, f32x16{}, r32, hi); } asm volatile("s_nop 15\n\ts_nop 7" : "+v"(pA0), "+v"(pA1)); CMASK(pA0, pA1, 0);
  START(pA0, pA1);
  _Pragma("unroll") for (int r = 0; r < 16; ++r) pA1[r] = __builtin_amdgcn_exp2f(pA1[r]);
  WAIT_BAR(0);
  DMA_K(3, 0); DMA_V(1, SLOTB);
  ROT();
  kload8(kf, kp0 + sl_cur);
  WAIT_BAR(3);
  s16x4 vlo[8], vhi[8]; u32x4 pw0, pw1, pw2, pw3;
  #define PKW(P, B) cvtpk_s(P[B], P[B + 1])
  #define PAF(k) __builtin_bit_cast(bf16x8, pw##k)
  #define VFR(i) (bf16x8){vlo[i][0], vlo[i][1], vlo[i][2], vlo[i][3], vhi[i][0], vhi[i][1], vhi[i][2], vhi[i][3]}
  #define PIN(x) asm volatile("" : "+v"(x))
  #define MX3(a, b, c) __builtin_fmaxf(__builtin_fmaxf((a), (b)), (c))
  #define GAPA(MF, A0, A1, A2, A3, W0, W1, PW) do { MF; sacc += A0; sacc += A1; sacc += A2; sacc += A3; PIN(sacc); W0; W1; PIN(PW); SBAR(); } while (0)
  #define EX(v) __builtin_amdgcn_exp2f(v)
  #define GAPB(MF, X, B) do { MF; X[B] = EX(X[B]); X[B + 1] = EX(X[B + 1]); X[B + 2] = EX(X[B + 2]); X[B + 3] = EX(X[B + 3]); PIN(X); SBAR(); } while (0)
  #define GAPC(MF, X, B, RD) do { MF; X[B] = EX(X[B]); X[B + 1] = EX(X[B + 1]); PIN(X); RD; SBAR(); } while (0)
  #define VRD(i) do { vlo[i] = vtr(vp_ + (((i) >> 2) * 4096 + ((i) & 3) * 1024)); vhi[i] = vtr(vp_ + (((i) >> 2) * 4096 + ((i) & 3) * 1024 + 512)); } while (0)
  #define VRD2(i) do { vlo[i] = vtr(vp_ + (8192 + ((i) >> 2) * 4096 + ((i) & 3) * 1024)); vhi[i] = vtr(vp_ + (8192 + ((i) >> 2) * 4096 + ((i) & 3) * 1024 + 512)); } while (0)
  #define KRD(G, j) do { if (G) { kload2(kf, kp0 + sl_next, j); SBAR(); } } while (0)
  #define STEP(C0, C1, P0, P1, t, GK, GV, GL) do { SBAR(); \
    const lds_cptr vp_ = vp0 + 2 * sl_prev; \
    VRD(0); SBAR(); float sacc = (P0[0] + P0[1]); \
    GAPA(C0 = __builtin_amdgcn_mfma_f32_32x32x16_bf16(kf[0], QR(0), f32x16{}, 0, 0, 0), P0[2], P0[3], P0[4], P0[5],     pw0[0] = PKW(P0, 0), pw0[1] = PKW(P0, 2), pw0); \
    VRD(4); SBAR(); GAPA(C1 = __builtin_amdgcn_mfma_f32_32x32x16_bf16(kf[1], QR(0), f32x16{}, 0, 0, 0), P0[6], P0[7], P0[8], P0[9],     pw0[2] = PKW(P0, 4), pw0[3] = PKW(P0, 6), pw0); \
    VRD(1); SBAR(); GAPA(C0 = __builtin_amdgcn_mfma_f32_32x32x16_bf16(kf[2], QR(1), C0, 0, 0, 0),   P0[10], P0[11], P0[12], P0[13], pw1[0] = PKW(P0, 8), pw1[1] = PKW(P0, 10), pw1); \
    VRD(5); SBAR(); GAPA(C1 = __builtin_amdgcn_mfma_f32_32x32x16_bf16(kf[3], QR(1), C1, 0, 0, 0),   P0[14], P0[15], P1[0], P1[1],   pw1[2] = PKW(P0, 12), pw1[3] = PKW(P0, 14), pw1); \
    VRD(2); SBAR(); GAPA(C0 = __builtin_amdgcn_mfma_f32_32x32x16_bf16(kf[4], QR(2), C0, 0, 0, 0),   P1[2], P1[3], P1[4], P1[5],     pw2[0] = PKW(P1, 0), pw2[1] = PKW(P1, 2), pw2); \
    VRD(6); SBAR(); GAPA(C1 = __builtin_amdgcn_mfma_f32_32x32x16_bf16(kf[5], QR(2), C1, 0, 0, 0),   P1[6], P1[7], P1[8], P1[9],     pw2[2] = PKW(P1, 4), pw2[3] = PKW(P1, 6), pw2); \
    VRD(3); SBAR(); GAPA(C0 = __builtin_amdgcn_mfma_f32_32x32x16_bf16(kf[6], QR(3), C0, 0, 0, 0),   P1[10], P1[11], P1[12], P1[13], pw3[0] = PKW(P1, 8), pw3[1] = PKW(P1, 10), pw3); \
    VRD(7); SBAR(); GAPA(C1 = __builtin_amdgcn_mfma_f32_32x32x16_bf16(kf[7], QR(3), C1, 0, 0, 0),   P1[14], P1[15], 0.f, 0.f,       pw3[2] = PKW(P1, 12), pw3[3] = PKW(P1, 14), pw3); \
    l_reg += sacc; \
    _Pragma("unroll") for (int r = 0; r < 16; ++r) { C0[r] -= mhat; C1[r] -= mhat; } \
    if (GK) { DMA_K((t) + 3, sl_cur); } if (GV) { DMA_V((t) + 1, sl_next); } \
    CMASK(C0, C1, t); \
    { float a = MX3(C0[0], C0[1], C1[0]), b = MX3(C0[2], C0[3], C1[1]); a = MX3(a, C1[2], C1[3]); \
      _Pragma("unroll") for (int r = 4; r < 16; r += 4) { a = MX3(a, C0[r], C0[r + 1]); b = MX3(b, C0[r + 2], C0[r + 3]); a = MX3(a, C1[r], C1[r + 1]); b = MX3(b, C1[r + 2], C1[r + 3]); } \
      float rm = __builtin_fmaxf(a, b); { auto rr = __builtin_amdgcn_permlane32_swap(__float_as_uint(rm), __float_as_uint(rm), false, false); rm = __builtin_fmaxf(__uint_as_float(rr[0]), __uint_as_float(rr[1])); } \
      resc = false; \
      if (__builtin_expect(__any(rm > (float)THRL), 0)) { const float dl = __builtin_fmaxf(rm, 0.f); mhat += dl; \
        _Pragma("unroll") for (int r = 0; r < 16; ++r) { C0[r] -= dl; C1[r] -= dl; } \
        const float f = __builtin_amdgcn_exp2f(-dl); l_reg *= f; if (hi == 0) wsf[r32] = f; resc = true; } } \
    SBAR(); \
    GAPC(o[0] = __builtin_amdgcn_mfma_f32_32x32x16_bf16(PAF(0), VFR(0), o[0], 0, 0, 0), C0, 0, VRD2(0)); \
    GAPC(o[1] = __builtin_amdgcn_mfma_f32_32x32x16_bf16(PAF(0), VFR(4), o[1], 0, 0, 0), C0, 2, VRD2(4)); \
    KRD(GL, 0); GAPC(o[0] = __builtin_amdgcn_mfma_f32_32x32x16_bf16(PAF(1), VFR(1), o[0], 0, 0, 0), C0, 4, VRD2(1)); \
    KRD(GL, 1); GAPC(o[1] = __builtin_amdgcn_mfma_f32_32x32x16_bf16(PAF(1), VFR(5), o[1], 0, 0, 0), C0, 6, VRD2(5)); \
    KRD(GL, 2); GAPC(o[0] = __builtin_amdgcn_mfma_f32_32x32x16_bf16(PAF(2), VFR(2), o[0], 0, 0, 0), C0, 8, VRD2(2)); \
    KRD(GL, 3); GAPC(o[1] = __builtin_amdgcn_mfma_f32_32x32x16_bf16(PAF(2), VFR(6), o[1], 0, 0, 0), C0, 10, VRD2(6)); \
    GAPC(o[0] = __builtin_amdgcn_mfma_f32_32x32x16_bf16(PAF(3), VFR(3), o[0], 0, 0, 0), C0, 12, VRD2(3)); \
    GAPC(o[1] = __builtin_amdgcn_mfma_f32_32x32x16_bf16(PAF(3), VFR(7), o[1], 0, 0, 0), C0, 14, VRD2(7)); \
    GAPC(o[2] = __builtin_amdgcn_mfma_f32_32x32x16_bf16(PAF(0), VFR(0), o[2], 0, 0, 0), C1, 0, (void)0); \
    GAPC(o[3] = __builtin_amdgcn_mfma_f32_32x32x16_bf16(PAF(0), VFR(4), o[3], 0, 0, 0), C1, 2, (void)0); \
    GAPC(o[2] = __builtin_amdgcn_mfma_f32_32x32x16_bf16(PAF(1), VFR(1), o[2], 0, 0, 0), C1, 4, (void)0); \
    GAPC(o[3] = __builtin_amdgcn_mfma_f32_32x32x16_bf16(PAF(1), VFR(5), o[3], 0, 0, 0), C1, 6, (void)0); \
    GAPC(o[2] = __builtin_amdgcn_mfma_f32_32x32x16_bf16(PAF(2), VFR(2), o[2], 0, 0, 0), C1, 8, (void)0); \
    GAPC(o[3] = __builtin_amdgcn_mfma_f32_32x32x16_bf16(PAF(2), VFR(6), o[3], 0, 0, 0), C1, 10, (void)0); \
    GAPC(o[2] = __builtin_amdgcn_mfma_f32_32x32x16_bf16(PAF(3), VFR(3), o[2], 0, 0, 0), C1, 12, (void)0); \
    GAPC(o[3] = __builtin_amdgcn_mfma_f32_32x32x16_bf16(PAF(3), VFR(7), o[3], 0, 0, 0), C1, 14, (void)0); \
    } while (0)
  int t = 1;
  #undef CMASK
  #define CMASK(P0, P1, t) do {} while (0)
  for (; t + 5 < NT; t += 2) {
    STEP(pB0, pB1, pA0, pA1, t, true, true, true);     WAIT_BAR(3); RESC(); ROT();
    STEP(pA0, pA1, pB0, pB1, t + 1, true, true, true); WAIT_BAR(3); RESC(); ROT();
  }
  #undef CMASK
  #define CMASK(P0, P1, t) do { int jb_ = (t) - (NT - 4); if (jb_ >= 0) cmask(P0, P1, jb_, qrel, hi); } while (0)
  #define ENDW(tt) do { if ((tt) + 3 < NT) { WAIT_BAR(3); } else if ((tt) + 2 < NT) { WAIT_BAR(2); } else { WAIT_BAR(0); } } while (0)
  for (; t + 1 < NT; t += 2) {
    STEP(pB0, pB1, pA0, pA1, t, (t + 3 < NT), (t + 1 < NT), (t + 1 < NT));         ENDW(t);     RESC(); ROT();
    STEP(pA0, pA1, pB0, pB1, t + 1, (t + 4 < NT), (t + 2 < NT), (t + 2 < NT));     ENDW(t + 1); RESC(); ROT();
  }
  STEP(pB0, pB1, pA0, pA1, NT - 1, false, false, false); RESC();
  { float sacc = pB0[0] + pB0[1]; _Pragma("unroll") for (int r = 2; r < 16; ++r) sacc += pB0[r]; _Pragma("unroll") for (int r = 0; r < 16; ++r) sacc += pB1[r]; l_reg += sacc;
    pw0 = (u32x4){PKW(pB0, 0), PKW(pB0, 2), PKW(pB0, 4), PKW(pB0, 6)}; pw1 = (u32x4){PKW(pB0, 8), PKW(pB0, 10), PKW(pB0, 12), PKW(pB0, 14)}; pw2 = (u32x4){PKW(pB1, 0), PKW(pB1, 2), PKW(pB1, 4), PKW(pB1, 6)}; pw3 = (u32x4){PKW(pB1, 8), PKW(pB1, 10), PKW(pB1, 12), PKW(pB1, 14)};
    SBAR(); pv(o, vb0 + 2 * sl_cur, PAF(0), PAF(1), PAF(2), PAF(3)); pv(o + 2, vb0 + 2 * sl_cur + 8192, PAF(0), PAF(1), PAF(2), PAF(3)); }
  #undef PKW
  #undef PAF
  #undef VFR
  #undef PIN
  #undef MX3
  #undef GAPA
  #undef GAPB
  #undef GAPC
  #undef EX
  #undef VRD
  #undef VRD2
  #undef KRD
  #undef STEP
  #undef ENDW
  { auto rr = __builtin_amdgcn_permlane32_swap(__float_as_uint(l_reg), __float_as_uint(l_reg), false, false); l_reg = __uint_as_float(rr[0]) + __uint_as_float(rr[1]); }
  if (hi == 0) wsf[32 + r32] = l_reg; asm volatile("s_waitcnt lgkmcnt(0)" ::: "memory");
  float rli[16];
  #pragma unroll
  for (int r = 0; r < 16; ++r) rli[r] = __builtin_amdgcn_rcpf(wsf[32 + crow(r, hi)]);
  bf16* Ow = Oh + (rowbase + q0 + wid * QBLK) * PO;
  { bf16* stg = (bf16*)(shm + LDS_OST2) + wid * 2048;
    int te_ = threadIdx.x; asm volatile("" : "+v"(te_)); const int lane = te_ & 63;
    #pragma unroll
    for (int hv = 0; hv < 2; ++hv) {
      #pragma unroll
      for (int r = 0; r < 16; ++r) { const int orow = crow(r, hi);
        #pragma unroll
        for (int d0 = 0; d0 < 2; ++d0) stg[orow * 64 + d0 * 32 + r32] = __float2bfloat16(o[2 * hv + d0][r] * rli[r]); }
      asm volatile("s_waitcnt lgkmcnt(0)" ::: "memory");
      #pragma unroll
      for (int i = 0; i < 4; ++i) { const int row = i * 8 + (lane >> 3), ch = lane & 7; const u32x4 v = *(const u32x4*)(stg + row * 64 + ch * 8); ATTN_STORE16(Ow + (long)row * PO + hv * 64 + ch * 8, v); }
      asm volatile("s_waitcnt lgkmcnt(0)" ::: "memory");
    } }
  asm volatile("s_waitcnt lgkmcnt(0)\n\ts_barrier" ::: "memory");
  #undef QR
  #undef DMA_K
  #undef DMA_V
  #undef CMASK
  #undef START
  #undef RESC
  #undef ROT
}
__device__ __forceinline__ void attn_phase128(char* lds, const bf16_t* proj, bf16_t* att, int G, int vcu) {
  for (int i = 0;; ++i) {
    const int L = i * G + vcu; if (L >= 512) break;
    const int k = L >> 8, w = L & 255, ph = w >> 2, sq = w & 3;
    const int qb = (k == 0) ? (7 - sq) : sq;
    const int b = ph >> 4, rem = ph & 15, h = rem >> 1, c = rem & 1;
    const bf16* P = (const bf16*)proj;
    attn_unit128<8>((long)b * SEQ, qb, P + C_Q + (2 * h + c) * 64, P + C_K + (2 * h + c) * 64, P + C_V + h * 128, (bf16*)att + c * 1024 + h * 128, lds);
  }
}

__device__ __forceinline__ void attn_phase(char* lds, const bf16_t* proj, bf16_t* att, int G, int vcu) {
  for (int i = 0;; ++i) {
    const int L = i * G + vcu; if (L >= 1024) break;
    const int k = L >> 8, w = L & 255, ph = w >> 1, set = w & 1;
    const int qb = (k == 0) ? (7 - set) : (k == 1) ? set : (k == 2) ? (4 + set) : (3 - set);
    const int b = ph >> 5, rem = ph & 31, h = rem >> 2, c = (rem >> 1) & 1, vh = rem & 1;
    const bf16* P = (const bf16*)proj;
    attn_unit<8>((long)b * SEQ, qb, P + C_Q + (2 * h + c) * 64, P + C_K + (2 * h + c) * 64, P + C_V + h * 128 + vh * 64, (bf16*)att + c * 1024 + h * 128 + vh * 64, lds);
  }
}
#undef SBAR
#undef WAIT_BAR
}

#define XB_TMO      128
#define XB_XCNT(j)  (256  + 64 * (j))
#define XB_XSUB(j)  (1280 + 64 * (j))
#define XB_XGEN(j)  (2304 + 64 * (j))
#define XB_TOP      3328
#define XB_TOPGEN   3392
#define XCD_BAR_WORDS 3456
#define XB_SPIN_CAP (1u << 18)
__device__ __forceinline__ unsigned xb_ld(unsigned* p)              { return __hip_atomic_load(p, __ATOMIC_RELAXED, __HIP_MEMORY_SCOPE_AGENT); }
__device__ __forceinline__ unsigned xb_add(unsigned* p, unsigned v) { return __hip_atomic_fetch_add(p, v, __ATOMIC_RELAXED, __HIP_MEMORY_SCOPE_AGENT); }
__device__ __forceinline__ unsigned xb_xcc_id() { return (unsigned)__builtin_amdgcn_s_getreg((3 << 11) | 20) & 0xFu; }
#define XB_SPIN(cond, bar) do { unsigned _sp = 0; while (cond) { __builtin_amdgcn_s_sleep(1); \
    if ((++_sp & 255u) == 0u) { if (xb_ld(&(bar)[XB_TMO])) break; if (_sp > XB_SPIN_CAP) { atomicAdd(&(bar)[XB_TMO], 1u); break; } } } } while (0)
struct XcdBarrier { unsigned* bar; unsigned x; volatile LAS unsigned* st; };
__device__ __forceinline__ XcdBarrier xcd_barrier_post(unsigned* bar, volatile LAS unsigned* st) {
    XcdBarrier b; b.bar = bar; b.x = xb_xcc_id(); b.st = st;
    if (threadIdx.x == 0) (void)xb_add(&bar[XB_XCNT(b.x)], 1u);
    return b;
}
__device__ __forceinline__ void xcd_barrier_complete(unsigned* bar, unsigned x, unsigned& nloc, unsigned& nx) {
    const unsigned G = gridDim.x * gridDim.y * gridDim.z;
    unsigned sum, cnt, mine, sp = 0u;
    for (;;) {
        sum = 0u; cnt = 0u; mine = 0u;
#pragma unroll
        for (unsigned j = 0; j < 16; ++j) { const unsigned c = xb_ld(&bar[XB_XCNT(j)]); sum += c; cnt += (c > 0u) ? 1u : 0u; mine = (j == x) ? c : mine; }
        if (sum == G) break;
        __builtin_amdgcn_s_sleep(1);
        if ((++sp & 255u) == 0u) { if (xb_ld(&bar[XB_TMO])) break; if (sp > XB_SPIN_CAP) { atomicAdd(&bar[XB_TMO], 1u); break; } }
    }
    nloc = mine > 0u ? mine : 1u; nx = cnt > 0u ? cnt : 1u;
}
__device__ __forceinline__ void xcd_barrier(const XcdBarrier& b) {
    asm volatile("s_waitcnt vmcnt(0)" ::: "memory");
    __syncthreads();
    if (threadIdx.x == 0) {
        unsigned* bar = b.bar;
        __builtin_amdgcn_s_waitcnt(0);
        unsigned nloc = b.st[0], nx = b.st[1];
        if (nloc == 0u) { xcd_barrier_complete(bar, b.x, nloc, nx); b.st[0] = nloc; b.st[1] = nx; }
        const unsigned old = xb_add(&bar[XB_XSUB(b.x)], 1u);
        const unsigned gen = old / nloc;
        if (old + 1u == (gen + 1u) * nloc) {
            __builtin_amdgcn_fence(__ATOMIC_RELEASE, "agent");
            asm volatile("s_waitcnt vmcnt(0)" ::: "memory");
            const unsigned og = xb_add(&bar[XB_TOP], 1u);
            const unsigned tg = og / nx;
            if (og + 1u == (tg + 1u) * nx) xb_add(&bar[XB_TOPGEN], 1u);
            else XB_SPIN(xb_ld(&bar[XB_TOPGEN]) == tg, bar);
            __builtin_amdgcn_fence(__ATOMIC_ACQUIRE, "agent");
            xb_add(&bar[XB_XGEN(b.x)], 1u);
            asm volatile("s_waitcnt vmcnt(0)" ::: "memory");
        } else {
            XB_SPIN(xb_ld(&bar[XB_XGEN(b.x)]) == gen, bar);
            __builtin_amdgcn_fence(__ATOMIC_ACQUIRE, "agent");
            asm volatile("s_waitcnt vmcnt(0)" ::: "memory");
        }
    }
    __syncthreads();
}

struct Ptrs {
    const float* in[24]; float* out; unsigned char* ws;
};
__device__ __forceinline__ void p0_transpose_item(const float* W, int K, int N, int Nvalid, bf16_t* WT, LAS float* scr, int item, int nblk, int lane) {
    const int kb = item / nblk, nb = item % nblk, k0 = 64 * kb, n0 = 32 * nb;
    const int nn = n0 + (lane & 31); const bool ok = nn < Nvalid;
    float v[32];
#pragma unroll
    for (int i = 0; i < 32; ++i) { const int kk = 2 * i + (lane >> 5); v[i] = ok ? W[(size_t)(k0 + kk) * N + nn] : 0.f; }
#pragma unroll
    for (int i = 0; i < 32; ++i) { const int kk = 2 * i + (lane >> 5); scr[kk * 33 + (lane & 31)] = v[i]; }
    LDS_WAIT(); asm volatile("" ::: "memory");
    const int c = lane & 7;
#pragma unroll
    for (int j = 0; j < 4; ++j) { const int n = (lane >> 3) + 8 * j; const LAS float* s = scr + (8 * c) * 33 + n;
        u32x4 o; o.x = cvt_pk_bf16(s[0 * 33], s[1 * 33]); o.y = cvt_pk_bf16(s[2 * 33], s[3 * 33]); o.z = cvt_pk_bf16(s[4 * 33], s[5 * 33]); o.w = cvt_pk_bf16(s[6 * 33], s[7 * 33]);
        *(u32x4*)(WT + (size_t)(n0 + n) * K + k0 + 8 * c) = o; }
    LDS_WAIT(); asm volatile("" ::: "memory");
}
__device__ __forceinline__ void p0_prologue(const Ptrs& P, LAS unsigned char* lds, int gw, int NGW, int wave) {
    int tq_ = threadIdx.x; asm volatile("" : "+v"(tq_)); const int lane = tq_ & 63;
    LAS float* scr = (LAS float*)(lds + wave * 16384);
    unsigned char* ws = P.ws;
    constexpr int I_IN = 32 * (NPROJP / 32), I_OUT = 32 * 64;
    constexpr int NITEMS = I_IN + I_OUT;
    for (int it = gw; it < NITEMS; it += NGW) {
        int r = it;
        if (r < I_IN) { p0_transpose_item(P.in[3], DM, NPROJ, NPROJ, (bf16_t*)(ws + WS_WIN), scr, r, NPROJP / 32, lane); continue; } r -= I_IN;
        p0_transpose_item(P.in[15], DM, DM, DM, (bf16_t*)(ws + WS_WOUT), scr, r, 64, lane);
    }
    const float* x = P.in[0]; const float* nw = P.in[2]; bf16_t* XN = (bf16_t*)(ws + WS_XN);
    for (int m = gw; m < NTOK; m += NGW) {
        const f32x4* xr = (const f32x4*)(x + (size_t)m * DM) + lane; f32x4 v[8]; float s = 0.f;
#pragma unroll
        for (int j = 0; j < 8; ++j) { v[j] = xr[64 * j]; s += (v[j].x * v[j].x + v[j].y * v[j].y) + (v[j].z * v[j].z + v[j].w * v[j].w); }
        const float rstd = 1.0f / sqrtf(wave_sum(s) * (1.f / DM) + EPS);
        u32x2* o8 = (u32x2*)(XN + (size_t)m * DM) + lane;
#pragma unroll
        for (int j = 0; j < 8; ++j) { const f32x4 w = ((const f32x4*)nw)[lane + 64 * j]; u32x2 o; o.x = cvt_pk_bf16(v[j].x * rstd * w.x, v[j].y * rstd * w.y); o.y = cvt_pk_bf16(v[j].z * rstd * w.z, v[j].w * rstd * w.w); o8[64 * j] = o; }
    }
    const int* pos = (const int*)P.in[1]; float* rope = (float*)(ws + WS_ROPE);
    for (int idx = gw * 64 + lane; idx < NTOK * 8; idx += NGW * 64) {
        const int t = idx >> 3, i = idx & 7;
        const float inv = powf(500000.0f, -(float)(2 * i) / 16.0f);
        const float ang = (float)pos[t] * inv;
        rope[t * 16 + i] = (float)cos((double)ang); rope[t * 16 + 8 + i] = (float)sin((double)ang);
    }
}

constexpr int SP = 272;
constexpr int L_BN = 0, L_CN = 128 * SP, L_BT = 2 * 128 * SP, L_XT = 3 * 128 * SP, L_DT = L_XT + 64 * SP, L_CSV = L_DT + 512, L_DA = L_CSV + 512;
static_assert(L_DA + 512 <= RING_BYTES, "ssd lds");
static_assert(VAN_OFF + 512 * 16 <= BIAS_OFF && BIAS_OFF + 2048 <= LDS_BYTES, "lds map");
__device__ __forceinline__ int crow16(int r, int hi) { return (r & 3) + 8 * (r >> 2) + 4 * hi; }
template <bool SWA, bool SWB>
__device__ __forceinline__ f32x16 mm32_k128(const LAS unsigned char* As, int m0, const LAS unsigned char* Bs, int n0, int r32, int hi) {
    f32x16 acc = f32x16{};
    const int ra = m0 + r32, rbw = n0 + r32, xa = SWA ? ((ra >> 3) & 15) : 0, xb = SWB ? ((rbw >> 3) & 15) : 0;
#pragma unroll
    for (int k0 = 0; k0 < 128; k0 += 16) {
        const int kc = (k0 >> 3) + hi;
        const bf16x8 a = *(const LAS bf16x8*)(As + ra * SP + ((kc ^ xa) << 4));
        const bf16x8 b = *(const LAS bf16x8*)(Bs + rbw * SP + ((kc ^ xb) << 4));
        acc = __builtin_amdgcn_mfma_f32_32x32x16_bf16(a, b, acc, 0, 0, 0);
    }
    return acc;
}
constexpr int LA_BN = 0, LA_CN = 128 * SP, LA_BT = 2 * 128 * SP, LA_XT1 = LA_CN, LA_XT2 = LA_CN + 64 * SP, LA_DT = 3 * 128 * SP, LA_CSV = LA_DT + 2048, LA_TMP = LA_CSV + 2048;
static_assert(LA_TMP + 64 <= RING_BYTES, "ssd-a lds");
__device__ __forceinline__ void ssd_a_unit(const Ptrs& P, LAS unsigned char* lds, int b, int c, int g, int hh) {
    int tid = threadIdx.x; asm volatile("" : "+v"(tid));
    const int lane = tid & 63, wid = __builtin_amdgcn_readfirstlane(tid >> 6), r32 = lane & 31, hi = lane >> 5;
    unsigned char* ws = P.ws;
    const bf16_t* proj = (const bf16_t*)(ws + WS_PROJ);
    const float* dtraw = (const float*)(ws + WS_DTRAW);
    float* CS = (float*)(ws + WS_CS);
    const float* conv_w = P.in[9]; const float* conv_b = P.in[10];
    bf16_t* XCONV = (bf16_t*)(ws + WS_XCONV); bf16_t* CCONV = (bf16_t*)(ws + WS_CCONV);
    const int row0 = b * SEQ + c * 128, h0 = g * 8 + hh * 4;
    LAS float* sDT = (LAS float*)(lds + LA_DT); LAS float* sCS = (LAS float*)(lds + LA_CSV); LAS float* sTMP = (LAS float*)(lds + LA_TMP);
    const int hq = wid >> 1, stp = tid & 127;
    const float raw_q = dtraw[(size_t)(row0 + stp) * 16 + h0 + hq];
    if (tid < 384) {
        const int rb = tid >> 5, grp = tid & 31;
        const int ch = grp < 16 ? 1024 + g * 128 + 8 * grp : 1280 + g * 128 + 8 * (grp - 16);
        const int l0 = rb * 11, nrow = (l0 + 11 <= 128) ? 11 : 128 - l0;
        u32x4 v[14];
#pragma unroll
        for (int j = 0; j < 14; ++j) {
            const int ls = c * 128 + l0 - 3 + j;
            v[j] = (ls >= 0 && j < nrow + 3) ? *(const u32x4*)(proj + (size_t)(b * SEQ + ls) * NPROJP + C_XBC + ch) : (u32x4){0u, 0u, 0u, 0u};
        }
        f32x4 w[4][2];
#pragma unroll
        for (int j = 0; j < 4; ++j) { w[j][0] = *(const f32x4*)(conv_w + j * 1536 + ch); w[j][1] = *(const f32x4*)(conv_w + j * 1536 + ch + 4); }
        const f32x4 cb0 = *(const f32x4*)(conv_b + ch), cb1 = *(const f32x4*)(conv_b + ch + 4);
#pragma unroll
        for (int r = 0; r < 11; ++r) {
            if (r < nrow) {
                const int l = l0 + r;
                float a[8] = {cb0.x, cb0.y, cb0.z, cb0.w, cb1.x, cb1.y, cb1.z, cb1.w};
#pragma unroll
                for (int j = 0; j < 4; ++j) {
                    const u32x4 x = v[r + j];
                    a[0] += w[j][0].x * bf_lo(x.x); a[1] += w[j][0].y * bf_hi(x.x); a[2] += w[j][0].z * bf_lo(x.y); a[3] += w[j][0].w * bf_hi(x.y);
                    a[4] += w[j][1].x * bf_lo(x.z); a[5] += w[j][1].y * bf_hi(x.z); a[6] += w[j][1].z * bf_lo(x.w); a[7] += w[j][1].w * bf_hi(x.w);
                }
#pragma unroll
                for (int q = 0; q < 8; ++q) a[q] = a[q] * sigmoidf_(a[q]);
                u32x4 pk; pk.x = cvt_pk_bf16(a[0], a[1]); pk.y = cvt_pk_bf16(a[2], a[3]); pk.z = cvt_pk_bf16(a[4], a[5]); pk.w = cvt_pk_bf16(a[6], a[7]);
                if (grp < 16) {
                    const int n0 = 8 * grp;
                    *(LAS u32x4*)(lds + LA_BN + l * SP + n0 * 2) = pk;
                    const unsigned tb = (unsigned)(LA_BT + n0 * SP + (((l >> 3) ^ grp) << 4) + (l & 7) * 2);
                    *(LAS bf16_t*)(lds + tb + 0 * SP) = (bf16_t)(pk.x & 0xffffu); *(LAS bf16_t*)(lds + tb + 1 * SP) = (bf16_t)(pk.x >> 16);
                    *(LAS bf16_t*)(lds + tb + 2 * SP) = (bf16_t)(pk.y & 0xffffu); *(LAS bf16_t*)(lds + tb + 3 * SP) = (bf16_t)(pk.y >> 16);
                    *(LAS bf16_t*)(lds + tb + 4 * SP) = (bf16_t)(pk.z & 0xffffu); *(LAS bf16_t*)(lds + tb + 5 * SP) = (bf16_t)(pk.z >> 16);
                    *(LAS bf16_t*)(lds + tb + 6 * SP) = (bf16_t)(pk.w & 0xffffu); *(LAS bf16_t*)(lds + tb + 7 * SP) = (bf16_t)(pk.w >> 16);
                } else {
                    const int n0 = 8 * (grp - 16);
                    *(LAS u32x4*)(lds + LA_CN + l * SP + n0 * 2) = pk;
                    if (hh == 0) *(u32x4*)(CCONV + (size_t)(row0 + l) * 256 + g * 128 + n0) = pk;
                }
            }
        }
    }
    __syncthreads();
    f32x16 cbt[2];
#pragma unroll
    for (int q = 0; q < 2; ++q) { const int t = wid * 2 + q, mi = t >> 2, ni = t & 3; cbt[q] = mm32_k128<false, false>(lds + LA_CN, 32 * mi, lds + LA_BN, 32 * ni, r32, hi); }
    {
        const int h = h0 + hq;
        const float raw = raw_q + P.in[11][h];
        const float dtv = raw > 20.f ? raw : log1pf(expf(raw));
        float s_ = dtv * (-expf(P.in[12][h]));
#pragma unroll
        for (int o = 1; o < 64; o <<= 1) { const float t = __shfl_up(s_, o); if (lane >= o) s_ += t; }
        if ((tid & 127) == 63) sTMP[hq] = s_;
        __syncthreads();
        if (tid & 64) s_ += sTMP[hq];
        sDT[hq * 128 + stp] = dtv; sCS[hq * 128 + stp] = s_; CS[(size_t)(row0 + stp) * 16 + h] = s_;
        __syncthreads();
    }
#pragma unroll 1
    for (int i = 0; i < 4; ++i) {
        const int h = h0 + i;
        const int l2 = tid >> 3, grp = tid & 7, chx = h * 64 + 8 * grp, lx = 2 * l2;
        u32x4 xv[5];
#pragma unroll
        for (int j = 0; j < 5; ++j) { const int ls = c * 128 + lx - 3 + j; xv[j] = (ls >= 0) ? *(const u32x4*)(proj + (size_t)(b * SEQ + ls) * NPROJP + C_XBC + chx) : (u32x4){0u, 0u, 0u, 0u}; }
        LAS float* sDTh = sDT + i * 128; LAS float* sCSh = sCS + i * 128;
        const float cs_last = sCSh[127];
        {
            f32x4 w[4][2];
#pragma unroll
            for (int j = 0; j < 4; ++j) { w[j][0] = *(const f32x4*)(conv_w + j * 1536 + chx); w[j][1] = *(const f32x4*)(conv_w + j * 1536 + chx + 4); }
            const f32x4 cb0 = *(const f32x4*)(conv_b + chx), cb1 = *(const f32x4*)(conv_b + chx + 4);
#pragma unroll
            for (int r = 0; r < 2; ++r) {
                const int l = lx + r;
                float a[8] = {cb0.x, cb0.y, cb0.z, cb0.w, cb1.x, cb1.y, cb1.z, cb1.w};
#pragma unroll
                for (int j = 0; j < 4; ++j) {
                    const u32x4 x = xv[r + j];
                    a[0] += w[j][0].x * bf_lo(x.x); a[1] += w[j][0].y * bf_hi(x.x); a[2] += w[j][0].z * bf_lo(x.y); a[3] += w[j][0].w * bf_hi(x.y);
                    a[4] += w[j][1].x * bf_lo(x.z); a[5] += w[j][1].y * bf_hi(x.z); a[6] += w[j][1].z * bf_lo(x.w); a[7] += w[j][1].w * bf_hi(x.w);
                }
#pragma unroll
                for (int q = 0; q < 8; ++q) a[q] = a[q] * sigmoidf_(a[q]);
                u32x4 pk; pk.x = cvt_pk_bf16(a[0], a[1]); pk.y = cvt_pk_bf16(a[2], a[3]); pk.z = cvt_pk_bf16(a[4], a[5]); pk.w = cvt_pk_bf16(a[6], a[7]);
                *(u32x4*)(XCONV + (size_t)(row0 + l) * 1024 + chx) = pk;
                const float dt = sDTh[l], dw = dt * fexp(cs_last - sCSh[l]);
                const unsigned tb = (unsigned)((8 * grp) * SP + (((l >> 3) ^ grp) << 4) + (l & 7) * 2);
#pragma unroll
                for (int q = 0; q < 8; q += 2) {
                    const unsigned p1 = cvt_pk_bf16(a[q] * dt, a[q + 1] * dt), p2 = cvt_pk_bf16(a[q] * dw, a[q + 1] * dw);
                    *(LAS bf16_t*)(lds + LA_XT1 + tb + q * SP) = (bf16_t)(p1 & 0xffffu); *(LAS bf16_t*)(lds + LA_XT1 + tb + (q + 1) * SP) = (bf16_t)(p1 >> 16);
                    *(LAS bf16_t*)(lds + LA_XT2 + tb + q * SP) = (bf16_t)(p2 & 0xffffu); *(LAS bf16_t*)(lds + LA_XT2 + tb + (q + 1) * SP) = (bf16_t)(p2 >> 16);
                }
            }
        }
#pragma unroll
        for (int q = 0; q < 2; ++q) {
            const int t = wid * 2 + q, mi = t >> 2, ni = t & 3; const int s_ = 32 * ni + r32; const float css = sCSh[s_];
#pragma unroll
            for (int r = 0; r < 16; ++r) { const int l = 32 * mi + crow16(r, hi); const float m = (s_ <= l) ? cbt[q][r] * fexp(sCSh[l] - css) : 0.f; *(LAS bf16_t*)(lds + LA_BN + l * SP + s_ * 2) = f2bf(m); }
        }
        __syncthreads();
        {
            const int mi = wid >> 2, ni = wid & 3;
            const f32x16 acc = mm32_k128<true, true>(lds + LA_XT2, 32 * mi, lds + LA_BT, 32 * ni, r32, hi);
            float* st = (float*)(ws + WS_STATES) + ((size_t)((b * 16 + c) * 16 + h)) * 8192;
#pragma unroll
            for (int r = 0; r < 16; ++r) st[(32 * mi + crow16(r, hi)) * 128 + 32 * ni + r32] = acc[r];
        }
        {
            const int mi = wid >> 1, ni = wid & 1;
            const f32x16 acc = mm32_k128<false, true>(lds + LA_BN, 32 * mi, lds + LA_XT1, 32 * ni, r32, hi);
            float* yd = (float*)(ws + WS_YDIAG);
#pragma unroll
            for (int r = 0; r < 16; ++r) yd[(size_t)(row0 + 32 * mi + crow16(r, hi)) * 1024 + h * 64 + 32 * ni + r32] = acc[r];
        }
        __syncthreads();
    }
}
__device__ __forceinline__ void ssd_scan(const Ptrs& P, int gtid, int nthr) {
    float* st = (float*)(P.ws + WS_STATES); const float* CS = (const float*)(P.ws + WS_CS);
    for (int e4 = gtid; e4 < NB * 16 * 2048; e4 += nthr) {
        const int bh = e4 >> 11, off = e4 & 2047, b = bh >> 4, h = bh & 15;
        f32x4 sv[16]; float dec[16];
#pragma unroll
        for (int c = 0; c < 16; ++c) { sv[c] = *((const f32x4*)(st + ((size_t)((b * 16 + c) * 16 + h)) * 8192) + off); dec[c] = CS[(size_t)(b * SEQ + c * 128 + 127) * 16 + h]; }
        f32x4 carry = (f32x4){0.f, 0.f, 0.f, 0.f};
#pragma unroll
        for (int c = 0; c < 16; ++c) {
            *((f32x4*)(st + ((size_t)((b * 16 + c) * 16 + h)) * 8192) + off) = carry;
            carry = carry * fexp(dec[c]) + sv[c];
        }
    }
}
constexpr int L2_CS = 0, L2_PV = 64 * SP, L2_Y = L2_PV + 2 * 64 * SP, YP = 1040;
static_assert(L2_Y + 64 * YP <= RING_BYTES, "ssd-c lds");
__device__ __forceinline__ void ssd_c_unit(const Ptrs& P, LAS unsigned char* lds, int b, int c, int g, int rh) {
    int tid = threadIdx.x; asm volatile("" : "+v"(tid));
    const int lane = tid & 63, wid = __builtin_amdgcn_readfirstlane(tid >> 6), r32 = lane & 31, hi = lane >> 5;
    unsigned char* ws = P.ws;
    const int row0 = b * SEQ + c * 128 + rh * 64;
    const bf16_t* CCONV = (const bf16_t*)(ws + WS_CCONV); const bf16_t* XCONV = (const bf16_t*)(ws + WS_XCONV); const bf16_t* proj = (const bf16_t*)(ws + WS_PROJ);
    const float* st = (const float*)(ws + WS_STATES); const float* CS = (const float*)(ws + WS_CS); const float* yd = (const float*)(ws + WS_YDIAG);
    bf16_t* CAT = (bf16_t*)(ws + WS_CAT);
    for (int q = tid; q < 64 * 16; q += 512) { const int l = q >> 4, n8 = q & 15; *(LAS u32x4*)(lds + L2_CS + l * SP + n8 * 16) = *(const u32x4*)(CCONV + (size_t)(row0 + l) * 256 + g * 128 + n8 * 8); }
    const int hw = wid >> 2, tile = wid & 3, mi = tile >> 1, ni = tile & 1;
    for (int hp = 0; hp < 4; ++hp) {
        __syncthreads();
        const int h0 = g * 8 + 2 * hp;
        const int h = h0 + hw;
        const unsigned rowA = (unsigned)(row0 + 32 * mi + 4 * hi), col = (unsigned)(h * 64 + 32 * ni + r32);
        float e_yd[16], e_cs[16]; bf16_t e_xc[16], e_z[16];
#pragma unroll
        for (int r = 0; r < 16; ++r) { const unsigned row = rowA + 8 * (r >> 2) + (r & 3);
            e_yd[r] = yd[row * 1024u + col]; e_cs[r] = CS[row * 16u + (unsigned)h]; e_xc[r] = XCONV[row * 1024u + col]; e_z[r] = proj[row * (unsigned)NPROJP + (unsigned)C_Z + col]; }
#pragma unroll
        for (int q = 0; q < 4; ++q) {
            const int idx = tid + 512 * q, hh = idx >> 10, rem = idx & 1023, p = rem >> 4, n8 = rem & 15;
            const float* src = st + ((size_t)((b * 16 + c) * 16 + h0 + hh)) * 8192 + p * 128 + n8 * 8;
            const f32x4 v0 = *(const f32x4*)src, v1 = *(const f32x4*)(src + 4);
            u32x4 pk; pk.x = cvt_pk_bf16(v0.x, v0.y); pk.y = cvt_pk_bf16(v0.z, v0.w); pk.z = cvt_pk_bf16(v1.x, v1.y); pk.w = cvt_pk_bf16(v1.z, v1.w);
            *(LAS u32x4*)(lds + L2_PV + (hh * 64 + p) * SP + n8 * 16) = pk;
        }
        __syncthreads();
        const f32x16 acc = mm32_k128<false, false>(lds + L2_CS, 32 * mi, lds + L2_PV + hw * 64 * SP, 32 * ni, r32, hi);
        const float dsk = P.in[13][h];
        const unsigned ybase = (unsigned)(L2_Y + (32 * mi + 4 * hi) * YP + ((2 * hp + hw) * 64 + 32 * ni + r32) * 2);
#pragma unroll
        for (int r = 0; r < 16; ++r) {
            float y = acc[r] * fexp(e_cs[r]) + e_yd[r] + dsk * bf2f(e_xc[r]);
            const float z = bf2f(e_z[r]);
            y *= z * sigmoidf_(z);
            *(LAS bf16_t*)(lds + ybase + (8 * (r >> 2) + (r & 3)) * YP) = f2bf(y);
        }
    }
    __syncthreads();
    const float* nw = P.in[14] + g * 512 + 8 * lane;
    const f32x4 nw0 = *(const f32x4*)nw, nw1 = *(const f32x4*)(nw + 4);
    for (int i = 0; i < 8; ++i) {
        const int ll = wid * 8 + i;
        const u32x4 v = *(const LAS u32x4*)(lds + L2_Y + ll * YP + lane * 16);
        float a[8] = {bf_lo(v.x), bf_hi(v.x), bf_lo(v.y), bf_hi(v.y), bf_lo(v.z), bf_hi(v.z), bf_lo(v.w), bf_hi(v.w)};
        float ss = 0.f;
#pragma unroll
        for (int k = 0; k < 8; ++k) ss += a[k] * a[k];
        const float rstd = rsqrtf_(wave_sum(ss) * (1.f / 512.f) + EPS);
        u32x4 o; o.x = cvt_pk_bf16(a[0] * rstd * nw0.x, a[1] * rstd * nw0.y); o.y = cvt_pk_bf16(a[2] * rstd * nw0.z, a[3] * rstd * nw0.w);
        o.z = cvt_pk_bf16(a[4] * rstd * nw1.x, a[5] * rstd * nw1.y); o.w = cvt_pk_bf16(a[6] * rstd * nw1.z, a[7] * rstd * nw1.w);
        *(u32x4*)(CAT + (size_t)(row0 + ll) * DM + 1024 + g * 512 + 8 * lane) = o;
    }
    __syncthreads();
}
__device__ __forceinline__ void attn_post(const Ptrs& P, int gw, int NGW) {
    int tq_ = threadIdx.x; asm volatile("" : "+v"(tq_)); const int lane = tq_ & 63;
    float d1 = 0.f, d2 = 0.f;
    for (int i = 0; i < 64; ++i) { d1 += P.in[4][i] * P.in[5][i]; d2 += P.in[6][i] * P.in[7][i]; }
    const float lam = expf(d1) - expf(d2) + LAM_INIT;
    const bf16_t* ATT = (const bf16_t*)(P.ws + WS_ATT); bf16_t* CAT = (bf16_t*)(P.ws + WS_CAT);
    const float* sw = P.in[8] + (lane & 7) * 16;
    float swv[16];
#pragma unroll
    for (int i = 0; i < 16; ++i) swv[i] = sw[i] * (1.0f - LAM_INIT);
    for (int t0 = gw; t0 < NTOK; t0 += 4 * NGW) {
        u32x4 ld[4][4];
#pragma unroll
        for (int k = 0; k < 4; ++k) { const int t = t0 + k * NGW; if (t < NTOK) {
            const u32x4* p0 = (const u32x4*)(ATT + (size_t)t * 2048 + lane * 16); const u32x4* p1 = (const u32x4*)(ATT + (size_t)t * 2048 + 1024 + lane * 16);
            ld[k][0] = p0[0]; ld[k][1] = p0[1]; ld[k][2] = p1[0]; ld[k][3] = p1[1]; } }
#pragma unroll
        for (int k = 0; k < 4; ++k) { const int t = t0 + k * NGW; if (t < NTOK) {
            const u32x4 a0 = ld[k][0], a1 = ld[k][1], b0 = ld[k][2], b1 = ld[k][3];
            float a[16];
            a[0] = bf_lo(a0.x) - lam * bf_lo(b0.x); a[1] = bf_hi(a0.x) - lam * bf_hi(b0.x); a[2] = bf_lo(a0.y) - lam * bf_lo(b0.y); a[3] = bf_hi(a0.y) - lam * bf_hi(b0.y);
            a[4] = bf_lo(a0.z) - lam * bf_lo(b0.z); a[5] = bf_hi(a0.z) - lam * bf_hi(b0.z); a[6] = bf_lo(a0.w) - lam * bf_lo(b0.w); a[7] = bf_hi(a0.w) - lam * bf_hi(b0.w);
            a[8] = bf_lo(a1.x) - lam * bf_lo(b1.x); a[9] = bf_hi(a1.x) - lam * bf_hi(b1.x); a[10] = bf_lo(a1.y) - lam * bf_lo(b1.y); a[11] = bf_hi(a1.y) - lam * bf_hi(b1.y);
            a[12] = bf_lo(a1.z) - lam * bf_lo(b1.z); a[13] = bf_hi(a1.z) - lam * bf_hi(b1.z); a[14] = bf_lo(a1.w) - lam * bf_lo(b1.w); a[15] = bf_hi(a1.w) - lam * bf_hi(b1.w);
            float ss = 0.f;
#pragma unroll
            for (int i = 0; i < 16; ++i) ss += a[i] * a[i];
            ss += __shfl_xor(ss, 1); ss += __shfl_xor(ss, 2); ss += __shfl_xor(ss, 4);
            const float rstd = rsqrtf_(ss * (1.f / 128.f) + EPS);
            float o[16];
#pragma unroll
            for (int i = 0; i < 16; ++i) o[i] = a[i] * rstd * swv[i];
            u32x4 w0, w1;
            w0.x = cvt_pk_bf16(o[0], o[1]); w0.y = cvt_pk_bf16(o[2], o[3]); w0.z = cvt_pk_bf16(o[4], o[5]); w0.w = cvt_pk_bf16(o[6], o[7]);
            w1.x = cvt_pk_bf16(o[8], o[9]); w1.y = cvt_pk_bf16(o[10], o[11]); w1.z = cvt_pk_bf16(o[12], o[13]); w1.w = cvt_pk_bf16(o[14], o[15]);
            u32x4* op = (u32x4*)(CAT + (size_t)t * DM + lane * 16); op[0] = w0; op[1] = w1; } }
    }
}
constexpr int R_RED = 0, R_SSQ = 8 * 4096, R_LOG = R_SSQ + 8 * 128, R_RSTD = R_LOG + 4096;
__device__ __forceinline__ void router_tile(const Ptrs& P, LAS unsigned char* lds, int tile) {
    int tid = threadIdx.x; asm volatile("" : "+v"(tid));
    const int lane = tid & 63, wid = __builtin_amdgcn_readfirstlane(tid >> 6), tt = lane & 31, kk = lane >> 5;
    unsigned char* ws = P.ws;
    const bf16_t* X1 = (const bf16_t*)(ws + WS_X1); bf16_t* H2 = (bf16_t*)(ws + WS_H2);
    const float* nw = P.in[16]; const float* rw = P.in[17]; const float* rb = P.in[18];
    int* TOPE = (int*)(ws + WS_ROUTE + RT_TOPE); float* TOPG = (float*)(ws + WS_ROUTE + RT_TOPG); int* LRANK = (int*)(ws + WS_ROUTE + RT_LRANK); int* HIST = (int*)(ws + WS_ROUTE + RT_HIST);
    LAS int* lhist = (LAS int*)(lds + LHIST_OFF);
    LAS float* red = (LAS float*)(lds + R_RED); LAS float* ssqp = (LAS float*)(lds + R_SSQ); LAS float* slog = (LAS float*)(lds + R_LOG); LAS float* srstd = (LAS float*)(lds + R_RSTD);
    const int t0 = tile * 32;
    if (tid < 32) lhist[tid] = 0;
    {
        f32x16 acc = f32x16{}; float ssq = 0.f;
        const int r32 = tt, hi = kk;
        const bf16_t* xp = X1 + (size_t)(t0 + r32) * DM + wid * 256 + 8 * hi;
        const float* wp = rw + (size_t)(wid * 256 + 8 * hi) * 32 + r32;
        const float* np = nw + wid * 256 + 8 * hi;
#pragma unroll 4
        for (int i = 0; i < 16; ++i) {
            const u32x4 xa = *(const u32x4*)(xp + 16 * i);
            const f32x4 n0 = *(const f32x4*)(np + 16 * i), n1 = *(const f32x4*)(np + 16 * i + 4);
            float w[8];
#pragma unroll
            for (int jx = 0; jx < 8; ++jx) w[jx] = wp[(16 * i + jx) * 32];
            w[0] *= n0.x; w[1] *= n0.y; w[2] *= n0.z; w[3] *= n0.w; w[4] *= n1.x; w[5] *= n1.y; w[6] *= n1.z; w[7] *= n1.w;
            u32x4 wh, wl;
            wh.x = cvt_pk_bf16(w[0], w[1]); wh.y = cvt_pk_bf16(w[2], w[3]); wh.z = cvt_pk_bf16(w[4], w[5]); wh.w = cvt_pk_bf16(w[6], w[7]);
            wl.x = cvt_pk_bf16(w[0] - bf_lo(wh.x), w[1] - bf_hi(wh.x)); wl.y = cvt_pk_bf16(w[2] - bf_lo(wh.y), w[3] - bf_hi(wh.y));
            wl.z = cvt_pk_bf16(w[4] - bf_lo(wh.z), w[5] - bf_hi(wh.z)); wl.w = cvt_pk_bf16(w[6] - bf_lo(wh.w), w[7] - bf_hi(wh.w));
            const bf16x8 af = __builtin_bit_cast(bf16x8, xa);
            acc = __builtin_amdgcn_mfma_f32_32x32x16_bf16(af, __builtin_bit_cast(bf16x8, wh), acc, 0, 0, 0);
            acc = __builtin_amdgcn_mfma_f32_32x32x16_bf16(af, __builtin_bit_cast(bf16x8, wl), acc, 0, 0, 0);
            const float x0 = bf_lo(xa.x), x1 = bf_hi(xa.x), x2 = bf_lo(xa.y), x3 = bf_hi(xa.y), x4 = bf_lo(xa.z), x5 = bf_hi(xa.z), x6 = bf_lo(xa.w), x7 = bf_hi(xa.w);
            ssq += ((x0 * x0 + x1 * x1) + (x2 * x2 + x3 * x3)) + ((x4 * x4 + x5 * x5) + (x6 * x6 + x7 * x7));
        }
        ssq += __shfl_xor(ssq, 32);
        if (kk == 0) ssqp[wid * 32 + tt] = ssq;
#pragma unroll
        for (int r = 0; r < 16; ++r) red[wid * 1024 + crow16(r, kk) * 32 + tt] = acc[r];
    }
    __syncthreads();
    if (tid < 32) { float s = 0.f;
#pragma unroll
        for (int w = 0; w < 8; ++w) s += ssqp[w * 32 + tid];
        srstd[tid] = rsqrtf_(s * (1.f / DM) + EPS); }
    __syncthreads();
    for (int q = tid; q < 1024; q += 512) { float s = 0.f;
#pragma unroll
        for (int w = 0; w < 8; ++w) s += red[w * 1024 + q];
        slog[q] = s * srstd[q >> 5] + rb[q & 31]; }
    __syncthreads();
#pragma unroll
    for (int it = 0; it < 2; ++it) {
        const int tl = wid * 4 + it * 2 + kk, t = t0 + tl;
        float v = slog[tl * 32 + tt];
        float tv[4]; int te[4];
#pragma unroll
        for (int j = 0; j < 4; ++j) {
            float bv = v; int be = tt;
#pragma unroll
            for (int o = 1; o < 32; o <<= 1) { const float ov = __shfl_xor(bv, o); const int oe = __shfl_xor(be, o); const bool take = (ov > bv) || (ov == bv && oe < be); bv = take ? ov : bv; be = take ? oe : be; }
            tv[j] = bv; te[j] = be; if (tt == be) v = -INFINITY;
        }
        const float e1 = fexp(tv[1] - tv[0]), e2 = fexp(tv[2] - tv[0]), e3 = fexp(tv[3] - tv[0]); const float inv = 1.f / (1.f + e1 + e2 + e3);
        if (tt < 4) {
            const int ej = tt == 0 ? te[0] : tt == 1 ? te[1] : tt == 2 ? te[2] : te[3];
            const float gj = (tt == 0 ? 1.f : tt == 1 ? e1 : tt == 2 ? e2 : e3) * inv;
            const int lr = atomicAdd((int*)(lhist + ej), 1);
            TOPE[t * 4 + tt] = ej; TOPG[t * 4 + tt] = gj; LRANK[t * 4 + tt] = lr;
        }
    }
    {
        u32x2 xb[4][8]; f32x4 wv[8];
#pragma unroll
        for (int q = 0; q < 8; ++q) wv[q] = ((const f32x4*)nw)[lane + 64 * q];
#pragma unroll
        for (int r = 0; r < 4; ++r)
#pragma unroll
            for (int q = 0; q < 8; ++q) xb[r][q] = ((const u32x2*)(X1 + (size_t)(t0 + wid * 4 + r) * DM))[lane + 64 * q];
#pragma unroll
        for (int r = 0; r < 4; ++r) {
            const int tl = wid * 4 + r; const float rs = srstd[tl];
            u32x2* o8 = (u32x2*)(H2 + (size_t)(t0 + tl) * DM) + lane;
#pragma unroll
            for (int q = 0; q < 8; ++q) { const f32x4 x = (f32x4){bf_lo(xb[r][q].x), bf_hi(xb[r][q].x), bf_lo(xb[r][q].y), bf_hi(xb[r][q].y)}; u32x2 o; o.x = cvt_pk_bf16(x.x * rs * wv[q].x, x.y * rs * wv[q].y); o.y = cvt_pk_bf16(x.z * rs * wv[q].z, x.w * rs * wv[q].w); o8[64 * q] = o; }
        }
    }
    __syncthreads();
    if (tid < 32) HIST[tile * 32 + tid] = lhist[tid];
    __syncthreads();
}
__device__ __forceinline__ void route_positions(const Ptrs& P, LAS unsigned char* lds, int tile) {
    unsigned char* ws = P.ws; const int tid = threadIdx.x;
    const int* HIST = (const int*)(ws + WS_ROUTE + RT_HIST); const int* TOPE = (const int*)(ws + WS_ROUTE + RT_TOPE); const int* LRANK = (const int*)(ws + WS_ROUTE + RT_LRANK);
    int* TOKPOS = (int*)(ws + WS_ROUTE + RT_TOKPOS); int* META = (int*)(ws + WS_ROUTE + RT_META); int* ROWTOK = (int*)(ws + WS_ROUTE + RT_ROWTOK);
    LAS int* sh = (LAS int*)lds;
    LAS int* stot = sh + 8192; LAS int* sbase = stot + 32; LAS int* sseg = sbase + 32;
    __syncthreads();
    for (int i = tid; i < 8192; i += 512) sh[i] = HIST[i];
    __syncthreads();
    if (tid < 32) { int tot = 0, base = 0; for (int i = 0; i < 256; ++i) { const int v = sh[i * 32 + tid]; if (i < tile) base += v; tot += v; } stot[tid] = tot; sbase[tid] = base; }
    __syncthreads();
    if (tid == 0) { int s = 0; for (int e = 0; e < 32; ++e) { sseg[e] = s; s += (stot[e] + 255) & ~255; } sseg[32] = s; }
    __syncthreads();
    if (tid < 128) { const int t = tile * 32 + (tid >> 2), j = tid & 3; const int e = TOPE[t * 4 + j]; const int pos = sseg[e] + sbase[e] + LRANK[t * 4 + j]; ROWTOK[pos] = t; TOKPOS[t * 4 + j] = pos; }
    if (tile < 32) { const int e = tile; for (int p = stot[e] + tid; p < ((stot[e] + 255) & ~255); p += 512) ROWTOK[sseg[e] + p] = 0; }
    if (tile == 0) {
        if (tid < 33) META[META_SEG + tid] = sseg[tid];
        if (tid == 0) META[META_NT] = sseg[32] >> 8;
        if (tid < 32) { const int e = tid; for (int T = sseg[e] >> 8; T < (sseg[e + 1] >> 8); ++T) META[META_TILE_E + T] = e; }
    }
    __syncthreads();
}
__device__ __forceinline__ void final_rows(const Ptrs& P, int gw, int NGW) {
    int tq_ = threadIdx.x; asm volatile("" : "+v"(tq_)); const int lane = tq_ & 63;
    unsigned char* ws = P.ws;
    const bf16_t* X1 = (const bf16_t*)(ws + WS_X1); const bf16_t* YS = (const bf16_t*)(ws + WS_YS);
    const int* TOKPOS = (const int*)(ws + WS_ROUTE + RT_TOKPOS); const float* TOPG = (const float*)(ws + WS_ROUTE + RT_TOPG);
    const float* nw = P.in[23];
    for (int t = gw; t < NTOK; t += NGW) {
        f32x4 v[8];
#pragma unroll
        for (int q = 0; q < 8; ++q) { const u32x2 xb = ((const u32x2*)(X1 + (size_t)t * DM))[lane + 64 * q]; v[q] = (f32x4){bf_lo(xb.x), bf_hi(xb.x), bf_lo(xb.y), bf_hi(xb.y)}; }
#pragma unroll
        for (int j = 0; j < 4; ++j) {
            const int pos = TOKPOS[t * 4 + j]; const float gj = TOPG[t * 4 + j];
            const u32x2* yr = (const u32x2*)(YS + (size_t)pos * DM);
#pragma unroll
            for (int q = 0; q < 8; ++q) { const u32x2 y = yr[lane + 64 * q]; v[q].x += gj * bf_lo(y.x); v[q].y += gj * bf_hi(y.x); v[q].z += gj * bf_lo(y.y); v[q].w += gj * bf_hi(y.y); }
        }
        float s = 0.f;
#pragma unroll
        for (int q = 0; q < 8; ++q) s += (v[q].x * v[q].x + v[q].y * v[q].y) + (v[q].z * v[q].z + v[q].w * v[q].w);
        const float rstd = 1.0f / sqrtf(wave_sum(s) * (1.f / DM) + EPS);
#pragma unroll
        for (int q = 0; q < 8; ++q) { const f32x4 w = ((const f32x4*)nw)[lane + 64 * q]; ((f32x4*)(P.out + (size_t)t * DM))[lane + 64 * q] = v[q] * rstd * w; }
    }
}

constexpr int NPHASE = 12;
struct Args { Ptrs p; int ph_lo, ph_hi; };
__global__ void __launch_bounds__(NWAVES * 64, 2) hybrid_fwd(Args args) {
    extern __shared__ __attribute__((aligned(16))) unsigned char lds_raw[];
    LAS unsigned char* lds = (LAS unsigned char*)lds_raw;
    const int tid = threadIdx.x, wave = __builtin_amdgcn_readfirstlane(tid >> 6);
    const int G = gridDim.x; const int bx = blockIdx.x; const int vcu = (G % 8 == 0) ? (bx % 8) * (G / 8) + bx / 8 : bx;
    const Ptrs& P = args.p; unsigned char* ws = P.ws;
    unsigned* ctl = (unsigned*)(ws + WS_CTL);
    for (int u = tid; u < (LDS_BYTES - LDSCTL_OFF) / 4; u += NWAVES * 64) ((LAS unsigned*)(lds + LDSCTL_OFF))[u] = 0u;
    __syncthreads();
    volatile LAS unsigned* MISC = (volatile LAS unsigned*)(lds + MISC_OFF);
    XcdBarrier bar; bar.bar = ctl + CW_BAR; bar.x = 0; bar.st = nullptr;
    if (MK_N_LAUNCHES == 1) bar = xcd_barrier_post(ctl + CW_BAR, MISC + 8);
#define GRID_BAR() do { if (MK_N_LAUNCHES == 1) xcd_barrier(bar); } while (0)
    const int lo = args.ph_lo, hi_ = args.ph_hi;
#ifndef PHASE_MASK
#define PHASE_MASK 0xFFFF
#endif
#define IN(k) (((PHASE_MASK >> (k)) & 1) && lo <= (k) && (k) < hi_)
#define BOTH(k) (IN(k) && IN((k) + 1))
    const int gw = vcu * NWAVES + wave, NGW = G * NWAVES;

    if (IN(0)) { p0_prologue(P, lds, gw, NGW, wave); if (BOTH(0)) GRID_BAR(); }
    if (IN(1)) {
        pg8::SchedDense S; S.init(ws + WS_XN, ws + WS_WIN, NTOK, NPROJP, G, bx);
        pg8::EpiProj E{(bf16_t*)(ws + WS_PROJ), (float*)(ws + WS_DTRAW), (const float*)(ws + WS_ROPE)};
        pg8::gemm_phase<pg8::EpiProj, pg8::SchedDense>(lds, S, E);
        if (BOTH(1)) GRID_BAR();
    }
    if (IN(2)) {
        attn_body::attn_phase128((char*)lds_raw, (const bf16_t*)(ws + WS_PROJ), (bf16_t*)(ws + WS_ATT), G, vcu);
        __syncthreads();
    }
    if (IN(11)) {
        for (int u = vcu; u < NB * 16 * 2 * 2; u += G) { const int hh = u & 1, g = (u >> 1) & 1, c = (u >> 2) & 15, b = u >> 6; ssd_a_unit(P, lds, b, c, g, hh); }
        GRID_BAR();
    }
    if (IN(3)) { ssd_scan(P, vcu * 512 + tid, G * 512); if (BOTH(3)) GRID_BAR(); }
    if (IN(4)) {
#ifndef NO_SSDC
        for (int u = vcu; u < NB * 16 * 2 * 2; u += G) { const int rh = u & 1, g = (u >> 1) & 1, c = (u >> 2) & 15, b = u >> 6; ssd_c_unit(P, lds, b, c, g, rh); }
#endif
#ifndef NO_APOST
        attn_post(P, gw, NGW);
#endif
        if (BOTH(4)) GRID_BAR();
    }
    if (IN(5)) {
        pg8::SchedDense S; S.init(ws + WS_CAT, ws + WS_WOUT, NTOK, DM, G, bx);
        pg8::EpiRes E{P.in[0], (bf16_t*)(ws + WS_X1), DM};
        pg8::gemm_phase<pg8::EpiRes, pg8::SchedDense>(lds, S, E);
        if (BOTH(5)) GRID_BAR();
    }
    if (IN(6)) { for (int tile = vcu; tile < 256; tile += G) router_tile(P, lds, tile); if (BOTH(6)) GRID_BAR(); }
    if (IN(7)) { for (int tile = vcu; tile < 256; tile += G) route_positions(P, lds, tile); if (BOTH(7)) GRID_BAR(); }
    if (IN(8)) {
        const int* META = (const int*)(ws + WS_ROUTE + RT_META);
        typedef pg8::SchedMoeF<4096, 8192, true> SG;
        SG S; S.A = (const char*)(ws + WS_H2); S.W = P.in[19]; S.tile_e = META + META_TILE_E; S.rowtok = (const int*)(ws + WS_ROUTE + RT_ROWTOK);
        S.nT = META[META_NT]; S.nN = 16; S.G = G; S.c = vcu;
        pg8::EpiGate E{(bf16_t*)(ws + WS_ACT), P.in[20], ctl + CW_TCNT};
        pg8::gemm_phase_fb<pg8::EpiGate, SG, 4096, 8192, true>(lds, S, E);
        if (MK_N_LAUNCHES != 1 && BOTH(8)) GRID_BAR();
    }
    if (IN(9)) {
        const int* META = (const int*)(ws + WS_ROUTE + RT_META);
        typedef pg8::SchedMoeF<2048, 512, false> SD;
        SD S; S.A = (const char*)(ws + WS_ACT); S.W = P.in[21]; S.tile_e = META + META_TILE_E; S.rowtok = nullptr;
        S.nT = META[META_NT]; S.nN = 8; S.G = G;
        { const int r8 = ((S.nT * 16) % G) & ~31; S.c = (MK_N_LAUNCHES == 1) ? (vcu - r8 + G) % G : vcu; }
        pg8::EpiDown E{(bf16_t*)(ws + WS_YS), P.in[22]};
        pg8::gemm_phase_fb<pg8::EpiDown, SD, 2048, 512, false, MK_N_LAUNCHES == 1>(lds, S, E, ctl + CW_TCNT, 128u);
        if (BOTH(9)) GRID_BAR();
    }
    if (IN(10)) { final_rows(P, gw, NGW); }
#undef IN
#undef BOTH
#undef GRID_BAR
}

extern "C" void kernel_launch(void* const* d_in, const int* in_sizes, int n_in, void* d_out, int out_size, void* d_ws, size_t ws_size, hipStream_t stream) {
    static int grid = 0;
    if (grid == 0) {
        if (n_in != 24 || out_size != NTOK * DM || ws_size < WS_END) { fprintf(stderr, "kernel_launch: unexpected shapes (n_in %d, out %d, ws %zu)\n", n_in, out_size, ws_size); grid = -1; return; }
        int dev = 0, cus = 0, per_cu = 0;
        if (hipGetDevice(&dev) != hipSuccess || hipDeviceGetAttribute(&cus, hipDeviceAttributeMultiprocessorCount, dev) != hipSuccess) { grid = -1; return; }
        if (hipFuncSetAttribute((const void*)hybrid_fwd, hipFuncAttributeMaxDynamicSharedMemorySize, LDS_BYTES) != hipSuccess) { fprintf(stderr, "kernel_launch: hipFuncSetAttribute failed\n"); grid = -1; return; }
        if (hipOccupancyMaxActiveBlocksPerMultiprocessor(&per_cu, (const void*)hybrid_fwd, NWAVES * 64, LDS_BYTES) != hipSuccess || per_cu < 1) { fprintf(stderr, "kernel_launch: occupancy query says %d\n", per_cu); }
        (void)hipGetLastError();
        grid = cus;
    }
    if (grid < 0) return;
    (void)hipMemsetAsync((char*)d_ws + WS_CTL, 0, CTL_ZERO_BYTES, stream);
    Args a{};
    for (int i = 0; i < 24; ++i) a.p.in[i] = (const float*)d_in[i];
    a.p.out = (float*)d_out; a.p.ws = (unsigned char*)d_ws;
    if (MK_N_LAUNCHES == 1) {
        a.ph_lo = 0; a.ph_hi = NPHASE;
        hipLaunchKernelGGL(hybrid_fwd, dim3(grid), dim3(NWAVES * 64), LDS_BYTES, stream, a);
    } else {
        static const int order[NPHASE] = {0, 1, 2, 11, 3, 4, 5, 6, 7, 8, 9, 10};
        for (int q = 0; q < NPHASE; ++q) {
            const int ph = order[q];
            a.ph_lo = ph; a.ph_hi = ph + 1; hipLaunchKernelGGL(hybrid_fwd, dim3(grid), dim3(NWAVES * 64), LDS_BYTES, stream, a);
#if defined(PROBE_PHASE)
            if (ph == PROBE_PHASE) hipLaunchKernelGGL(hybrid_fwd, dim3(grid), dim3(NWAVES * 64), LDS_BYTES, stream, a);
#endif
        }
    }
}
```

```cpp
#include <hip/hip_runtime.h>
#include <hip/hip_bf16.h>
#include <cstdio>
#include <cstdint>
#include <cmath>

#ifndef MK_N_LAUNCHES
#define MK_N_LAUNCHES 1
#endif

#define LAS __attribute__((address_space(3)))
#define GAS __attribute__((address_space(1)))
typedef unsigned short bf16_t;
typedef short bf16x8 __attribute__((ext_vector_type(8)));
typedef float f32x2 __attribute__((ext_vector_type(2)));
typedef float f32x4 __attribute__((ext_vector_type(4)));
typedef float f32x16 __attribute__((ext_vector_type(16)));
typedef unsigned u32x2 __attribute__((ext_vector_type(2)));
typedef unsigned u32x4 __attribute__((ext_vector_type(4)));

constexpr int NB = 4, SEQ = 2048, NTOK = NB * SEQ, DM = 2048;
constexpr int NPROJ = 5648, NPROJP = 5888;
constexpr int C_Q = 0, C_K = 1024, C_V = 2048, C_Z = 3072, C_XBC = 4096, C_DT = 5632;
constexpr int NEXP = 32, FFD = 2048, MAXROWS = 40960, MAXTILES = 160;
constexpr float EPS = 1e-5f;
constexpr float ATT_C2 = 0.125f * 1.4426950408889634f;
constexpr float LAM_INIT = 0.2f;

constexpr size_t MiB = 1u << 20;
constexpr size_t WS_CTL = 0, CTL_ZERO_BYTES = 1 * MiB;
constexpr size_t WS_WIN = 2 * MiB;
constexpr size_t WS_WOUT = 26 * MiB;
constexpr size_t WS_ROPE = 34 * MiB;
constexpr size_t WS_DTRAW = 34 * MiB + 512 * 1024;
constexpr size_t WS_CS = 35 * MiB;
constexpr size_t WS_ROUTE = 36 * MiB;
constexpr size_t WS_XN = 40 * MiB;
constexpr size_t WS_PROJ = 72 * MiB;
constexpr size_t WS_ATT = 164 * MiB;
constexpr size_t WS_YDIAG = 196 * MiB;
constexpr size_t WS_STATES = 228 * MiB;
constexpr size_t WS_XCONV = 260 * MiB;
constexpr size_t WS_CCONV = 276 * MiB;
constexpr size_t WS_CAT = 280 * MiB;
constexpr size_t WS_X1 = 312 * MiB;
constexpr size_t WS_H2 = 376 * MiB;
constexpr size_t WS_ACT = 408 * MiB;
constexpr size_t WS_YS = 568 * MiB;
constexpr size_t WS_WGU = 728 * MiB;
constexpr size_t WS_YS2 = 728 * MiB;
constexpr size_t WS_WD = 1240 * MiB;
constexpr size_t WS_END = 1496 * MiB;
constexpr size_t RT_TOPE = 0, RT_TOPG = 128 * 1024, RT_LRANK = 256 * 1024, RT_TOKPOS = 384 * 1024, RT_HIST = 512 * 1024, RT_META = 544 * 1024, RT_ROWTOK = 576 * 1024;
constexpr int META_SEG = 0, META_NT = 40, META_TILE_E = 48;
constexpr int CW_BAR = 4096;
constexpr int CW_TCNT = 16384;

constexpr int RING_BYTES = 131072;
constexpr int LDSCTL_OFF = RING_BYTES, MISC_OFF = LDSCTL_OFF + 320;
constexpr int LHIST_OFF = LDSCTL_OFF + 1024;
constexpr int BIAS_OFF = LDSCTL_OFF + 2048 + 8192;
constexpr int VAN_OFF = LDSCTL_OFF + 2048;
constexpr int LDS_BYTES = 147456;
constexpr int NWAVES = 8;

__device__ __forceinline__ unsigned cvt_pk_bf16(float lo, float hi) { unsigned r; asm volatile("v_cvt_pk_bf16_f32 %0, %1, %2" : "=v"(r) : "v"(lo), "v"(hi)); return r; }
__device__ __forceinline__ float bf_lo(unsigned w) { return __uint_as_float(w << 16); }
__device__ __forceinline__ float bf_hi(unsigned w) { return __uint_as_float(w & 0xffff0000u); }
__device__ __forceinline__ float bf2f(bf16_t h) { return __uint_as_float((unsigned)h << 16); }
__device__ __forceinline__ bf16_t f2bf(float f) { return (bf16_t)(cvt_pk_bf16(f, 0.f) & 0xffffu); }
__device__ __forceinline__ float wave_sum(float v) {
#pragma unroll
    for (int o = 1; o < 64; o <<= 1) v += __shfl_xor(v, o);
    return v;
}
__device__ __forceinline__ float sigmoidf_(float x) { return __builtin_amdgcn_rcpf(1.f + __builtin_amdgcn_exp2f(-1.4426950408889634f * x)); }
__device__ __forceinline__ float rsqrtf_(float x) { return __builtin_amdgcn_rsqf(x); }
__device__ __forceinline__ float fexp(float x) { return __builtin_amdgcn_exp2f(1.4426950408889634f * x); }
#define LDS_WAIT() asm volatile("s_waitcnt lgkmcnt(0)" ::: "memory")
#define VM_WAIT() asm volatile("s_waitcnt vmcnt(0)" ::: "memory")

__device__ __forceinline__ const char* uni(const char* p) { const unsigned long long v = (unsigned long long)p; const unsigned lo = __builtin_amdgcn_readfirstlane((unsigned)v), hi = __builtin_amdgcn_readfirstlane((unsigned)(v >> 32)); return (const char*)(((unsigned long long)hi << 32) | lo); }
namespace pg8 {
constexpr int BM = 256, BK = 64, HALF = 128, HTB = HALF * BK * 2, STAGE_BYTES = 8 * HTB, NXCD = 8, WGM = 8, KD = 2048, NKT = KD / BK;
__host__ __device__ __forceinline__ int lds_byte(int r, int c) { const int st = (r >> 4) * 2 + (c >> 5), rr = r & 15, cc = c & 31, ob = rr * 64 + cc * 2; return st * 1024 + (ob ^ (((ob >> 9) & 1) << 5)); }
__host__ __device__ __forceinline__ void stage_rc(int b, int& R, int& C) { const int st = b / 1024, sb = b % 1024, swz = sb ^ (((sb >> 9) & 1) << 5); R = (st >> 1) * 16 + swz / 64; C = (st & 1) * 32 + (swz % 64) / 2; }
__host__ __device__ __forceinline__ int perm32(int rho) { const int n = rho >> 4, i = rho & 15; return 8 * (i >> 2) + 4 * n + (i & 3); }

struct Unit { const char* a; const char* b0; const char* b1; int pm, pn, e; };
struct UnitF { const char* a; const char* b; int pm, pn, e, nk, kh; };

struct SchedDense {
    const char* A; const char* Bt; int nM, nN, nwg, G, c;
    __device__ __forceinline__ void init(const void* A_, const void* Bt_, int M, int N, int G_, int c_) { A = (const char*)A_; Bt = (const char*)Bt_; nM = M / BM; nN = N / BM; nwg = nM * nN; G = G_; c = c_; }
    __device__ __forceinline__ bool get(int i, Unit& u) const {
        const long L = (long)i * G + c; if (L >= nwg) return false;
        int wgid = (int)L; { const int q = nwg / NXCD, r = nwg % NXCD, xcd = wgid % NXCD, off = wgid / NXCD; wgid = (xcd < r ? xcd * (q + 1) : r * (q + 1) + (xcd - r) * q) + off; }
        const int nig = WGM * nN, gid = wgid / nig, fm = gid * WGM, gsz = (nM - fm) < WGM ? (nM - fm) : WGM;
        u.pm = fm + ((wgid % nig) % gsz); u.pn = (wgid % nig) / gsz; u.e = 0;
        u.a = A; u.b0 = Bt + (size_t)u.pn * BM * KD * 2; u.b1 = u.b0 + (size_t)HALF * KD * 2; return true;
    }
    __device__ __forceinline__ unsigned aoff(const Unit& u, int h, int R, int C) const { return (unsigned)(((u.pm * BM + h * HALF + R) * KD + C) * 2); }
};
struct SchedMoe {
    const char* A; const char* Bt; const int* tile_e; const int* rowtok; int nT, nN, G, c; bool gu;
    __device__ __forceinline__ bool get(int i, Unit& u) const {
        const long L = (long)i * G + c; const int NU = nT * nN; if (L >= NU) return false;
        const int nTb = nT >> 2, full = nTb * 4 * nN; int T, nt;
        if ((int)L < full) { const int blk = (int)L >> 5, w = (int)L & 31, nb = nN >> 3, tb = blk / nb, nbk = blk % nb; T = tb * 4 + (w & 3); nt = nbk * 8 + (w >> 2); }
        else { const int Lp = (int)L - full, rT = nT & 3; T = nTb * 4 + Lp % rT; nt = Lp / rT; }
        const int e = tile_e[T]; u.pm = T; u.pn = nt; u.e = e; u.a = A;
        if (gu) { u.b0 = Bt + ((size_t)e * 4096 + (size_t)nt * 128) * KD * 2; u.b1 = u.b0 + (size_t)2048 * KD * 2; }
        else    { u.b0 = Bt + ((size_t)e * 2048 + (size_t)nt * 256) * KD * 2; u.b1 = u.b0 + (size_t)HALF * KD * 2; }
        return true;
    }
    __device__ __forceinline__ unsigned aoff(const Unit& u, int h, int R, int C) const { int row = u.pm * BM + h * HALF + R; if (rowtok) row = rowtok[row]; return (unsigned)((row * KD + C) * 2); }
};

struct EpiProj {
    static constexpr bool PERM = true;
    bf16_t* P; float* dtraw; const float* rope;
    __device__ __forceinline__ void operator()(const f32x4 (&acc)[2][2][4][2], const Unit& u, int wr, int wc, int fr, int fq) const {
        const int row0 = u.pm * BM + wr * 64 + fr;
        if (u.pn == 22) {
            if (wc == 0 && fq < 2) {
#pragma unroll
                for (int ai = 0; ai < 2; ++ai)
#pragma unroll
                    for (int m = 0; m < 4; ++m) { float* d = dtraw + (size_t)(row0 + ai * HALF + m * 16) * 16 + 8 * fq; *(f32x4*)d = acc[ai][0][m][0]; *(f32x4*)(d + 4) = acc[ai][0][m][1]; }
            }
            return;
        }
        const bool ropet = (u.pn < 8) && ((wc & 1) == 0);
        const float qs = (u.pn < 4) ? ATT_C2 : 1.f;
        const int col0 = u.pn * BM + wc * 32 + 8 * fq;
#pragma unroll
        for (int ai = 0; ai < 2; ++ai)
#pragma unroll
            for (int m = 0; m < 4; ++m) {
                const int row = row0 + ai * HALF + m * 16;
                f32x4 v[2][2];
#pragma unroll
                for (int bj = 0; bj < 2; ++bj)
#pragma unroll
                    for (int n = 0; n < 2; ++n) v[bj][n] = acc[ai][bj][m][n];
                if (ropet) {
                    const float* rp = rope + (size_t)row * 16;
                    const f32x4 c0 = *(const f32x4*)rp, c1 = *(const f32x4*)(rp + 4), s0 = *(const f32x4*)(rp + 8), s1 = *(const f32x4*)(rp + 12);
#pragma unroll
                    for (int bj = 0; bj < 2; ++bj)
#pragma unroll
                        for (int n = 0; n < 2; ++n)
#pragma unroll
                            for (int j = 0; j < 4; ++j) {
                                const float x = v[bj][n][j], o = __shfl_xor(x, 16);
                                const float cc = n ? c1[j] : c0[j], ss = n ? s1[j] : s0[j];
                                const float r = (fq == 0) ? (x * cc - o * ss) : (x * cc + o * ss);
                                v[bj][n][j] = (fq < 2) ? r : x;
                            }
                }
                bf16_t* rowp = P + (size_t)row * NPROJP + col0;
#pragma unroll
                for (int bj = 0; bj < 2; ++bj) {
                    const f32x4 v0 = v[bj][0] * qs, v1 = v[bj][1] * qs; u32x4 w;
                    w.x = cvt_pk_bf16(v0[0], v0[1]); w.y = cvt_pk_bf16(v0[2], v0[3]); w.z = cvt_pk_bf16(v1[0], v1[1]); w.w = cvt_pk_bf16(v1[2], v1[3]);
                    *(u32x4*)(rowp + bj * HALF) = w;
                }
            }
    }
};
struct EpiRes {
    static constexpr bool PERM = false;
    const float* base; bf16_t* out; int ldc;
    __device__ __forceinline__ void operator()(const f32x4 (&acc)[2][2][4][2], const Unit& u, int wr, int wc, int fr, int fq) const {
        const int row0 = u.pm * BM + wr * 64 + fr, col0 = u.pn * BM + wc * 32 + 4 * fq;
#pragma unroll
        for (int ai = 0; ai < 2; ++ai)
#pragma unroll
            for (int m = 0; m < 4; ++m) { const size_t off = (size_t)(row0 + ai * HALF + m * 16) * ldc + col0;
#pragma unroll
                for (int bj = 0; bj < 2; ++bj)
#pragma unroll
                    for (int n = 0; n < 2; ++n) { const f32x4 v = *(const f32x4*)(base + off + bj * HALF + n * 16) + acc[ai][bj][m][n]; u32x2 w; w.x = cvt_pk_bf16(v[0], v[1]); w.y = cvt_pk_bf16(v[2], v[3]); *(u32x2*)(out + off + bj * HALF + n * 16) = w; } }
    }
};
struct EpiGate {
    static constexpr bool PERM = true;
    bf16_t* O; const float* bgu;
    unsigned* cnt;
    __device__ __forceinline__ unsigned bias_off(const UnitF& u, int wc, int idx) const { const int fq = idx >> 4, k = (idx >> 2) & 3, cp = idx & 3; return (unsigned)((u.e * 4096 + (k >> 1) * 2048 + u.pn * 128 + wc * 32 + 8 * fq + 4 * (k & 1) + cp) * 4); }
    __device__ __forceinline__ const char* bias_base() const { return (const char*)bgu; }
    __device__ __forceinline__ void operator()(const f32x4 (&acc)[2][2][4][2], const Unit& u, int wr, int wc, int fr, int fq, const LAS float* bl = nullptr) const {
        const int row0 = u.pm * BM + wr * 64 + fr, colg = u.pn * 128 + wc * 32 + 8 * fq;
        f32x4 bg[2], bu[2];
        if (bl) { const LAS f32x4* q = (const LAS f32x4*)bl + fq * 4; bg[0] = q[0]; bg[1] = q[1]; bu[0] = q[2]; bu[1] = q[3]; }
        else { const float* bp = bgu + (size_t)u.e * 4096 + colg;
#pragma unroll
            for (int n = 0; n < 2; ++n) { bg[n] = *(const f32x4*)(bp + 4 * n); bu[n] = *(const f32x4*)(bp + 2048 + 4 * n); } }
        const __amdgpu_buffer_rsrc_t rsrc = __builtin_amdgcn_make_buffer_rsrc((void*)O, 0, MAXROWS * FFD * 2, 0x00020000);
#pragma unroll
        for (int ai = 0; ai < 2; ++ai)
#pragma unroll
            for (int m = 0; m < 4; ++m) {
                float a[8];
#pragma unroll
                for (int n = 0; n < 2; ++n)
#pragma unroll
                    for (int j = 0; j < 4; ++j) {
                        float g = acc[ai][0][m][n][j] + bg[n][j], up = acc[ai][1][m][n][j] + bu[n][j];
                        g = fminf(g, 7.0f); up = fminf(fmaxf(up, -7.0f), 7.0f);
                        a[4 * n + j] = g * sigmoidf_(1.702f * g) * (up + 1.0f);
                    }
                u32x4 w; w.x = cvt_pk_bf16(a[0], a[1]); w.y = cvt_pk_bf16(a[2], a[3]); w.z = cvt_pk_bf16(a[4], a[5]); w.w = cvt_pk_bf16(a[6], a[7]);
                __builtin_amdgcn_raw_buffer_store_b128(w, rsrc, (int)(((unsigned)(row0 + ai * HALF + m * 16) * FFD + colg) * 2u), 0, 16);
            }
        asm volatile("s_waitcnt vmcnt(0)" ::: "memory");
        if (fr == 0 && fq == 0) __hip_atomic_fetch_add(cnt + 64 * u.pm, 1u, __ATOMIC_RELAXED, __HIP_MEMORY_SCOPE_AGENT);
    }
};
struct EpiDown {
    static constexpr bool PERM = true;
    bf16_t* O; const float* bd;
    __device__ __forceinline__ unsigned bias_off(const UnitF& u, int wc, int idx) const { const int fq = idx >> 4, k = (idx >> 2) & 3, cp = idx & 3; return (unsigned)((u.e * DM + u.pn * BM + wc * 32 + 8 * fq + (k >> 1) * HALF + 4 * (k & 1) + cp) * 4); }
    __device__ __forceinline__ const char* bias_base() const { return (const char*)bd; }
    __device__ __forceinline__ void operator()(const f32x4 (&acc)[2][2][4][2], const Unit& u, int wr, int wc, int fr, int fq, const LAS float* bl = nullptr) const {
        const int row0 = u.pm * BM + wr * 64 + fr, col0 = u.pn * BM + wc * 32 + 8 * fq;
        f32x4 bv[2][2];
        if (bl) { const LAS f32x4* q = (const LAS f32x4*)bl + fq * 4; bv[0][0] = q[0]; bv[0][1] = q[1]; bv[1][0] = q[2]; bv[1][1] = q[3]; }
        else { const float* bp = bd + (size_t)u.e * DM + col0;
#pragma unroll
            for (int bj = 0; bj < 2; ++bj)
#pragma unroll
                for (int n = 0; n < 2; ++n) bv[bj][n] = *(const f32x4*)(bp + bj * HALF + 4 * n); }
#pragma unroll
        for (int ai = 0; ai < 2; ++ai)
#pragma unroll
            for (int m = 0; m < 4; ++m) { bf16_t* rowp = O + (size_t)(row0 + ai * HALF + m * 16) * DM + col0;
#pragma unroll
                for (int bj = 0; bj < 2; ++bj) { const f32x4 v0 = acc[ai][bj][m][0] + bv[bj][0], v1 = acc[ai][bj][m][1] + bv[bj][1]; u32x4 w;
                    w.x = cvt_pk_bf16(v0[0], v0[1]); w.y = cvt_pk_bf16(v0[2], v0[3]); w.z = cvt_pk_bf16(v1[0], v1[1]); w.w = cvt_pk_bf16(v1[2], v1[3]);
                    *(u32x4*)(rowp + bj * HALF) = w; } }
    }
};

struct EpiDownK {
    static constexpr bool PERM = true;
    bf16_t* O; bf16_t* O2; const float* bd;
    __device__ __forceinline__ unsigned bias_off(const UnitF& u, int wc, int idx) const { const int fq = idx >> 4, k = (idx >> 2) & 3, cp = idx & 3; return (unsigned)((u.e * DM + u.pn * BM + wc * 32 + 8 * fq + (k >> 1) * HALF + 4 * (k & 1) + cp) * 4); }
    __device__ __forceinline__ const char* bias_base() const { return (const char*)bd; }
    __device__ __forceinline__ void operator()(const f32x4 (&acc)[2][2][4][2], const Unit& u, int wr, int wc, int fr, int fq, const LAS float* bl) const {
        const int kh = __builtin_amdgcn_readfirstlane(u.e >> 8);
        const int row0 = u.pm * BM + wr * 64 + fr, col0 = u.pn * BM + wc * 32 + 8 * fq;
        f32x4 bv[2][2];
        { const LAS f32x4* q = (const LAS f32x4*)bl + fq * 4; bv[0][0] = q[0]; bv[0][1] = q[1]; bv[1][0] = q[2]; bv[1][1] = q[3]; }
        if (kh) { bv[0][0] = (f32x4){0.f, 0.f, 0.f, 0.f}; bv[0][1] = bv[0][0]; bv[1][0] = bv[0][0]; bv[1][1] = bv[0][0]; }
        bf16_t* Ob = kh ? O2 : O;
#pragma unroll
        for (int ai = 0; ai < 2; ++ai)
#pragma unroll
            for (int m = 0; m < 4; ++m) { bf16_t* rowp = Ob + (size_t)(row0 + ai * HALF + m * 16) * DM + col0;
#pragma unroll
                for (int bj = 0; bj < 2; ++bj) { const f32x4 v0 = acc[ai][bj][m][0] + bv[bj][0], v1 = acc[ai][bj][m][1] + bv[bj][1]; u32x4 w;
                    w.x = cvt_pk_bf16(v0[0], v0[1]); w.y = cvt_pk_bf16(v0[2], v0[3]); w.z = cvt_pk_bf16(v1[0], v1[1]); w.w = cvt_pk_bf16(v1[2], v1[3]);
                    *(u32x4*)(rowp + bj * HALF) = w; } }
    }
};

template <class Epi, class Sched>
__device__ __forceinline__ void gemm_phase(LAS unsigned char* lds, const Sched& S, const Epi& E) {
    const int tid = threadIdx.x, wid = __builtin_amdgcn_readfirstlane(tid >> 6), lane = tid & 63, wr = wid >> 2, wc = wid & 3, fr = lane & 15, fq = lane >> 4;
    constexpr int nt = NKT;
    int Rr[2], Cc[2]; unsigned voffB[2];
#pragma unroll
    for (int i = 0; i < 2; ++i) { stage_rc(tid * 16 + i * 8192, Rr[i], Cc[i]); const int Rb = Epi::PERM ? ((Rr[i] & ~31) + perm32(Rr[i] & 31)) : Rr[i]; voffB[i] = (unsigned)(Rb * KD + Cc[i]) * 2u; }
    const size_t kstep = (size_t)(BK * 2);
    const unsigned ldsw = (unsigned)wid * 1024u;
    const int aoff = lds_byte(wr * 64 + fr, fq * 8), boff = lds_byte(wc * 32 + fr, fq * 8);
#define PG8_SA(b, h) (((b) * 2 + (h)) * HTB)
#define PG8_SB(b, h) ((4 + (b) * 2 + (h)) * HTB)
#define PG8_STAGE(bufoff, gbase, voff) do { _Pragma("unroll") for (int _i = 0; _i < 2; ++_i) \
        __builtin_amdgcn_global_load_lds((const unsigned*)((const char*)(gbase) + (voff)[_i]), (LAS unsigned*)(lds + (bufoff) + ldsw + _i * 8192), 16, 0, 0); } while (0)
#define PG8_LDA(dst, b, h) do { _Pragma("unroll") for (int m = 0; m < 4; ++m) _Pragma("unroll") for (int k = 0; k < 2; ++k) dst[m][k] = *(const LAS bf16x8*)(lds + PG8_SA(b, h) + aoff + m * 2048 + k * 1024); } while (0)
#define PG8_LDB(dst, b, h) do { _Pragma("unroll") for (int n = 0; n < 2; ++n) _Pragma("unroll") for (int k = 0; k < 2; ++k) dst[n][k] = *(const LAS bf16x8*)(lds + PG8_SB(b, h) + boff + n * 2048 + k * 1024); } while (0)
#define PG8_MMA(ai, bj, At, Bt) do { __builtin_amdgcn_s_setprio(1); _Pragma("unroll") for (int m = 0; m < 4; ++m) _Pragma("unroll") for (int n = 0; n < 2; ++n) _Pragma("unroll") for (int k = 0; k < 2; ++k) \
        acc[ai][bj][m][n] = __builtin_amdgcn_mfma_f32_16x16x32_bf16(Bt[n][k], At[m][k], acc[ai][bj][m][n], 0, 0, 0); __builtin_amdgcn_s_setprio(0); } while (0)
#define PG8_WAIT_V(n) asm volatile("s_waitcnt vmcnt(" #n ")" ::: "memory")
#define PG8_WAIT_L(n) asm volatile("s_waitcnt lgkmcnt(" #n ")" ::: "memory")
#define PG8_BAR __builtin_amdgcn_s_barrier()
#define PG8_SCHED __builtin_amdgcn_sched_barrier(0)
    Unit cur, nxt; int ui = 0;
    if (!S.get(0, cur)) return;
    unsigned vaC[2][2], vaN[2][2];
#pragma unroll
    for (int h = 0; h < 2; ++h)
#pragma unroll
        for (int i = 0; i < 2; ++i) vaC[h][i] = S.aoff(cur, h, Rr[i], Cc[i]);
    f32x4 acc[2][2][4][2];
#pragma unroll
    for (int a = 0; a < 2; ++a)
#pragma unroll
        for (int b = 0; b < 2; ++b)
#pragma unroll
            for (int m = 0; m < 4; ++m)
#pragma unroll
                for (int n = 0; n < 2; ++n) acc[a][b][m][n] = (f32x4){0.f, 0.f, 0.f, 0.f};
    bf16x8 At[4][2], B0[2][2], B1[2][2];
    PG8_STAGE(PG8_SB(0, 0), cur.b0, voffB); PG8_STAGE(PG8_SB(0, 1), cur.b1, voffB); PG8_STAGE(PG8_SA(0, 0), cur.a, vaC[0]); PG8_STAGE(PG8_SA(0, 1), cur.a, vaC[1]);
    if (wr == 1) PG8_BAR;
    PG8_WAIT_V(2); PG8_BAR;
    PG8_STAGE(PG8_SB(1, 0), cur.b0 + kstep, voffB); PG8_STAGE(PG8_SA(1, 0), cur.a + kstep, vaC[0]); PG8_STAGE(PG8_SB(1, 1), cur.b1 + kstep, voffB);
    PG8_WAIT_V(6); PG8_BAR;
    for (;;) {
        const bool has_next = S.get(ui + 1, nxt);
        if (has_next) {
#pragma unroll
            for (int h = 0; h < 2; ++h)
#pragma unroll
                for (int i = 0; i < 2; ++i) vaN[h][i] = S.aoff(nxt, h, Rr[i], Cc[i]);
        } else {
            nxt = cur;
#pragma unroll
            for (int h = 0; h < 2; ++h)
#pragma unroll
                for (int i = 0; i < 2; ++i) vaN[h][i] = vaC[h][i];
        }
        for (int t = 0; t < nt; t += 2) {
            const bool last = (t == nt - 2);
            const char* a1 = cur.a + (size_t)(t + 1) * kstep;
            const char* a2 = last ? nxt.a : cur.a + (size_t)(t + 2) * kstep;
            const char* b20 = last ? nxt.b0 : cur.b0 + (size_t)(t + 2) * kstep;
            const char* b21 = last ? nxt.b1 : cur.b1 + (size_t)(t + 2) * kstep;
            const char* a3 = a2 + kstep; const char* b30 = b20 + kstep; const char* b31 = b21 + kstep;
            unsigned v2[2][2];
#pragma unroll
            for (int h = 0; h < 2; ++h)
#pragma unroll
                for (int i = 0; i < 2; ++i) v2[h][i] = last ? vaN[h][i] : vaC[h][i];
            PG8_LDB(B0, 0, 0); PG8_LDB(B1, 0, 1); PG8_SCHED; PG8_LDA(At, 0, 0); PG8_STAGE(PG8_SA(1, 1), a1, vaC[1]);
            PG8_WAIT_V(8); PG8_WAIT_L(0); PG8_BAR; PG8_MMA(0, 0, At, B0); PG8_MMA(0, 1, At, B1); PG8_BAR; PG8_SCHED;
            PG8_LDA(At, 0, 1); PG8_STAGE(PG8_SB(0, 0), b20, voffB); PG8_STAGE(PG8_SB(0, 1), b21, voffB); PG8_STAGE(PG8_SA(0, 0), a2, v2[0]);
            PG8_WAIT_V(8); PG8_WAIT_L(0); PG8_BAR; PG8_MMA(1, 0, At, B0); PG8_MMA(1, 1, At, B1); PG8_BAR; PG8_SCHED;
            PG8_LDB(B0, 1, 0); PG8_LDB(B1, 1, 1); PG8_SCHED; PG8_LDA(At, 1, 0); PG8_STAGE(PG8_SA(0, 1), a2, v2[1]);
            PG8_WAIT_V(8); PG8_WAIT_L(0); PG8_BAR; PG8_MMA(0, 0, At, B0); PG8_MMA(0, 1, At, B1); PG8_BAR; PG8_SCHED;
            PG8_LDA(At, 1, 1); PG8_STAGE(PG8_SB(1, 0), b30, voffB); PG8_STAGE(PG8_SB(1, 1), b31, voffB); PG8_STAGE(PG8_SA(1, 0), a3, v2[0]);
            PG8_WAIT_V(8); PG8_WAIT_L(0); PG8_BAR; PG8_MMA(1, 0, At, B0); PG8_MMA(1, 1, At, B1); PG8_BAR; PG8_SCHED;
        }
        if (wr == 0) PG8_BAR;
        E(acc, cur, wr, wc, fr, fq);
        if (!has_next) break;
#pragma unroll
        for (int a = 0; a < 2; ++a)
#pragma unroll
            for (int b = 0; b < 2; ++b)
#pragma unroll
                for (int m = 0; m < 4; ++m)
#pragma unroll
                    for (int n = 0; n < 2; ++n) acc[a][b][m][n] = (f32x4){0.f, 0.f, 0.f, 0.f};
        cur = nxt; ++ui;
#pragma unroll
        for (int h = 0; h < 2; ++h)
#pragma unroll
            for (int i = 0; i < 2; ++i) vaC[h][i] = vaN[h][i];
        if (wr == 1) PG8_BAR;
    }
    PG8_WAIT_V(0);
    PG8_BAR;
#undef PG8_SA
#undef PG8_SB
#undef PG8_STAGE
#undef PG8_LDA
#undef PG8_LDB
#undef PG8_MMA
#undef PG8_WAIT_V
#undef PG8_WAIT_L
#undef PG8_BAR
#undef PG8_SCHED
}

__host__ __device__ __forceinline__ void moe_split(int nT, int nN, int G, int& sR, int& sLt) { const int NU = nT * nN, R = NU / G, Lt = NU - R * G; if (Lt > 0 && 2 * Lt <= G && (G & 31) == 0) {       sR = R; sLt = Lt; } else { sR = -1; sLt = 0; } }
template <int NP  , int HDELTA  , bool GATHER, bool KSPLIT = false>
struct SchedMoeF {
    static constexpr bool KS = KSPLIT;
    const char* A; const float* W; const int* tile_e; const int* rowtok; int nT, nN, G, c, sR, sLt;
    __device__ __forceinline__ bool get(int i, UnitF& u) const {
        long L = (long)i * G + c; const int NU = nT * nN; int kh = 0;
        if constexpr (KSPLIT) { if (sR >= 0 && i >= sR) { if (i > sR || c >= 2 * sLt) return false; kh = (c >= sLt) ? 1 : 0; L = (long)sR * G + (c - kh * sLt); } }
        if (L >= NU) return false;
        const int nTb = nT >> 2, full = nTb * 4 * nN; int T, nt;
        if ((int)L < full) { const int blk = (int)L >> 5, w = (int)L & 31, nb = nN >> 3, tb = blk / nb, nbk = blk % nb; T = tb * 4 + (w & 3); nt = nbk * 8 + (w >> 2); }
        else { const int Lp = (int)L - full, rT = nT & 3; T = nTb * 4 + Lp % rT; nt = Lp / rT; }
        T = __builtin_amdgcn_readfirstlane(T); nt = __builtin_amdgcn_readfirstlane(nt);
        const int e = __builtin_amdgcn_readfirstlane(tile_e[T]); u.pm = T; u.pn = nt; u.e = e;
        u.a = GATHER ? A : A + (size_t)T * BM * KD * 2;
        u.b = (const char*)(W + (size_t)e * 2048 * NP + (size_t)nt * (HDELTA == 512 ? 256 : 128));
        u.nk = NKT; u.kh = 0;
        if constexpr (KSPLIT) { if (sR >= 0 && i >= sR) { kh = __builtin_amdgcn_readfirstlane(kh); u.nk = NKT / 2; u.kh = kh; u.a += (size_t)kh * (NKT / 2) * BK * 2; u.b += (size_t)kh * (NKT / 2) * 64 * NP * 4; } }
        return true;
    }
    __device__ __forceinline__ unsigned aoff(const UnitF& u, int h, int R, int C) const { const int row = GATHER ? rowtok[u.pm * BM + h * HALF + R] : h * HALF + R; return (unsigned)((row * KD + C) * 2); }
};
typedef short s16x4_t __attribute__((ext_vector_type(4)));
__device__ __forceinline__ s16x4_t tr16(const LAS unsigned char* p) { return __builtin_bit_cast(s16x4_t, __builtin_amdgcn_ds_read_tr16_b64_v4i16((LAS s16x4_t*)p)); }
__device__ __forceinline__ void glds16s(const char* sbase, unsigned voff, unsigned lds_dst) { unsigned keep;
    asm volatile("s_mov_b32 %0, m0\n\ts_mov_b32 m0, %2\n\ts_nop 2\n\tglobal_load_lds_dwordx4 %1, %3\n\ts_mov_b32 m0, %0" : "=&s"(keep) : "v"(voff), "s"(lds_dst), "s"(sbase) : "memory"); }

__device__ __forceinline__ void glds4s(const char* sbase, unsigned voff, unsigned lds_dst) { unsigned keep;
    asm volatile("s_mov_b32 %0, m0\n\ts_mov_b32 m0, %2\n\ts_nop 2\n\tglobal_load_lds_dword %1, %3\n\ts_mov_b32 m0, %0" : "=&s"(keep) : "v"(voff), "s"(lds_dst), "s"(sbase) : "memory"); }

template <class Epi, class Sched, int NP, int HDELTA, bool GATHER, bool WAITA = false>
__device__ __forceinline__ void gemm_phase_fb(LAS unsigned char* lds, const Sched& S, const Epi& E, const unsigned* ready = nullptr, unsigned need = 0u) {
    static_assert(Epi::PERM, "the B image's column-slot permutation assumes a PERM epilogue");
    const int tid = threadIdx.x, wid = __builtin_amdgcn_readfirstlane(tid >> 6), lane = tid & 63, wr = wid >> 2, wc = wid & 3;
    constexpr size_t kstep = (size_t)(BK * 2);
    constexpr size_t BKT = (size_t)64 * NP * 4;
    constexpr size_t BR8 = (size_t)8 * NP * 4;
    const unsigned lds0 = (unsigned)__builtin_amdgcn_readfirstlane((unsigned)(size_t)lds);
    const unsigned ldsw = lds0 + (unsigned)wid * 1024u;
    const int aoff = lds_byte(wr * 64 + (lane & 15), (lane >> 4) * 8);
    const int bh = lane >> 5, c4 = lane & 31;
    const unsigned blane = (unsigned)(bh * HDELTA + wid * NP * 4 + c4 * 16);
    const int s4 = (c4 & ~7) + 4 * (c4 & 1) + ((c4 & 7) >> 1), ch16 = s4 >> 1, sub = s4 & 1;
    const int X0 = ((wid & 3) << 2) | (wid >> 2);
    const unsigned bw0 = (unsigned)(4 * HTB + bh * HTB + 256 * wid + 16 * (ch16 ^ X0) + 8 * sub);
    unsigned radr[2];
    { const int g = lane >> 4, q = (lane & 15) >> 2, p = lane & 3;
#pragma unroll
      for (int t = 0; t < 2; ++t) { const int row = 8 * g + 4 * t + q, X = ((row & 3) << 2) | ((row >> 2) & 3), ch = 2 * (2 * wc) + (p >> 1); radr[t] = (unsigned)(4 * HTB + 256 * row + 16 * (ch ^ X) + 8 * (p & 1)); } }
#define FB_SA(b, h) (((b) * 2 + (h)) * HTB)
#define FB_SB(b, h) (((b) * 2 + (h)) * HTB)
#define FB_STAGE(bufoff, sbase, voff) do { _Pragma("unroll") for (int _i = 0; _i < 2; ++_i) glds16s((sbase), (voff)[_i], ldsw + (unsigned)(bufoff) + _i * 8192u); } while (0)
#define FB_STAGEH(bufoff, sbase, vv, h) do { if constexpr (GATHER) { FB_STAGE(bufoff, sbase, (vv)[h]); } else { FB_STAGE(bufoff, (sbase) + (size_t)(h) * HALF * KD * 2, (vv)[0]); } } while (0)
#define FB_LDA(dst, b, h) do { _Pragma("unroll") for (int m = 0; m < 4; ++m) _Pragma("unroll") for (int k = 0; k < 2; ++k) dst[m][k] = *(const LAS bf16x8*)(lds + FB_SA(b, h) + aoff + m * 2048 + k * 1024); } while (0)
#define FB_LDB(dst, b, h) do { _Pragma("unroll") for (int n = 0; n < 2; ++n) _Pragma("unroll") for (int k = 0; k < 2; ++k) { \
        const s16x4_t lo_ = tr16(lds + FB_SB(b, h) + (radr[0] ^ (n ? 32u : 0u)) + k * 8192), hi_ = tr16(lds + FB_SB(b, h) + (radr[1] ^ (n ? 32u : 0u)) + k * 8192); \
        dst[n][k] = (bf16x8){lo_[0], lo_[1], lo_[2], lo_[3], hi_[0], hi_[1], hi_[2], hi_[3]}; } } while (0)
#define FB_BLOAD(LD, bsrc, hr, rj) do { _Pragma("unroll") for (int _i = 0; _i < 4; ++_i) { const char* sb_ = (const char*)(bsrc) + (size_t)((4 * (hr) + _i + (rj)) & 7) * BR8; \
        asm volatile("s_nop 4\n\tglobal_load_dwordx4 %0, %1, %2 sc0" : "=v"(LD[_i]) : "v"(blane), "s"(sb_) : "memory"); } } while (0)
#define FB_BWAIT(LD, n) asm volatile("s_waitcnt vmcnt(" #n ")" : "+v"(LD[0]), "+v"(LD[1]), "+v"(LD[2]), "+v"(LD[3]) :: "memory")
#define FB_BCW(LD, b, hr, rj) do { _Pragma("unroll") for (int _i = 0; _i < 4; ++_i) { u32x2 w_; w_.x = cvt_pk_bf16(LD[_i].x, LD[_i].y); w_.y = cvt_pk_bf16(LD[_i].z, LD[_i].w); \
        *(LAS u32x2*)(lds + FB_SB(b, 0) + ((_i & 1) ? (bw0 ^ 32u) : bw0) + 2048 * ((4 * (hr) + _i + (rj)) & 7)) = w_; } } while (0)
#define FB_BSTEP(LD, wb, whr, wrj, nsrc, nhr, nrj, nw) do { FB_BWAIT(LD, nw); FB_BCW(LD, wb, whr, wrj); FB_BLOAD(LD, nsrc, nhr, nrj); } while (0)
#define FB_BCONS(LD, wb, whr, wrj, nw) do { FB_BWAIT(LD, nw); FB_BCW(LD, wb, whr, wrj); } while (0)
#define FB_MMA(ai, bj, At, Bt) do { __builtin_amdgcn_s_setprio(1); _Pragma("unroll") for (int m = 0; m < 4; ++m) _Pragma("unroll") for (int n = 0; n < 2; ++n) _Pragma("unroll") for (int k = 0; k < 2; ++k) \
        acc[ai][bj][m][n] = __builtin_amdgcn_mfma_f32_16x16x32_bf16(Bt[n][k], At[m][k], acc[ai][bj][m][n], 0, 0, 0); __builtin_amdgcn_s_setprio(0); } while (0)
#define FB_WAIT_V(n) asm volatile("s_waitcnt vmcnt(" #n ")" ::: "memory")
#define FB_WAIT_L(n) asm volatile("s_waitcnt lgkmcnt(" #n ")" ::: "memory")
#define FB_BAR __builtin_amdgcn_s_barrier()
#define FB_SCHED __builtin_amdgcn_sched_barrier(0)
#define FB_AWAIT(T) do { if constexpr (WAITA) { if (wid == 0) { unsigned sp_ = 0; \
        while ((unsigned)__builtin_amdgcn_readfirstlane(__hip_atomic_load(ready + 64 * (T), __ATOMIC_RELAXED, __HIP_MEMORY_SCOPE_AGENT)) < need) { __builtin_amdgcn_s_sleep(2); if (++sp_ > (1u << 22)) break; } \
        __builtin_amdgcn_fence(__ATOMIC_ACQUIRE, "agent"); asm volatile("s_waitcnt vmcnt(0)" ::: "memory"); } \
        asm volatile("" ::: "memory"); __builtin_amdgcn_s_barrier(); asm volatile("" ::: "memory"); } } while (0)
#define FB_BIAS(u) do { int tq_ = threadIdx.x; asm volatile("" : "+v"(tq_)); glds4s(uni(E.bias_base()), E.bias_off((u), wc, tq_ & 63), lds0 + (unsigned)BIAS_OFF + (unsigned)wid * 256u); } while (0)
    UnitF cur, nxt; int ui = 0;
    if (!S.get(0, cur)) return;
    FB_AWAIT(cur.pm);
    FB_BIAS(cur);
    unsigned vaC[2][2];
    { int tq = threadIdx.x; asm volatile("" : "+v"(tq));
#pragma unroll
      for (int i = 0; i < 2; ++i) { int R_, C_; stage_rc(tq * 16 + i * 8192, R_, C_);
#pragma unroll
        for (int h = 0; h < 2; ++h) vaC[h][i] = S.aoff(cur, h, R_, C_); } }
    f32x4 acc[2][2][4][2];
#pragma unroll
    for (int a = 0; a < 2; ++a)
#pragma unroll
        for (int b = 0; b < 2; ++b)
#pragma unroll
            for (int m = 0; m < 4; ++m)
#pragma unroll
                for (int n = 0; n < 2; ++n) acc[a][b][m][n] = (f32x4){0.f, 0.f, 0.f, 0.f};
    bf16x8 At[4][2], B0[2][2], B1[2][2];
    f32x4 ldX[4], ldY[4];
    { const char* a0 = uni(cur.a); const char* bb = uni(cur.b);
    FB_STAGEH(FB_SA(0, 0), a0, vaC, 0); FB_STAGEH(FB_SA(0, 1), a0, vaC, 1); FB_STAGEH(FB_SA(1, 0), a0 + kstep, vaC, 0);
    const int j0 = 2 * (cur.pm & 3);
    FB_BLOAD(ldY, bb, 0, j0); FB_BLOAD(ldX, bb, 1, j0);
    FB_BSTEP(ldY, 0, 0, j0, bb + BKT, 0, j0, 4);
    FB_BSTEP(ldX, 0, 1, j0, bb + BKT, 1, j0, 4);
    FB_BSTEP(ldY, 1, 0, j0, bb + 2 * BKT, 0, j0, 4); }
    FB_WAIT_V(0); FB_WAIT_L(0);
    if (wr == 1) FB_BAR;
    FB_BAR;
    for (;;) {
        const bool has_next = S.get(ui + 1, nxt);
        if (!has_next) nxt = cur;
        if (ui > 0) FB_BIAS(cur);
        if constexpr (GATHER) {
            if (has_next) { int tq = threadIdx.x; asm volatile("" : "+v"(tq));
                int R0, C0, R1, C1; stage_rc(tq * 16, R0, C0); stage_rc(tq * 16 + 8192, R1, C1);
                const char* rtb = uni((const char*)(S.rowtok + nxt.pm * BM)); const unsigned sd = lds0 + (unsigned)VAN_OFF + (unsigned)wid * 1024u;
                glds4s(rtb, (unsigned)(R0 * 4), sd); glds4s(rtb, (unsigned)(R1 * 4), sd + 256u); glds4s(rtb, (unsigned)((HALF + R0) * 4), sd + 512u); glds4s(rtb, (unsigned)((HALF + R1) * 4), sd + 768u); }
        }
        const char* ca = uni(cur.a); const char* cb = uni(cur.b); const char* na = uni(nxt.a); const char* nb = uni(nxt.b);
        const int jc = 2 * (cur.pm & 3), jn = 2 * (nxt.pm & 3);
        const int nt = Sched::KS ? __builtin_amdgcn_readfirstlane(cur.nk) : NKT;
        for (int t = 0; t < nt; t += 2) {
            const bool last = (t == nt - 2);
            if (last && has_next) FB_AWAIT(nxt.pm);
            const char* a1 = ca + (size_t)(t + 1) * kstep;
            const char* a2 = last ? na : ca + (size_t)(t + 2) * kstep;
            const char* a3 = a2 + kstep;
            const char* b2 = last ? nb : cb + (size_t)(t + 2) * BKT;
            const char* b3 = b2 + BKT;
            const char* b4 = (t + 4 < nt) ? cb + (size_t)(t + 4) * BKT : nb + (size_t)(t + 4 - nt) * BKT;
            const int j2 = last ? jn : jc, j4 = (t + 4 < nt) ? jc : jn;
            FB_BCONS(ldX, 1, 1, jc, 6);
            FB_LDB(B0, 0, 0); FB_LDB(B1, 0, 1); FB_SCHED; FB_LDA(At, 0, 0); FB_STAGEH(FB_SA(1, 1), a1, vaC, 1);
            if constexpr (GATHER) { if (last && has_next) { int tq = threadIdx.x; asm volatile("" : "+v"(tq));
                int R0, C0, R1, C1; stage_rc(tq * 16, R0, C0); stage_rc(tq * 16 + 8192, R1, C1);
                const LAS unsigned* sp = (const LAS unsigned*)(lds + VAN_OFF + wid * 1024) + (tq & 63);
                vaC[0][0] = (sp[0] * KD + C0) * 2u; vaC[0][1] = (sp[64] * KD + C1) * 2u; vaC[1][0] = (sp[128] * KD + C0) * 2u; vaC[1][1] = (sp[192] * KD + C1) * 2u; } }
            FB_WAIT_V(8); FB_WAIT_L(0); FB_BAR; FB_MMA(0, 0, At, B0); FB_BLOAD(ldX, b2, 1, j2); FB_MMA(0, 1, At, B1); FB_BAR; FB_SCHED;
            FB_BCONS(ldY, 0, 0, j2, 6);
            FB_LDA(At, 0, 1); FB_STAGEH(FB_SA(0, 0), a2, vaC, 0);
            FB_WAIT_V(8); FB_WAIT_L(0); FB_BAR; FB_MMA(1, 0, At, B0); FB_BLOAD(ldY, b3, 0, j2); FB_MMA(1, 1, At, B1); FB_BAR; FB_SCHED;
            FB_BCONS(ldX, 0, 1, j2, 6);
            FB_LDB(B0, 1, 0); FB_LDB(B1, 1, 1); FB_SCHED; FB_LDA(At, 1, 0); FB_STAGEH(FB_SA(0, 1), a2, vaC, 1);
            FB_WAIT_V(8); FB_WAIT_L(0); FB_BAR; FB_MMA(0, 0, At, B0); FB_BLOAD(ldX, b3, 1, j2); FB_MMA(0, 1, At, B1); FB_BAR; FB_SCHED;
            FB_BCONS(ldY, 1, 0, j2, 6);
            FB_LDA(At, 1, 1); FB_STAGEH(FB_SA(1, 0), a3, vaC, 0);
            FB_WAIT_V(8); FB_WAIT_L(0); FB_BAR; FB_MMA(1, 0, At, B0); FB_BLOAD(ldY, b4, 0, j4); FB_MMA(1, 1, At, B1); FB_BAR; FB_SCHED;
        }
        if (wr == 0) FB_BAR;
        { Unit ue; ue.a = nullptr; ue.b0 = nullptr; ue.b1 = nullptr; ue.pm = cur.pm; ue.pn = cur.pn; ue.e = Sched::KS ? (cur.e | (cur.kh << 8)) : cur.e;
          int tq = threadIdx.x; asm volatile("" : "+v"(tq)); E(acc, ue, wr, wc, tq & 15, (tq & 63) >> 4, (const LAS float*)(lds + BIAS_OFF + wid * 256)); }
        if (!has_next) break;
#pragma unroll
        for (int a = 0; a < 2; ++a)
#pragma unroll
            for (int b = 0; b < 2; ++b)
#pragma unroll
                for (int m = 0; m < 4; ++m)
#pragma unroll
                    for (int n = 0; n < 2; ++n) acc[a][b][m][n] = (f32x4){0.f, 0.f, 0.f, 0.f};
        cur = nxt; ++ui;
        if (wr == 1) FB_BAR;
    }
    FB_WAIT_V(0);
    FB_BAR;
#undef FB_SA
#undef FB_SB
#undef FB_STAGE
#undef FB_STAGEH
#undef FB_BIAS
#undef FB_LDA
#undef FB_LDB
#undef FB_BLOAD
#undef FB_BWRITE
#undef FB_BCW
#undef FB_BWAIT
#undef FB_BSTEP
#undef FB_BCONS
#undef FB_MMA
#undef FB_WAIT_V
#undef FB_WAIT_L
#undef FB_BAR
#undef FB_SCHED
#undef FB_AWAIT
}
}

namespace attn_body {
using bf16 = __hip_bfloat16;
using s16x4 = __attribute__((ext_vector_type(4))) short;
constexpr int PQ = NPROJP, PO = 2048;
constexpr int NW = 8, QBLK = 32, QB = QBLK * NW, KVBLK = 64;
__device__ __forceinline__ int crow(int r, int hi) { return (r & 3) + 8 * (r >> 2) + 4 * hi; }
#define SBAR() __builtin_amdgcn_sched_barrier(0)
__device__ __forceinline__ void cmask(f32x16& p0, f32x16& p1, int jb, int qrel, int hi) {
  const float NEG = -INFINITY; int d = qrel - (64 * jb + 4 * hi); asm volatile("" : "+v"(d));
  #pragma unroll
  for (int r = 0; r < 16; ++r) { const int cc = (r & 3) + 8 * (r >> 2); if (cc > d) p0[r] = NEG; if (cc + 32 > d) p1[r] = NEG; }
}
constexpr int NSLOT = 3, SLOTB = 8192;
constexpr int LDS_K = 0, LDS_V = NSLOT * SLOTB, LDS_WS = 2 * NSLOT * SLOTB, LDS_OST = LDS_WS + NW * 64 * 4, LDS_BYTES_A = LDS_OST + NW * 4096;
__device__ __forceinline__ void glds16(const void* sbase, unsigned voff, unsigned lds_dst) { unsigned keep;
  asm volatile("s_mov_b32 %0, m0\n\ts_mov_b32 m0, %2\n\ts_nop 0\n\tglobal_load_lds_dwordx4 %1, %3\n\ts_mov_b32 m0, %0" : "=&s"(keep) : "v"(voff), "s"(lds_dst), "s"(sbase) : "memory"); }
__device__ __forceinline__ float max3f(float a, float b, float c) { float r; asm("v_max3_f32 %0, %1, %2, %3" : "=v"(r) : "v"(a), "v"(b), "v"(c)); return r; }
__device__ __forceinline__ float max2f(float a, float b) { float r; asm("v_max_f32_e32 %0, %1, %2" : "=v"(r) : "v"(a), "v"(b)); return r; }
__device__ __forceinline__ float fadd_s(float a, float b) { float r; asm("v_add_f32_e32 %0, %1, %2" : "=v"(r) : "v"(a), "v"(b)); return r; }
__device__ __forceinline__ float fsub_s(float a, float b) { float r; asm("v_sub_f32_e32 %0, %1, %2" : "=v"(r) : "v"(a), "v"(b)); return r; }
typedef float f32x2_t __attribute__((ext_vector_type(2))); typedef __bf16 bf16x2_t __attribute__((ext_vector_type(2)));
__device__ __forceinline__ unsigned cvtpk_s(float lo, float hi) { f32x2_t v = {lo, hi}; bf16x2_t b = __builtin_convertvector(v, bf16x2_t); return __builtin_bit_cast(unsigned, b); }
#define WAIT_BAR(N) asm volatile("s_waitcnt vmcnt(" #N ") lgkmcnt(0)\n\ts_barrier" ::: "memory")
__device__ __forceinline__ void qkt(f32x16& p0, f32x16& p1, const char* Kslot, const bf16x8* qr, const f32x16& negm, int r32, int hi) {
  const char* kb = Kslot + hi * 1024 + r32 * 16;
  #pragma unroll
  for (int d0 = 0; d0 < 4; ++d0) {
    const bf16x8 b0 = *reinterpret_cast<const bf16x8*>(kb + d0 * 2048);
    const bf16x8 b1 = *reinterpret_cast<const bf16x8*>(kb + d0 * 2048 + 512);
    if (d0 == 0) { p0 = __builtin_amdgcn_mfma_f32_32x32x16_bf16(b0, qr[0], negm, 0, 0, 0); p1 = __builtin_amdgcn_mfma_f32_32x32x16_bf16(b1, qr[0], negm, 0, 0, 0); }
    else { p0 = __builtin_amdgcn_mfma_f32_32x32x16_bf16(b0, qr[d0], p0, 0, 0, 0); p1 = __builtin_amdgcn_mfma_f32_32x32x16_bf16(b1, qr[d0], p1, 0, 0, 0); } }
}
typedef __attribute__((address_space(3))) const char* lds_cptr;
typedef short v4i16_t __attribute__((ext_vector_type(4)));
__device__ __forceinline__ void kload8(bf16x8* kf, lds_cptr kp) {
  kf[0] = *(const __attribute__((address_space(3))) bf16x8*)(kp);        kf[1] = *(const __attribute__((address_space(3))) bf16x8*)(kp + 512);
  kf[2] = *(const __attribute__((address_space(3))) bf16x8*)(kp + 2048); kf[3] = *(const __attribute__((address_space(3))) bf16x8*)(kp + 2560);
  kf[4] = *(const __attribute__((address_space(3))) bf16x8*)(kp + 4096); kf[5] = *(const __attribute__((address_space(3))) bf16x8*)(kp + 4608);
  kf[6] = *(const __attribute__((address_space(3))) bf16x8*)(kp + 6144); kf[7] = *(const __attribute__((address_space(3))) bf16x8*)(kp + 6656);
}
__device__ __forceinline__ void kload2(bf16x8* kf, lds_cptr kp, int j) { kf[2 * j] = *(const __attribute__((address_space(3))) bf16x8*)(kp + j * 2048); kf[2 * j + 1] = *(const __attribute__((address_space(3))) bf16x8*)(kp + j * 2048 + 512); }
__device__ __forceinline__ s16x4 vtr(lds_cptr p) { return __builtin_bit_cast(s16x4, __builtin_amdgcn_ds_read_tr16_b64_v4i16((__attribute__((address_space(3))) v4i16_t*)p)); }
__device__ __forceinline__ float rowmax(const f32x16& p0, const f32x16& p1) {
  float a = max3f(p0[0], p0[1], p1[0]), b = max3f(p0[2], p0[3], p1[1]); a = max3f(a, p1[2], p1[3]);
  #pragma unroll
  for (int r = 4; r < 16; r += 4) { a = max3f(a, p0[r], p0[r + 1]); b = max3f(b, p0[r + 2], p0[r + 3]); a = max3f(a, p1[r], p1[r + 1]); b = max3f(b, p1[r + 2], p1[r + 3]); }
  const float m = max2f(a, b);
  auto rr = __builtin_amdgcn_permlane32_swap(__float_as_uint(m), __float_as_uint(m), false, false);
  return max2f(__uint_as_float(rr[0]), __uint_as_float(rr[1]));
}
__device__ __forceinline__ void pv(f32x16* o, int vb, bf16x8 pa0, bf16x8 pa1, bf16x8 pa2, bf16x8 pa3) {
  #pragma unroll
  for (int d0 = 0; d0 < 2; ++d0) { s16x4 lo[4], hi[4];
    #pragma unroll
    for (int ks = 0; ks < 4; ++ks) {
      asm volatile("ds_read_b64_tr_b16 %0,%1 offset:%c2" : "=&v"(lo[ks]) : "v"(vb), "i"(d0 * 4096 + ks * 1024) : "memory");
      asm volatile("ds_read_b64_tr_b16 %0,%1 offset:%c2" : "=&v"(hi[ks]) : "v"(vb), "i"(d0 * 4096 + ks * 1024 + 512) : "memory"); }
    asm volatile("s_waitcnt lgkmcnt(0)" ::: "memory"); SBAR();
    #define PK(k) (bf16x8){lo[k][0], lo[k][1], lo[k][2], lo[k][3], hi[k][0], hi[k][1], hi[k][2], hi[k][3]}
    o[d0] = __builtin_amdgcn_mfma_f32_32x32x16_bf16(pa0, PK(0), o[d0], 0, 0, 0);
    o[d0] = __builtin_amdgcn_mfma_f32_32x32x16_bf16(pa1, PK(1), o[d0], 0, 0, 0);
    o[d0] = __builtin_amdgcn_mfma_f32_32x32x16_bf16(pa2, PK(2), o[d0], 0, 0, 0);
    o[d0] = __builtin_amdgcn_mfma_f32_32x32x16_bf16(pa3, PK(3), o[d0], 0, 0, 0);
    #undef PK
  }
}
#define ATTN_STORE16(p, v) (*(u32x4*)(p) = (v))
template <int THRL> __device__ __forceinline__ void attn_unit(long rowbase, int qb, const bf16* Qh, const bf16* __restrict__ Kh0, const bf16* __restrict__ Vh0, bf16* Oh, char* shm) {
  const int tid = threadIdx.x, lane = tid & 63, r32 = lane & 31, hi = lane >> 5; const int wid = __builtin_amdgcn_readfirstlane(tid >> 6);
  const int q0 = qb * QB;
  const bf16* Qw = Qh + (rowbase + q0 + wid * QBLK) * PQ;
  const bf16* Kh = Kh0 + rowbase * PQ, *Vh = Vh0 + rowbase * PQ;
  const unsigned lds0 = (unsigned)(uintptr_t)shm;
  float* wsf = (float*)(shm + LDS_WS) + wid * 64;
  const unsigned koff = (unsigned)((lane * PQ + wid * 8) * 2);
  const unsigned voff = (unsigned)(((16 * (wid & 3) + (lane >> 2)) * PQ + (wid >> 2) * 32 + (lane & 3) * 8) * 2);
  const unsigned kdst = lds0 + LDS_K + wid * 1024, vdst = lds0 + LDS_V + wid * 1024;
  #define DMA_K(t, slot) glds16((const char*)Kh + (size_t)(t) * (KVBLK * PQ * 2), koff, (unsigned)__builtin_amdgcn_readfirstlane(kdst + (slot)))
  #define DMA_V(t, slot) glds16((const char*)Vh + (size_t)(t) * (KVBLK * PQ * 2), voff, (unsigned)__builtin_amdgcn_readfirstlane(vdst + (slot)))
  const int vb0 = (int)(lds0 + LDS_V) + ((lane >> 4) & 1) * 32 + (lane & 3) * 8 + (4 * hi + ((lane & 15) >> 2)) * 64;
  const char* Kbase = shm + LDS_K; bf16x8 kf[8];
  const lds_cptr shm3 = (lds_cptr)shm; const lds_cptr kp0 = shm3 + LDS_K + hi * 1024 + r32 * 16; const lds_cptr vp0 = shm3 + LDS_V + ((lane >> 4) & 1) * 32 + (lane & 3) * 8 + (4 * hi + ((lane & 15) >> 2)) * 64;
  const int NT = (q0 + QB) / KVBLK;
  DMA_K(0, 0); DMA_V(0, 0); DMA_K(1, SLOTB);
  bf16x8 qr[4];
  #pragma unroll
  for (int d0 = 0; d0 < 4; ++d0) qr[d0] = *reinterpret_cast<const bf16x8*>(&Qw[(long)r32 * PQ + d0 * 16 + hi * 8]);
  float mhat = 0.f, l_reg = 0.f; f32x16 o[2]; o[0] = f32x16{}; o[1] = f32x16{}; asm volatile("" : "+v"(o[0]), "+v"(o[1])); f32x16 negm = f32x16{}; asm volatile("" : "+v"(negm));
  const int qrel = wid * QBLK + r32;
  #define CMASK(P0, P1, t) do { int jb_ = (t) - (NT - 4); if (jb_ >= 0) cmask(P0, P1, jb_, qrel, hi); } while (0)
  bool resc = false;
  #define START(P0, P1) do { const float rm = rowmax(P0, P1); resc = false; \
    { const float dl = rm; mhat = fadd_s(mhat, dl); \
      _Pragma("unroll") for (int r = 0; r < 16; ++r) { P0[r] = fsub_s(P0[r], dl); P1[r] = fsub_s(P1[r], dl); } \
      _Pragma("unroll") for (int r = 0; r < 16; ++r) negm[r] = -mhat; asm volatile("" : "+v"(negm)); } \
    _Pragma("unroll") for (int r = 0; r < 16; ++r) P0[r] = __builtin_amdgcn_exp2f(P0[r]); } while (0)
  #define RESC() do { if (resc) { asm volatile("s_waitcnt lgkmcnt(0)" ::: "memory"); \
      _Pragma("unroll") for (int d_ = 0; d_ < 2; ++d_) _Pragma("unroll") for (int r = 0; r < 16; ++r) o[d_][r] *= wsf[crow(r, hi)]; } } while (0)
  f32x16 pA0, pA1, pB0, pB1;
  int sl_prev = 0, sl_cur = 0, sl_next = SLOTB;
  #define ROT() do { sl_prev = sl_cur; sl_cur = sl_next; sl_next = (sl_next == (NSLOT - 1) * SLOTB) ? 0 : sl_next + SLOTB; } while (0)
  DMA_K(2, 2 * SLOTB);
  WAIT_BAR(3);
  qkt(pA0, pA1, Kbase, qr, negm, r32, hi); asm volatile("s_nop 15\n\ts_nop 7" : "+v"(pA0), "+v"(pA1)); CMASK(pA0, pA1, 0);
  START(pA0, pA1);
  _Pragma("unroll") for (int r = 0; r < 16; ++r) pA1[r] = __builtin_amdgcn_exp2f(pA1[r]);
  WAIT_BAR(0);
  DMA_K(3, 0); DMA_V(1, SLOTB);
  ROT();
  kload8(kf, kp0 + sl_cur);
  WAIT_BAR(2);
  s16x4 vlo[8], vhi[8]; u32x4 pw0, pw1, pw2, pw3;
  #define PKW(P, B) cvtpk_s(P[B], P[B + 1])
  #define PAF(k) __builtin_bit_cast(bf16x8, pw##k)
  #define VFR(i) (bf16x8){vlo[i][0], vlo[i][1], vlo[i][2], vlo[i][3], vhi[i][0], vhi[i][1], vhi[i][2], vhi[i][3]}
  #define PIN(x) asm volatile("" : "+v"(x))
  #define MX3(a, b, c) __builtin_fmaxf(__builtin_fmaxf((a), (b)), (c))
  #define GAPA(MF, A0, A1, A2, A3, W0, W1, PW) do { MF; sacc += A0; sacc += A1; sacc += A2; sacc += A3; PIN(sacc); W0; W1; PIN(PW); SBAR(); } while (0)
  #define EX(v) __builtin_amdgcn_exp2f(v)
  #define GAPB(MF, X, B) do { MF; X[B] = EX(X[B]); X[B + 1] = EX(X[B + 1]); X[B + 2] = EX(X[B + 2]); X[B + 3] = EX(X[B + 3]); PIN(X); SBAR(); } while (0)
  #define VRD(i) do { vlo[i] = vtr(vp_ + (((i) >> 2) * 4096 + ((i) & 3) * 1024)); vhi[i] = vtr(vp_ + (((i) >> 2) * 4096 + ((i) & 3) * 1024 + 512)); } while (0)
  #define KRD(G, j) do { if (G) { kload2(kf, kp0 + sl_next, j); SBAR(); } } while (0)
  #define STEP(C0, C1, P0, P1, t, GK, GV, GL) do { SBAR(); \
    const lds_cptr vp_ = vp0 + sl_prev; \
    VRD(0); SBAR(); float sacc = (P0[0] + P0[1]); \
    GAPA(C0 = __builtin_amdgcn_mfma_f32_32x32x16_bf16(kf[0], qr[0], negm, 0, 0, 0), P0[2], P0[3], P0[4], P0[5],     pw0[0] = PKW(P0, 0), pw0[1] = PKW(P0, 2), pw0); \
    VRD(4); SBAR(); GAPA(C1 = __builtin_amdgcn_mfma_f32_32x32x16_bf16(kf[1], qr[0], negm, 0, 0, 0), P0[6], P0[7], P0[8], P0[9],     pw0[2] = PKW(P0, 4), pw0[3] = PKW(P0, 6), pw0); \
    VRD(1); SBAR(); GAPA(C0 = __builtin_amdgcn_mfma_f32_32x32x16_bf16(kf[2], qr[1], C0, 0, 0, 0),   P0[10], P0[11], P0[12], P0[13], pw1[0] = PKW(P0, 8), pw1[1] = PKW(P0, 10), pw1); \
    VRD(5); SBAR(); GAPA(C1 = __builtin_amdgcn_mfma_f32_32x32x16_bf16(kf[3], qr[1], C1, 0, 0, 0),   P0[14], P0[15], P1[0], P1[1],   pw1[2] = PKW(P0, 12), pw1[3] = PKW(P0, 14), pw1); \
    VRD(2); SBAR(); GAPA(C0 = __builtin_amdgcn_mfma_f32_32x32x16_bf16(kf[4], qr[2], C0, 0, 0, 0),   P1[2], P1[3], P1[4], P1[5],     pw2[0] = PKW(P1, 0), pw2[1] = PKW(P1, 2), pw2); \
    VRD(6); SBAR(); GAPA(C1 = __builtin_amdgcn_mfma_f32_32x32x16_bf16(kf[5], qr[2], C1, 0, 0, 0),   P1[6], P1[7], P1[8], P1[9],     pw2[2] = PKW(P1, 4), pw2[3] = PKW(P1, 6), pw2); \
    VRD(3); SBAR(); GAPA(C0 = __builtin_amdgcn_mfma_f32_32x32x16_bf16(kf[6], qr[3], C0, 0, 0, 0),   P1[10], P1[11], P1[12], P1[13], pw3[0] = PKW(P1, 8), pw3[1] = PKW(P1, 10), pw3); \
    VRD(7); SBAR(); GAPA(C1 = __builtin_amdgcn_mfma_f32_32x32x16_bf16(kf[7], qr[3], C1, 0, 0, 0),   P1[14], P1[15], 0.f, 0.f,       pw3[2] = PKW(P1, 12), pw3[3] = PKW(P1, 14), pw3); \
    l_reg += sacc; \
    if (GK) { DMA_K((t) + 3, sl_cur); } if (GV) { DMA_V((t) + 1, sl_next); } \
    CMASK(C0, C1, t); \
    { float a = MX3(C0[0], C0[1], C1[0]), b = MX3(C0[2], C0[3], C1[1]); a = MX3(a, C1[2], C1[3]); \
      _Pragma("unroll") for (int r = 4; r < 16; r += 4) { a = MX3(a, C0[r], C0[r + 1]); b = MX3(b, C0[r + 2], C0[r + 3]); a = MX3(a, C1[r], C1[r + 1]); b = MX3(b, C1[r + 2], C1[r + 3]); } \
      float rm = __builtin_fmaxf(a, b); { auto rr = __builtin_amdgcn_permlane32_swap(__float_as_uint(rm), __float_as_uint(rm), false, false); rm = __builtin_fmaxf(__uint_as_float(rr[0]), __uint_as_float(rr[1])); } \
      resc = false; \
      if (__builtin_expect(__any(rm > (float)THRL), 0)) { const float dl = __builtin_fmaxf(rm, 0.f); mhat += dl; \
        _Pragma("unroll") for (int r = 0; r < 16; ++r) { C0[r] -= dl; C1[r] -= dl; } \
        _Pragma("unroll") for (int r = 0; r < 16; ++r) negm[r] = -mhat; asm volatile("" : "+v"(negm)); \
        const float f = __builtin_amdgcn_exp2f(-dl); l_reg *= f; if (hi == 0) wsf[r32] = f; resc = true; } } \
    SBAR(); \
    GAPB(o[0] = __builtin_amdgcn_mfma_f32_32x32x16_bf16(PAF(0), VFR(0), o[0], 0, 0, 0), C0, 0); \
    GAPB(o[1] = __builtin_amdgcn_mfma_f32_32x32x16_bf16(PAF(0), VFR(4), o[1], 0, 0, 0), C0, 4); \
    KRD(GL, 0); GAPB(o[0] = __builtin_amdgcn_mfma_f32_32x32x16_bf16(PAF(1), VFR(1), o[0], 0, 0, 0), C0, 8); \
    KRD(GL, 1); GAPB(o[1] = __builtin_amdgcn_mfma_f32_32x32x16_bf16(PAF(1), VFR(5), o[1], 0, 0, 0), C0, 12); \
    KRD(GL, 2); GAPB(o[0] = __builtin_amdgcn_mfma_f32_32x32x16_bf16(PAF(2), VFR(2), o[0], 0, 0, 0), C1, 0); \
    KRD(GL, 3); GAPB(o[1] = __builtin_amdgcn_mfma_f32_32x32x16_bf16(PAF(2), VFR(6), o[1], 0, 0, 0), C1, 4); \
    GAPB(o[0] = __builtin_amdgcn_mfma_f32_32x32x16_bf16(PAF(3), VFR(3), o[0], 0, 0, 0), C1, 8); \
    GAPB(o[1] = __builtin_amdgcn_mfma_f32_32x32x16_bf16(PAF(3), VFR(7), o[1], 0, 0, 0), C1, 12); \
    } while (0)
  int t = 1;
  #undef CMASK
  #define CMASK(P0, P1, t) do {} while (0)
  for (; t + 5 < NT; t += 2) {
    STEP(pB0, pB1, pA0, pA1, t, true, true, true);     WAIT_BAR(2); RESC(); ROT();
    STEP(pA0, pA1, pB0, pB1, t + 1, true, true, true); WAIT_BAR(2); RESC(); ROT();
  }
  #undef CMASK
  #define CMASK(P0, P1, t) do { int jb_ = (t) - (NT - 4); if (jb_ >= 0) cmask(P0, P1, jb_, qrel, hi); } while (0)
  #define ENDW(tt) do { if ((tt) + 3 < NT) { WAIT_BAR(2); } else if ((tt) + 2 < NT) { WAIT_BAR(1); } else { WAIT_BAR(0); } } while (0)
  for (; t + 1 < NT; t += 2) {
    STEP(pB0, pB1, pA0, pA1, t, (t + 3 < NT), (t + 1 < NT), (t + 1 < NT));         ENDW(t);     RESC(); ROT();
    STEP(pA0, pA1, pB0, pB1, t + 1, (t + 4 < NT), (t + 2 < NT), (t + 2 < NT));     ENDW(t + 1); RESC(); ROT();
  }
  STEP(pB0, pB1, pA0, pA1, NT - 1, false, false, false); RESC();
  { float sacc = pB0[0] + pB0[1]; _Pragma("unroll") for (int r = 2; r < 16; ++r) sacc += pB0[r]; _Pragma("unroll") for (int r = 0; r < 16; ++r) sacc += pB1[r]; l_reg += sacc;
    pw0 = (u32x4){PKW(pB0, 0), PKW(pB0, 2), PKW(pB0, 4), PKW(pB0, 6)}; pw1 = (u32x4){PKW(pB0, 8), PKW(pB0, 10), PKW(pB0, 12), PKW(pB0, 14)}; pw2 = (u32x4){PKW(pB1, 0), PKW(pB1, 2), PKW(pB1, 4), PKW(pB1, 6)}; pw3 = (u32x4){PKW(pB1, 8), PKW(pB1, 10), PKW(pB1, 12), PKW(pB1, 14)};
    SBAR(); pv(o, vb0 + sl_cur, PAF(0), PAF(1), PAF(2), PAF(3)); }
  #undef PKW
  #undef PAF
  #undef VFR
  #undef PIN
  #undef MX3
  #undef GAPA
  #undef GAPB
  #undef EX
  #undef VRD
  #undef KRD
  #undef STEP
  #undef ENDW
  { auto rr = __builtin_amdgcn_permlane32_swap(__float_as_uint(l_reg), __float_as_uint(l_reg), false, false); l_reg = __uint_as_float(rr[0]) + __uint_as_float(rr[1]); }
  if (hi == 0) wsf[32 + r32] = l_reg; asm volatile("s_waitcnt lgkmcnt(0)" ::: "memory");
  float rli[16];
  #pragma unroll
  for (int r = 0; r < 16; ++r) rli[r] = __builtin_amdgcn_rcpf(wsf[32 + crow(r, hi)]);
  bf16* Ow = Oh + (rowbase + q0 + wid * QBLK) * PO;
  { bf16* stg = (bf16*)(shm + LDS_OST) + wid * 2048;
    #pragma unroll
    for (int r = 0; r < 16; ++r) { const int orow = crow(r, hi);
      #pragma unroll
      for (int d0 = 0; d0 < 2; ++d0) stg[orow * 64 + d0 * 32 + r32] = __float2bfloat16(o[d0][r] * rli[r]); }
    asm volatile("s_waitcnt lgkmcnt(0)" ::: "memory");
    #pragma unroll
    for (int i = 0; i < 4; ++i) { const int row = i * 8 + (lane >> 3), ch = lane & 7; const u32x4 v = *(const u32x4*)(stg + row * 64 + ch * 8); ATTN_STORE16(Ow + (long)row * PO + ch * 8, v); } }
  asm volatile("s_waitcnt lgkmcnt(0)\n\ts_barrier" ::: "memory");
  #undef DMA_K
  #undef DMA_V
  #undef CMASK
  #undef START
  #undef RESC
  #undef ROT
}
template <int THRL> __device__ __forceinline__ void attn_unit128(long rowbase, int qb, const bf16* Qh, const bf16* __restrict__ Kh0, const bf16* __restrict__ Vh0, bf16* Oh, char* shm) {
  int tid = threadIdx.x; asm volatile("" : "+v"(tid));
  const int lane = tid & 63, r32 = lane & 31, hi = lane >> 5; const int wid = __builtin_amdgcn_readfirstlane(tid >> 6);
  const int q0 = qb * QB;
  const bf16* Qw = Qh + (rowbase + q0 + wid * QBLK) * PQ;
  const bf16* Kh = Kh0 + rowbase * PQ, *Vh = Vh0 + rowbase * PQ;
  const unsigned lds0 = (unsigned)(uintptr_t)shm;
  constexpr int LDS_WS2 = LDS_V + NSLOT * 2 * SLOTB, LDS_OST2 = LDS_WS2 + NW * 64 * 4;
  float* wsf = (float*)(shm + LDS_WS2) + wid * 64;
  const unsigned koff = (unsigned)((lane * PQ + wid * 8) * 2);
  const unsigned voff = (unsigned)(((16 * (wid & 3) + (lane >> 2)) * PQ + (wid >> 2) * 32 + (lane & 3) * 8) * 2);
  const unsigned kdst = lds0 + LDS_K + wid * 1024, vdst = lds0 + LDS_V + wid * 1024;
  #define DMA_K(t, slot) glds16((const char*)Kh + (size_t)(t) * (KVBLK * PQ * 2), koff, (unsigned)__builtin_amdgcn_readfirstlane(kdst + (slot)))
  #define DMA_V(t, slot) do { glds16((const char*)Vh + (size_t)(t) * (KVBLK * PQ * 2), voff, (unsigned)__builtin_amdgcn_readfirstlane(vdst + 2 * (slot))); \
    glds16((const char*)Vh + (size_t)(t) * (KVBLK * PQ * 2) + 128, voff, (unsigned)__builtin_amdgcn_readfirstlane(vdst + 2 * (slot) + 8192)); } while (0)
  const int vb0 = (int)(lds0 + LDS_V) + ((lane >> 4) & 1) * 32 + (lane & 3) * 8 + (4 * hi + ((lane & 15) >> 2)) * 64;
  const char* Kbase = shm + LDS_K; bf16x8 kf[8];
  const lds_cptr shm3 = (lds_cptr)shm; const lds_cptr kp0 = shm3 + LDS_K + hi * 1024 + r32 * 16; const lds_cptr vp0 = shm3 + LDS_V + ((lane >> 4) & 1) * 32 + (lane & 3) * 8 + (4 * hi + ((lane & 15) >> 2)) * 64;
  const int NT = (q0 + QB) / KVBLK;
  DMA_K(0, 0); DMA_V(0, 0); DMA_K(1, SLOTB);
  const lds_cptr qp0 = shm3 + LDS_OST2 + wid * 4096 + lane * 16;
  {
  #pragma unroll
  for (int d0 = 0; d0 < 4; ++d0) { const bf16x8 qv = *reinterpret_cast<const bf16x8*>(&Qw[(long)r32 * PQ + d0 * 16 + hi * 8]); *(__attribute__((address_space(3))) bf16x8*)(shm3 + LDS_OST2 + wid * 4096 + d0 * 1024 + lane * 16) = qv; }
  asm volatile("s_waitcnt lgkmcnt(0)" ::: "memory");
  }
  #define QR(d0) (*(const __attribute__((address_space(3))) bf16x8*)(qp0 + (d0) * 1024))
  float mhat = 0.f, l_reg = 0.f; f32x16 o[4]; o[0] = f32x16{}; o[1] = f32x16{}; o[2] = f32x16{}; o[3] = f32x16{}; asm volatile("" : "+v"(o[0]), "+v"(o[1]), "+v"(o[2]), "+v"(o[3]));
  const int qrel = wid * QBLK + r32;
  #define CMASK(P0, P1, t) do { int jb_ = (t) - (NT - 4); if (jb_ >= 0) cmask(P0, P1, jb_, qrel, hi); } while (0)
  bool resc = false;
  #define START(P0, P1) do { const float rm = rowmax(P0, P1); resc = false; \
    { const float dl = rm; mhat = fadd_s(mhat, dl); \
      _Pragma("unroll") for (int r = 0; r < 16; ++r) { P0[r] = fsub_s(P0[r], dl); P1[r] = fsub_s(P1[r], dl); } } \
    _Pragma("unroll") for (int r = 0; r < 16; ++r) P0[r] = __builtin_amdgcn_exp2f(P0[r]); } while (0)
  #define RESC() do { if (resc) { asm volatile("s_waitcnt lgkmcnt(0)" ::: "memory"); \
      _Pragma("unroll") for (int d_ = 0; d_ < 4; ++d_) _Pragma("unroll") for (int r = 0; r < 16; ++r) o[d_][r] *= wsf[crow(r, hi)]; } } while (0)
  f32x16 pA0, pA1, pB0, pB1;
  int sl_prev = 0, sl_cur = 0, sl_next = SLOTB;
  #define ROT() do { sl_prev = sl_cur; sl_cur = sl_next; sl_next = (sl_next == (NSLOT - 1) * SLOTB) ? 0 : sl_next + SLOTB; } while (0)
  DMA_K(2, 2 * SLOTB);
  WAIT_BAR(4);
  { bf16x8 qr_[4] = {QR(0), QR(1), QR(2), QR(3)}; qkt(pA0, pA1, Kbase, qr_, f32x16{}, r32, hi); } asm volatile("s_nop 15\n\ts_nop 7" : "+v"(pA0), "+v"(pA1)); CMASK(pA0, pA1, 0);
  START(pA0, pA1);
  _Pragma("unroll") for (int r = 0; r < 16; ++r) pA1[r] = __builtin_amdgcn_exp2f(pA1[r]);
  WAIT_BAR(0);
  DMA_K(3, 0); DMA_V(1, SLOTB);
  ROT();
  kload8(kf, kp0 + sl_cur);
  WAIT_BAR(3);
  s16x4 vlo[8], vhi[8]; u32x4 pw0, pw1, pw2, pw3;
  #define PKW(P, B) cvtpk_s(P[B], P[B + 1])
  #define PAF(k) __builtin_bit_cast(bf16x8, pw##k)
  #define VFR(i) (bf16x8){vlo[i][0], vlo[i][1], vlo[i][2], vlo[i][3], vhi[i][0], vhi[i][1], vhi[i][2], vhi[i][3]}
  #define PIN(x) asm volatile("" : "+v"(x))
  #define MX3(a, b, c) __builtin_fmaxf(__builtin_fmaxf((a), (b)), (c))
  #define GAPA(MF, A0, A1, A2, A3, W0, W1, PW) do { MF; sacc += A0; sacc += A1; sacc += A2; sacc += A3; PIN(sacc); W0; W1; PIN(PW); SBAR(); } while (0)
  #define EX(v) __builtin_amdgcn_exp2f(v)
  #define GAPB(MF, X, B) do { MF; X[B] = EX(X[B]); X[B + 1] = EX(X[B + 1]); X[B + 2] = EX(X[B + 2]); X[B + 3] = EX(X[B + 3]); PIN(X); SBAR(); } while (0)
  #define GAPC(MF, X, B, RD) do { MF; X[B] = EX(X[B]); X[B + 1] = EX(X[B + 1]); PIN(X); RD; SBAR(); } while (0)
  #define VRD(i) do { vlo[i] = vtr(vp_ + (((i) >> 2) * 4096 + ((i) & 3) * 1024)); vhi[i] = vtr(vp_ + (((i) >> 2) * 4096 + ((i) & 3) * 1024 + 512)); } while (0)
  #define VRD2(i) do { vlo[i] = vtr(vp_ + (8192 + ((i) >> 2) * 4096 + ((i) & 3) * 1024)); vhi[i] = vtr(vp_ + (8192 + ((i) >> 2) * 4096 + ((i) & 3) * 1024 + 512)); } while (0)
  #define KRD(G, j) do { if (G) { kload2(kf, kp0 + sl_next, j); SBAR(); } } while (0)
  #define STEP(C0, C1, P0, P1, t, GK, GV, GL) do { SBAR(); \
    const lds_cptr vp_ = vp0 + 2 * sl_prev; \
    VRD(0); SBAR(); float sacc = (P0[0] + P0[1]); \
    GAPA(C0 = __builtin_amdgcn_mfma_f32_32x32x16_bf16(kf[0], QR(0), f32x16{}, 0, 0, 0), P0[2], P0[3], P0[4], P0[5],     pw0[0] = PKW(P0, 0), pw0[1] = PKW(P0, 2), pw0); \
    VRD(4); SBAR(); GAPA(C1 = __builtin_amdgcn_mfma_f32_32x32x16_bf16(kf[1], QR(0), f32x16{}, 0, 0, 0), P0[6], P0[7], P0[8], P0[9],     pw0[2] = PKW(P0, 4), pw0[3] = PKW(P0, 6), pw0); \
    VRD(1); SBAR(); GAPA(C0 = __builtin_amdgcn_mfma_f32_32x32x16_bf16(kf[2], QR(1), C0, 0, 0, 0),   P0[10], P0[11], P0[12], P0[13], pw1[0] = PKW(P0, 8), pw1[1] = PKW(P0, 10), pw1); \
    VRD(5); SBAR(); GAPA(C1 = __builtin_amdgcn_mfma_f32_32x32x16_bf16(kf[3], QR(1), C1, 0, 0, 0),   P0[14], P0[15], P1[0], P1[1],   pw1[2] = PKW(P0, 12), pw1[3] = PKW(P0, 14), pw1); \
    VRD(2); SBAR(); GAPA(C0 = __builtin_amdgcn_mfma_f32_32x32x16_bf16(kf[4], QR(2), C0, 0, 0, 0),   P1[2], P1[3], P1[4], P1[5],     pw2[0] = PKW(P1, 0), pw2[1] = PKW(P1, 2), pw2); \
    VRD(6); SBAR(); GAPA(C1 = __builtin_amdgcn_mfma_f32_32x32x16_bf16(kf[5], QR(2), C1, 0, 0, 0),   P1[6], P1[7], P1[8], P1[9],     pw2[2] = PKW(P1, 4), pw2[3] = PKW(P1, 6), pw2); \
    VRD(3); SBAR(); GAPA(C0 = __builtin_amdgcn_mfma_f32_32x32x16_bf16(kf[6], QR(3), C0, 0, 0, 0),   P1[10], P1[11], P1[12], P1[13], pw3[0] = PKW(P1, 8), pw3[1] = PKW(P1, 10), pw3); \
    VRD(7); SBAR(); GAPA(C1 = __builtin_amdgcn_mfma_f32_32x32x16_bf16(kf[7], QR(3), C1, 0, 0, 0),   P1[14], P1[15], 0.f, 0.f,       pw3[2] = PKW(P1, 12), pw3[3] = PKW(P1, 14), pw3); \
    l_reg += sacc; \
    _Pragma("unroll") for (int r = 0; r < 16; ++r) { C0[r] -= mhat; C1[r] -= mhat; } \
    if (GK) { DMA_K((t) + 3, sl_cur); } if (GV) { DMA_V((t) + 1, sl_next); } \
    CMASK(C0, C1, t); \
    { float a = MX3(C0[0], C0[1], C1[0]), b = MX3(C0[2], C0[3], C1[1]); a = MX3(a, C1[2], C1[3]); \
      _Pragma("unroll") for (int r = 4; r < 16; r += 4) { a = MX3(a, C0[r], C0[r + 1]); b = MX3(b, C0[r + 2], C0[r + 3]); a = MX3(a, C1[r], C1[r + 1]); b = MX3(b, C1[r + 2], C1[r + 3]); } \
      float rm = __builtin_fmaxf(a, b); { auto rr = __builtin_amdgcn_permlane32_swap(__float_as_uint(rm), __float_as_uint(rm), false, false); rm = __builtin_fmaxf(__uint_as_float(rr[0]), __uint_as_float(rr[1])); } \
      resc = false; \
      if (__builtin_expect(__any(rm > (float)THRL), 0)) { const float dl = __builtin_fmaxf(rm, 0.f); mhat += dl; \
        _Pragma("unroll") for (int r = 0; r < 16; ++r) { C0[r] -= dl; C1[r] -= dl; } \
        const float f = __builtin_amdgcn_exp2f(-dl); l_reg *= f; if (hi == 0) wsf[r32] = f; resc = true; } } \
    SBAR(); \
    GAPC(o[0] = __builtin_amdgcn_mfma_f32_32x32x16_bf16(PAF(0), VFR(0), o[0], 0, 0, 0), C0, 0, VRD2(0)); \
    GAPC(o[1] = __builtin_amdgcn_mfma_f32_32x32x16_bf16(PAF(0), VFR(4), o[1], 0, 0, 0), C0, 2, VRD2(4)); \
    KRD(GL, 0); GAPC(o[0] = __builtin_amdgcn_mfma_f32_32x32x16_bf16(PAF(1), VFR(1), o[0], 0, 0, 0), C0, 4, VRD2(1)); \
    KRD(GL, 1); GAPC(o[1] = __builtin_amdgcn_mfma_f32_32x32x16_bf16(PAF(1), VFR(5), o[1], 0, 0, 0), C0, 6, VRD2(5)); \
    KRD(GL, 2); GAPC(o[0] = __builtin_amdgcn_mfma_f32_32x32x16_bf16(PAF(2), VFR(2), o[0], 0, 0, 0), C0, 8, VRD2(2)); \
    KRD(GL, 3); GAPC(o[1] = __builtin_amdgcn_mfma_f32_32x32x16_bf16(PAF(2), VFR(6), o[1], 0, 0, 0), C0, 10, VRD2(6)); \
    GAPC(o[0] = __builtin_amdgcn_mfma_f32_32x32x16_bf16(PAF(3), VFR(3), o[0], 0, 0, 0), C0, 12, VRD2(3)); \
    GAPC(o[1] = __builtin_amdgcn_mfma_f32_32x32x16_bf16(PAF(3), VFR(7), o[1], 0, 0, 0), C0, 14, VRD2(7)); \
    GAPC(o[2] = __builtin_amdgcn_mfma_f32_32x32x16_bf16(PAF(0), VFR(0), o[2], 0, 0, 0), C1, 0, (void)0); \
    GAPC(o[3] = __builtin_amdgcn_mfma_f32_32x32x16_bf16(PAF(0), VFR(4), o[3], 0, 0, 0), C1, 2, (void)0); \
    GAPC(o[2] = __builtin_amdgcn_mfma_f32_32x32x16_bf16(PAF(1), VFR(1), o[2], 0, 0, 0), C1, 4, (void)0); \
    GAPC(o[3] = __builtin_amdgcn_mfma_f32_32x32x16_bf16(PAF(1), VFR(5), o[3], 0, 0, 0), C1, 6, (void)0); \
    GAPC(o[2] = __builtin_amdgcn_mfma_f32_32x32x16_bf16(PAF(2), VFR(2), o[2], 0, 0, 0), C1, 8, (void)0); \
    GAPC(o[3] = __builtin_amdgcn_mfma_f32_32x32x16_bf16(PAF(2), VFR(6), o[3], 0, 0, 0), C1, 10, (void)0); \
    GAPC(o[2] = __builtin_amdgcn_mfma_f32_32x32x16_bf16(PAF(3), VFR(3), o[2], 0, 0, 0), C1, 12, (void)0); \
    GAPC(o[3] = __builtin_amdgcn_mfma_f32_32x32x16_bf16(PAF(3), VFR(7), o[3], 0, 0, 0), C1, 14, (void)0); \
    } while (0)
  int t = 1;
  #undef CMASK
  #define CMASK(P0, P1, t) do {} while (0)
  for (; t + 5 < NT; t += 2) {
    STEP(pB0, pB1, pA0, pA1, t, true, true, true);     WAIT_BAR(3); RESC(); ROT();
    STEP(pA0, pA1, pB0, pB1, t + 1, true, true, true); WAIT_BAR(3); RESC(); ROT();
  }
  #undef CMASK
  #define CMASK(P0, P1, t) do { int jb_ = (t) - (NT - 4); if (jb_ >= 0) cmask(P0, P1, jb_, qrel, hi); } while (0)
  #define ENDW(tt) do { if ((tt) + 3 < NT) { WAIT_BAR(3); } else if ((tt) + 2 < NT) { WAIT_BAR(2); } else { WAIT_BAR(0); } } while (0)
  for (; t + 1 < NT; t += 2) {
    STEP(pB0, pB1, pA0, pA1, t, (t + 3 < NT), (t + 1 < NT), (t + 1 < NT));         ENDW(t);     RESC(); ROT();
    STEP(pA0, pA1, pB0, pB1, t + 1, (t + 4 < NT), (t + 2 < NT), (t + 2 < NT));     ENDW(t + 1); RESC(); ROT();
  }
  STEP(pB0, pB1, pA0, pA1, NT - 1, false, false, false); RESC();
  { float sacc = pB0[0] + pB0[1]; _Pragma("unroll") for (int r = 2; r < 16; ++r) sacc += pB0[r]; _Pragma("unroll") for (int r = 0; r < 16; ++r) sacc += pB1[r]; l_reg += sacc;
    pw0 = (u32x4){PKW(pB0, 0), PKW(pB0, 2), PKW(pB0, 4), PKW(pB0, 6)}; pw1 = (u32x4){PKW(pB0, 8), PKW(pB0, 10), PKW(pB0, 12), PKW(pB0, 14)}; pw2 = (u32x4){PKW(pB1, 0), PKW(pB1, 2), PKW(pB1, 4), PKW(pB1, 6)}; pw3 = (u32x4){PKW(pB1, 8), PKW(pB1, 10), PKW(pB1, 12), PKW(pB1, 14)};
    SBAR(); pv(o, vb0 + 2 * sl_cur, PAF(0), PAF(1), PAF(2), PAF(3)); pv(o + 2, vb0 + 2 * sl_cur + 8192, PAF(0), PAF(1), PAF(2), PAF(3)); }
  #undef PKW
  #undef PAF
  #undef VFR
  #undef PIN
  #undef MX3
  #undef GAPA
  #undef GAPB
  #undef GAPC
  #undef EX
  #undef VRD
  #undef VRD2
  #undef KRD
  #undef STEP
  #undef ENDW
  { auto rr = __builtin_amdgcn_permlane32_swap(__float_as_uint(l_reg), __float_as_uint(l_reg), false, false); l_reg = __uint_as_float(rr[0]) + __uint_as_float(rr[1]); }
  if (hi == 0) wsf[32 + r32] = l_reg; asm volatile("s_waitcnt lgkmcnt(0)" ::: "memory");
  float rli[16];
  #pragma unroll
  for (int r = 0; r < 16; ++r) rli[r] = __builtin_amdgcn_rcpf(wsf[32 + crow(r, hi)]);
  bf16* Ow = Oh + (rowbase + q0 + wid * QBLK) * PO;
  { bf16* stg = (bf16*)(shm + LDS_OST2) + wid * 2048;
    int te_ = threadIdx.x; asm volatile("" : "+v"(te_)); const int lane = te_ & 63;
    #pragma unroll
    for (int hv = 0; hv < 2; ++hv) {
      #pragma unroll
      for (int r = 0; r < 16; ++r) { const int orow = crow(r, hi);
        #pragma unroll
        for (int d0 = 0; d0 < 2; ++d0) stg[orow * 64 + d0 * 32 + r32] = __float2bfloat16(o[2 * hv + d0][r] * rli[r]); }
      asm volatile("s_waitcnt lgkmcnt(0)" ::: "memory");
      #pragma unroll
      for (int i = 0; i < 4; ++i) { const int row = i * 8 + (lane >> 3), ch = lane & 7; const u32x4 v = *(const u32x4*)(stg + row * 64 + ch * 8); ATTN_STORE16(Ow + (long)row * PO + hv * 64 + ch * 8, v); }
      asm volatile("s_waitcnt lgkmcnt(0)" ::: "memory");
    } }
  asm volatile("s_waitcnt lgkmcnt(0)\n\ts_barrier" ::: "memory");
  #undef QR
  #undef DMA_K
  #undef DMA_V
  #undef CMASK
  #undef START
  #undef RESC
  #undef ROT
}
__device__ __forceinline__ void attn_phase128(char* lds, const bf16_t* proj, bf16_t* att, int G, int vcu) {
  for (int i = 0;; ++i) {
    const int L = i * G + vcu; if (L >= 512) break;
    const int k = L >> 8, w = L & 255, ph = w >> 2, sq = w & 3;
    const int qb = (k == 0) ? (7 - sq) : sq;
    const int b = ph >> 4, rem = ph & 15, h = rem >> 1, c = rem & 1;
    const bf16* P = (const bf16*)proj;
    attn_unit128<8>((long)b * SEQ, qb, P + C_Q + (2 * h + c) * 64, P + C_K + (2 * h + c) * 64, P + C_V + h * 128, (bf16*)att + c * 1024 + h * 128, lds);
  }
}

__device__ __forceinline__ void attn_phase(char* lds, const bf16_t* proj, bf16_t* att, int G, int vcu) {
  for (int i = 0;; ++i) {
    const int L = i * G + vcu; if (L >= 1024) break;
    const int k = L >> 8, w = L & 255, ph = w >> 1, set = w & 1;
    const int qb = (k == 0) ? (7 - set) : (k == 1) ? set : (k == 2) ? (4 + set) : (3 - set);
    const int b = ph >> 5, rem = ph & 31, h = rem >> 2, c = (rem >> 1) & 1, vh = rem & 1;
    const bf16* P = (const bf16*)proj;
    attn_unit<8>((long)b * SEQ, qb, P + C_Q + (2 * h + c) * 64, P + C_K + (2 * h + c) * 64, P + C_V + h * 128 + vh * 64, (bf16*)att + c * 1024 + h * 128 + vh * 64, lds);
  }
}
#undef SBAR
#undef WAIT_BAR
}

#define XB_TMO      128
#define XB_XCNT(j)  (256  + 64 * (j))
#define XB_XSUB(j)  (1280 + 64 * (j))
#define XB_XGEN(j)  (2304 + 64 * (j))
#define XB_TOP      3328
#define XB_TOPGEN   3392
#define XCD_BAR_WORDS 3456
#define XB_SPIN_CAP (1u << 18)
__device__ __forceinline__ unsigned xb_ld(unsigned* p)              { return __hip_atomic_load(p, __ATOMIC_RELAXED, __HIP_MEMORY_SCOPE_AGENT); }
__device__ __forceinline__ unsigned xb_add(unsigned* p, unsigned v) { return __hip_atomic_fetch_add(p, v, __ATOMIC_RELAXED, __HIP_MEMORY_SCOPE_AGENT); }
__device__ __forceinline__ unsigned xb_xcc_id() { return (unsigned)__builtin_amdgcn_s_getreg((3 << 11) | 20) & 0xFu; }
#define XB_SPIN(cond, bar) do { unsigned _sp = 0; while (cond) { __builtin_amdgcn_s_sleep(1); \
    if ((++_sp & 255u) == 0u) { if (xb_ld(&(bar)[XB_TMO])) break; if (_sp > XB_SPIN_CAP) { atomicAdd(&(bar)[XB_TMO], 1u); break; } } } } while (0)
struct XcdBarrier { unsigned* bar; unsigned x; volatile LAS unsigned* st; };
__device__ __forceinline__ XcdBarrier xcd_barrier_post(unsigned* bar, volatile LAS unsigned* st) {
    XcdBarrier b; b.bar = bar; b.x = xb_xcc_id(); b.st = st;
    if (threadIdx.x == 0) (void)xb_add(&bar[XB_XCNT(b.x)], 1u);
    return b;
}
__device__ __forceinline__ void xcd_barrier_complete(unsigned* bar, unsigned x, unsigned& nloc, unsigned& nx) {
    const unsigned G = gridDim.x * gridDim.y * gridDim.z;
    unsigned sum, cnt, mine, sp = 0u;
    for (;;) {
        sum = 0u; cnt = 0u; mine = 0u;
#pragma unroll
        for (unsigned j = 0; j < 16; ++j) { const unsigned c = xb_ld(&bar[XB_XCNT(j)]); sum += c; cnt += (c > 0u) ? 1u : 0u; mine = (j == x) ? c : mine; }
        if (sum == G) break;
        __builtin_amdgcn_s_sleep(1);
        if ((++sp & 255u) == 0u) { if (xb_ld(&bar[XB_TMO])) break; if (sp > XB_SPIN_CAP) { atomicAdd(&bar[XB_TMO], 1u); break; } }
    }
    nloc = mine > 0u ? mine : 1u; nx = cnt > 0u ? cnt : 1u;
}
__device__ __forceinline__ void xcd_barrier(const XcdBarrier& b) {
    asm volatile("s_waitcnt vmcnt(0)" ::: "memory");
    __syncthreads();
    if (threadIdx.x == 0) {
        unsigned* bar = b.bar;
        __builtin_amdgcn_s_waitcnt(0);
        unsigned nloc = b.st[0], nx = b.st[1];
        if (nloc == 0u) { xcd_barrier_complete(bar, b.x, nloc, nx); b.st[0] = nloc; b.st[1] = nx; }
        const unsigned old = xb_add(&bar[XB_XSUB(b.x)], 1u);
        const unsigned gen = old / nloc;
        if (old + 1u == (gen + 1u) * nloc) {
            __builtin_amdgcn_fence(__ATOMIC_RELEASE, "agent");
            asm volatile("s_waitcnt vmcnt(0)" ::: "memory");
            const unsigned og = xb_add(&bar[XB_TOP], 1u);
            const unsigned tg = og / nx;
            if (og + 1u == (tg + 1u) * nx) xb_add(&bar[XB_TOPGEN], 1u);
            else XB_SPIN(xb_ld(&bar[XB_TOPGEN]) == tg, bar);
            __builtin_amdgcn_fence(__ATOMIC_ACQUIRE, "agent");
            xb_add(&bar[XB_XGEN(b.x)], 1u);
            asm volatile("s_waitcnt vmcnt(0)" ::: "memory");
        } else {
            XB_SPIN(xb_ld(&bar[XB_XGEN(b.x)]) == gen, bar);
            __builtin_amdgcn_fence(__ATOMIC_ACQUIRE, "agent");
            asm volatile("s_waitcnt vmcnt(0)" ::: "memory");
        }
    }
    __syncthreads();
}

struct Ptrs {
    const float* in[24]; float* out; unsigned char* ws;
};
__device__ __forceinline__ void p0_transpose_item(const float* W, int K, int N, int Nvalid, bf16_t* WT, LAS float* scr, int item, int nblk, int lane) {
    const int kb = item / nblk, nb = item % nblk, k0 = 64 * kb, n0 = 32 * nb;
    const int nn = n0 + (lane & 31); const bool ok = nn < Nvalid;
    float v[32];
#pragma unroll
    for (int i = 0; i < 32; ++i) { const int kk = 2 * i + (lane >> 5); v[i] = ok ? W[(size_t)(k0 + kk) * N + nn] : 0.f; }
#pragma unroll
    for (int i = 0; i < 32; ++i) { const int kk = 2 * i + (lane >> 5); scr[kk * 33 + (lane & 31)] = v[i]; }
    LDS_WAIT(); asm volatile("" ::: "memory");
    const int c = lane & 7;
#pragma unroll
    for (int j = 0; j < 4; ++j) { const int n = (lane >> 3) + 8 * j; const LAS float* s = scr + (8 * c) * 33 + n;
        u32x4 o; o.x = cvt_pk_bf16(s[0 * 33], s[1 * 33]); o.y = cvt_pk_bf16(s[2 * 33], s[3 * 33]); o.z = cvt_pk_bf16(s[4 * 33], s[5 * 33]); o.w = cvt_pk_bf16(s[6 * 33], s[7 * 33]);
        *(u32x4*)(WT + (size_t)(n0 + n) * K + k0 + 8 * c) = o; }
    LDS_WAIT(); asm volatile("" ::: "memory");
}
__device__ __forceinline__ void p0_prologue(const Ptrs& P, LAS unsigned char* lds, int gw, int NGW, int wave) {
    int tq_ = threadIdx.x; asm volatile("" : "+v"(tq_)); const int lane = tq_ & 63;
    LAS float* scr = (LAS float*)(lds + wave * 16384);
    unsigned char* ws = P.ws;
    constexpr int I_IN = 32 * (NPROJP / 32), I_OUT = 32 * 64;
    constexpr int NITEMS = I_IN + I_OUT;
    for (int it = gw; it < NITEMS; it += NGW) {
        int r = it;
        if (r < I_IN) { p0_transpose_item(P.in[3], DM, NPROJ, NPROJ, (bf16_t*)(ws + WS_WIN), scr, r, NPROJP / 32, lane); continue; } r -= I_IN;
        p0_transpose_item(P.in[15], DM, DM, DM, (bf16_t*)(ws + WS_WOUT), scr, r, 64, lane);
    }
    const float* x = P.in[0]; const float* nw = P.in[2]; bf16_t* XN = (bf16_t*)(ws + WS_XN);
    for (int m = gw; m < NTOK; m += NGW) {
        const f32x4* xr = (const f32x4*)(x + (size_t)m * DM) + lane; f32x4 v[8]; float s = 0.f;
#pragma unroll
        for (int j = 0; j < 8; ++j) { v[j] = xr[64 * j]; s += (v[j].x * v[j].x + v[j].y * v[j].y) + (v[j].z * v[j].z + v[j].w * v[j].w); }
        const float rstd = 1.0f / sqrtf(wave_sum(s) * (1.f / DM) + EPS);
        u32x2* o8 = (u32x2*)(XN + (size_t)m * DM) + lane;
#pragma unroll
        for (int j = 0; j < 8; ++j) { const f32x4 w = ((const f32x4*)nw)[lane + 64 * j]; u32x2 o; o.x = cvt_pk_bf16(v[j].x * rstd * w.x, v[j].y * rstd * w.y); o.y = cvt_pk_bf16(v[j].z * rstd * w.z, v[j].w * rstd * w.w); o8[64 * j] = o; }
    }
    const int* pos = (const int*)P.in[1]; float* rope = (float*)(ws + WS_ROPE);
    for (int idx = gw * 64 + lane; idx < NTOK * 8; idx += NGW * 64) {
        const int t = idx >> 3, i = idx & 7;
        const float inv = powf(500000.0f, -(float)(2 * i) / 16.0f);
        const float ang = (float)pos[t] * inv;
        rope[t * 16 + i] = (float)cos((double)ang); rope[t * 16 + 8 + i] = (float)sin((double)ang);
    }
}

constexpr int SP = 272;
constexpr int L_BN = 0, L_CN = 128 * SP, L_BT = 2 * 128 * SP, L_XT = 3 * 128 * SP, L_DT = L_XT + 64 * SP, L_CSV = L_DT + 512, L_DA = L_CSV + 512;
static_assert(L_DA + 512 <= RING_BYTES, "ssd lds");
static_assert(VAN_OFF + 512 * 16 <= BIAS_OFF && BIAS_OFF + 2048 <= LDS_BYTES, "lds map");
__device__ __forceinline__ int crow16(int r, int hi) { return (r & 3) + 8 * (r >> 2) + 4 * hi; }
template <bool SWA, bool SWB>
__device__ __forceinline__ f32x16 mm32_k128(const LAS unsigned char* As, int m0, const LAS unsigned char* Bs, int n0, int r32, int hi) {
    f32x16 acc = f32x16{};
    const int ra = m0 + r32, rbw = n0 + r32, xa = SWA ? ((ra >> 3) & 15) : 0, xb = SWB ? ((rbw >> 3) & 15) : 0;
#pragma unroll
    for (int k0 = 0; k0 < 128; k0 += 16) {
        const int kc = (k0 >> 3) + hi;
        const bf16x8 a = *(const LAS bf16x8*)(As + ra * SP + ((kc ^ xa) << 4));
        const bf16x8 b = *(const LAS bf16x8*)(Bs + rbw * SP + ((kc ^ xb) << 4));
        acc = __builtin_amdgcn_mfma_f32_32x32x16_bf16(a, b, acc, 0, 0, 0);
    }
    return acc;
}
constexpr int LA_BN = 0, LA_CN = 128 * SP, LA_BT = 2 * 128 * SP, LA_XT1 = LA_CN, LA_XT2 = LA_CN + 64 * SP, LA_DT = 3 * 128 * SP, LA_CSV = LA_DT + 2048, LA_TMP = LA_CSV + 2048;
static_assert(LA_TMP + 64 <= RING_BYTES, "ssd-a lds");
__device__ __forceinline__ void ssd_a_unit(const Ptrs& P, LAS unsigned char* lds, int b, int c, int g, int hh) {
    int tid = threadIdx.x; asm volatile("" : "+v"(tid));
    const int lane = tid & 63, wid = __builtin_amdgcn_readfirstlane(tid >> 6), r32 = lane & 31, hi = lane >> 5;
    unsigned char* ws = P.ws;
    const bf16_t* proj = (const bf16_t*)(ws + WS_PROJ);
    const float* dtraw = (const float*)(ws + WS_DTRAW);
    float* CS = (float*)(ws + WS_CS);
    const float* conv_w = P.in[9]; const float* conv_b = P.in[10];
    bf16_t* XCONV = (bf16_t*)(ws + WS_XCONV); bf16_t* CCONV = (bf16_t*)(ws + WS_CCONV);
    const int row0 = b * SEQ + c * 128, h0 = g * 8 + hh * 4;
    LAS float* sDT = (LAS float*)(lds + LA_DT); LAS float* sCS = (LAS float*)(lds + LA_CSV); LAS float* sTMP = (LAS float*)(lds + LA_TMP);
    const int hq = wid >> 1, stp = tid & 127;
    const float raw_q = dtraw[(size_t)(row0 + stp) * 16 + h0 + hq];
    if (tid < 384) {
        const int rb = tid >> 5, grp = tid & 31;
        const int ch = grp < 16 ? 1024 + g * 128 + 8 * grp : 1280 + g * 128 + 8 * (grp - 16);
        const int l0 = rb * 11, nrow = (l0 + 11 <= 128) ? 11 : 128 - l0;
        u32x4 v[14];
#pragma unroll
        for (int j = 0; j < 14; ++j) {
            const int ls = c * 128 + l0 - 3 + j;
            v[j] = (ls >= 0 && j < nrow + 3) ? *(const u32x4*)(proj + (size_t)(b * SEQ + ls) * NPROJP + C_XBC + ch) : (u32x4){0u, 0u, 0u, 0u};
        }
        f32x4 w[4][2];
#pragma unroll
        for (int j = 0; j < 4; ++j) { w[j][0] = *(const f32x4*)(conv_w + j * 1536 + ch); w[j][1] = *(const f32x4*)(conv_w + j * 1536 + ch + 4); }
        const f32x4 cb0 = *(const f32x4*)(conv_b + ch), cb1 = *(const f32x4*)(conv_b + ch + 4);
#pragma unroll
        for (int r = 0; r < 11; ++r) {
            if (r < nrow) {
                const int l = l0 + r;
                float a[8] = {cb0.x, cb0.y, cb0.z, cb0.w, cb1.x, cb1.y, cb1.z, cb1.w};
#pragma unroll
                for (int j = 0; j < 4; ++j) {
                    const u32x4 x = v[r + j];
                    a[0] += w[j][0].x * bf_lo(x.x); a[1] += w[j][0].y * bf_hi(x.x); a[2] += w[j][0].z * bf_lo(x.y); a[3] += w[j][0].w * bf_hi(x.y);
                    a[4] += w[j][1].x * bf_lo(x.z); a[5] += w[j][1].y * bf_hi(x.z); a[6] += w[j][1].z * bf_lo(x.w); a[7] += w[j][1].w * bf_hi(x.w);
                }
#pragma unroll
                for (int q = 0; q < 8; ++q) a[q] = a[q] * sigmoidf_(a[q]);
                u32x4 pk; pk.x = cvt_pk_bf16(a[0], a[1]); pk.y = cvt_pk_bf16(a[2], a[3]); pk.z = cvt_pk_bf16(a[4], a[5]); pk.w = cvt_pk_bf16(a[6], a[7]);
                if (grp < 16) {
                    const int n0 = 8 * grp;
                    *(LAS u32x4*)(lds + LA_BN + l * SP + n0 * 2) = pk;
                    const unsigned tb = (unsigned)(LA_BT + n0 * SP + (((l >> 3) ^ grp) << 4) + (l & 7) * 2);
                    *(LAS bf16_t*)(lds + tb + 0 * SP) = (bf16_t)(pk.x & 0xffffu); *(LAS bf16_t*)(lds + tb + 1 * SP) = (bf16_t)(pk.x >> 16);
                    *(LAS bf16_t*)(lds + tb + 2 * SP) = (bf16_t)(pk.y & 0xffffu); *(LAS bf16_t*)(lds + tb + 3 * SP) = (bf16_t)(pk.y >> 16);
                    *(LAS bf16_t*)(lds + tb + 4 * SP) = (bf16_t)(pk.z & 0xffffu); *(LAS bf16_t*)(lds + tb + 5 * SP) = (bf16_t)(pk.z >> 16);
                    *(LAS bf16_t*)(lds + tb + 6 * SP) = (bf16_t)(pk.w & 0xffffu); *(LAS bf16_t*)(lds + tb + 7 * SP) = (bf16_t)(pk.w >> 16);
                } else {
                    const int n0 = 8 * (grp - 16);
                    *(LAS u32x4*)(lds + LA_CN + l * SP + n0 * 2) = pk;
                    if (hh == 0) *(u32x4*)(CCONV + (size_t)(row0 + l) * 256 + g * 128 + n0) = pk;
                }
            }
        }
    }
    __syncthreads();
    f32x16 cbt[2];
#pragma unroll
    for (int q = 0; q < 2; ++q) { const int t = wid * 2 + q, mi = t >> 2, ni = t & 3; cbt[q] = mm32_k128<false, false>(lds + LA_CN, 32 * mi, lds + LA_BN, 32 * ni, r32, hi); }
    {
        const int h = h0 + hq;
        const float raw = raw_q + P.in[11][h];
        const float dtv = raw > 20.f ? raw : log1pf(expf(raw));
        float s_ = dtv * (-expf(P.in[12][h]));
#pragma unroll
        for (int o = 1; o < 64; o <<= 1) { const float t = __shfl_up(s_, o); if (lane >= o) s_ += t; }
        if ((tid & 127) == 63) sTMP[hq] = s_;
        __syncthreads();
        if (tid & 64) s_ += sTMP[hq];
        sDT[hq * 128 + stp] = dtv; sCS[hq * 128 + stp] = s_; CS[(size_t)(row0 + stp) * 16 + h] = s_;
        __syncthreads();
    }
#pragma unroll 1
    for (int i = 0; i < 4; ++i) {
        const int h = h0 + i;
        const int l2 = tid >> 3, grp = tid & 7, chx = h * 64 + 8 * grp, lx = 2 * l2;
        u32x4 xv[5];
#pragma unroll
        for (int j = 0; j < 5; ++j) { const int ls = c * 128 + lx - 3 + j; xv[j] = (ls >= 0) ? *(const u32x4*)(proj + (size_t)(b * SEQ + ls) * NPROJP + C_XBC + chx) : (u32x4){0u, 0u, 0u, 0u}; }
        LAS float* sDTh = sDT + i * 128; LAS float* sCSh = sCS + i * 128;
        const float cs_last = sCSh[127];
        {
            f32x4 w[4][2];
#pragma unroll
            for (int j = 0; j < 4; ++j) { w[j][0] = *(const f32x4*)(conv_w + j * 1536 + chx); w[j][1] = *(const f32x4*)(conv_w + j * 1536 + chx + 4); }
            const f32x4 cb0 = *(const f32x4*)(conv_b + chx), cb1 = *(const f32x4*)(conv_b + chx + 4);
#pragma unroll
            for (int r = 0; r < 2; ++r) {
                const int l = lx + r;
                float a[8] = {cb0.x, cb0.y, cb0.z, cb0.w, cb1.x, cb1.y, cb1.z, cb1.w};
#pragma unroll
                for (int j = 0; j < 4; ++j) {
                    const u32x4 x = xv[r + j];
                    a[0] += w[j][0].x * bf_lo(x.x); a[1] += w[j][0].y * bf_hi(x.x); a[2] += w[j][0].z * bf_lo(x.y); a[3] += w[j][0].w * bf_hi(x.y);
                    a[4] += w[j][1].x * bf_lo(x.z); a[5] += w[j][1].y * bf_hi(x.z); a[6] += w[j][1].z * bf_lo(x.w); a[7] += w[j][1].w * bf_hi(x.w);
                }
#pragma unroll
                for (int q = 0; q < 8; ++q) a[q] = a[q] * sigmoidf_(a[q]);
                u32x4 pk; pk.x = cvt_pk_bf16(a[0], a[1]); pk.y = cvt_pk_bf16(a[2], a[3]); pk.z = cvt_pk_bf16(a[4], a[5]); pk.w = cvt_pk_bf16(a[6], a[7]);
                *(u32x4*)(XCONV + (size_t)(row0 + l) * 1024 + chx) = pk;
                const float dt = sDTh[l], dw = dt * fexp(cs_last - sCSh[l]);
                const unsigned tb = (unsigned)((8 * grp) * SP + (((l >> 3) ^ grp) << 4) + (l & 7) * 2);
#pragma unroll
                for (int q = 0; q < 8; q += 2) {
                    const unsigned p1 = cvt_pk_bf16(a[q] * dt, a[q + 1] * dt), p2 = cvt_pk_bf16(a[q] * dw, a[q + 1] * dw);
                    *(LAS bf16_t*)(lds + LA_XT1 + tb + q * SP) = (bf16_t)(p1 & 0xffffu); *(LAS bf16_t*)(lds + LA_XT1 + tb + (q + 1) * SP) = (bf16_t)(p1 >> 16);
                    *(LAS bf16_t*)(lds + LA_XT2 + tb + q * SP) = (bf16_t)(p2 & 0xffffu); *(LAS bf16_t*)(lds + LA_XT2 + tb + (q + 1) * SP) = (bf16_t)(p2 >> 16);
                }
            }
        }
#pragma unroll
        for (int q = 0; q < 2; ++q) {
            const int t = wid * 2 + q, mi = t >> 2, ni = t & 3; const int s_ = 32 * ni + r32; const float css = sCSh[s_];
#pragma unroll
            for (int r = 0; r < 16; ++r) { const int l = 32 * mi + crow16(r, hi); const float m = (s_ <= l) ? cbt[q][r] * fexp(sCSh[l] - css) : 0.f; *(LAS bf16_t*)(lds + LA_BN + l * SP + s_ * 2) = f2bf(m); }
        }
        __syncthreads();
        {
            const int mi = wid >> 2, ni = wid & 3;
            const f32x16 acc = mm32_k128<true, true>(lds + LA_XT2, 32 * mi, lds + LA_BT, 32 * ni, r32, hi);
            float* st = (float*)(ws + WS_STATES) + ((size_t)((b * 16 + c) * 16 + h)) * 8192;
#pragma unroll
            for (int r = 0; r < 16; ++r) st[(32 * mi + crow16(r, hi)) * 128 + 32 * ni + r32] = acc[r];
        }
        {
            const int mi = wid >> 1, ni = wid & 1;
            const f32x16 acc = mm32_k128<false, true>(lds + LA_BN, 32 * mi, lds + LA_XT1, 32 * ni, r32, hi);
            float* yd = (float*)(ws + WS_YDIAG);
#pragma unroll
            for (int r = 0; r < 16; ++r) yd[(size_t)(row0 + 32 * mi + crow16(r, hi)) * 1024 + h * 64 + 32 * ni + r32] = acc[r];
        }
        __syncthreads();
    }
}
__device__ __forceinline__ void ssd_scan(const Ptrs& P, int gtid, int nthr) {
    float* st = (float*)(P.ws + WS_STATES); const float* CS = (const float*)(P.ws + WS_CS);
    for (int e4 = gtid; e4 < NB * 16 * 2048; e4 += nthr) {
        const int bh = e4 >> 11, off = e4 & 2047, b = bh >> 4, h = bh & 15;
        f32x4 sv[16]; float dec[16];
#pragma unroll
        for (int c = 0; c < 16; ++c) { sv[c] = *((const f32x4*)(st + ((size_t)((b * 16 + c) * 16 + h)) * 8192) + off); dec[c] = CS[(size_t)(b * SEQ + c * 128 + 127) * 16 + h]; }
        f32x4 carry = (f32x4){0.f, 0.f, 0.f, 0.f};
#pragma unroll
        for (int c = 0; c < 16; ++c) {
            *((f32x4*)(st + ((size_t)((b * 16 + c) * 16 + h)) * 8192) + off) = carry;
            carry = carry * fexp(dec[c]) + sv[c];
        }
    }
}
constexpr int L2_CS = 0, L2_PV = 64 * SP, L2_Y = L2_PV + 2 * 64 * SP, YP = 1040;
static_assert(L2_Y + 64 * YP <= RING_BYTES, "ssd-c lds");
__device__ __forceinline__ void ssd_c_unit(const Ptrs& P, LAS unsigned char* lds, int b, int c, int g, int rh) {
    int tid = threadIdx.x; asm volatile("" : "+v"(tid));
    const int lane = tid & 63, wid = __builtin_amdgcn_readfirstlane(tid >> 6), r32 = lane & 31, hi = lane >> 5;
    unsigned char* ws = P.ws;
    const int row0 = b * SEQ + c * 128 + rh * 64;
    const bf16_t* CCONV = (const bf16_t*)(ws + WS_CCONV); const bf16_t* XCONV = (const bf16_t*)(ws + WS_XCONV); const bf16_t* proj = (const bf16_t*)(ws + WS_PROJ);
    const float* st = (const float*)(ws + WS_STATES); const float* CS = (const float*)(ws + WS_CS); const float* yd = (const float*)(ws + WS_YDIAG);
    bf16_t* CAT = (bf16_t*)(ws + WS_CAT);
    for (int q = tid; q < 64 * 16; q += 512) { const int l = q >> 4, n8 = q & 15; *(LAS u32x4*)(lds + L2_CS + l * SP + n8 * 16) = *(const u32x4*)(CCONV + (size_t)(row0 + l) * 256 + g * 128 + n8 * 8); }
    const int hw = wid >> 2, tile = wid & 3, mi = tile >> 1, ni = tile & 1;
    for (int hp = 0; hp < 4; ++hp) {
        __syncthreads();
        const int h0 = g * 8 + 2 * hp;
        const int h = h0 + hw;
        const unsigned rowA = (unsigned)(row0 + 32 * mi + 4 * hi), col = (unsigned)(h * 64 + 32 * ni + r32);
        float e_yd[16], e_cs[16]; bf16_t e_xc[16], e_z[16];
#pragma unroll
        for (int r = 0; r < 16; ++r) { const unsigned row = rowA + 8 * (r >> 2) + (r & 3);
            e_yd[r] = yd[row * 1024u + col]; e_cs[r] = CS[row * 16u + (unsigned)h]; e_xc[r] = XCONV[row * 1024u + col]; e_z[r] = proj[row * (unsigned)NPROJP + (unsigned)C_Z + col]; }
#pragma unroll
        for (int q = 0; q < 4; ++q) {
            const int idx = tid + 512 * q, hh = idx >> 10, rem = idx & 1023, p = rem >> 4, n8 = rem & 15;
            const float* src = st + ((size_t)((b * 16 + c) * 16 + h0 + hh)) * 8192 + p * 128 + n8 * 8;
            const f32x4 v0 = *(const f32x4*)src, v1 = *(const f32x4*)(src + 4);
            u32x4 pk; pk.x = cvt_pk_bf16(v0.x, v0.y); pk.y = cvt_pk_bf16(v0.z, v0.w); pk.z = cvt_pk_bf16(v1.x, v1.y); pk.w = cvt_pk_bf16(v1.z, v1.w);
            *(LAS u32x4*)(lds + L2_PV + (hh * 64 + p) * SP + n8 * 16) = pk;
        }
        __syncthreads();
        const f32x16 acc = mm32_k128<false, false>(lds + L2_CS, 32 * mi, lds + L2_PV + hw * 64 * SP, 32 * ni, r32, hi);
        const float dsk = P.in[13][h];
        const unsigned ybase = (unsigned)(L2_Y + (32 * mi + 4 * hi) * YP + ((2 * hp + hw) * 64 + 32 * ni + r32) * 2);
#pragma unroll
        for (int r = 0; r < 16; ++r) {
            float y = acc[r] * fexp(e_cs[r]) + e_yd[r] + dsk * bf2f(e_xc[r]);
            const float z = bf2f(e_z[r]);
            y *= z * sigmoidf_(z);
            *(LAS bf16_t*)(lds + ybase + (8 * (r >> 2) + (r & 3)) * YP) = f2bf(y);
        }
    }
    __syncthreads();
    const float* nw = P.in[14] + g * 512 + 8 * lane;
    const f32x4 nw0 = *(const f32x4*)nw, nw1 = *(const f32x4*)(nw + 4);
    for (int i = 0; i < 8; ++i) {
        const int ll = wid * 8 + i;
        const u32x4 v = *(const LAS u32x4*)(lds + L2_Y + ll * YP + lane * 16);
        float a[8] = {bf_lo(v.x), bf_hi(v.x), bf_lo(v.y), bf_hi(v.y), bf_lo(v.z), bf_hi(v.z), bf_lo(v.w), bf_hi(v.w)};
        float ss = 0.f;
#pragma unroll
        for (int k = 0; k < 8; ++k) ss += a[k] * a[k];
        const float rstd = rsqrtf_(wave_sum(ss) * (1.f / 512.f) + EPS);
        u32x4 o; o.x = cvt_pk_bf16(a[0] * rstd * nw0.x, a[1] * rstd * nw0.y); o.y = cvt_pk_bf16(a[2] * rstd * nw0.z, a[3] * rstd * nw0.w);
        o.z = cvt_pk_bf16(a[4] * rstd * nw1.x, a[5] * rstd * nw1.y); o.w = cvt_pk_bf16(a[6] * rstd * nw1.z, a[7] * rstd * nw1.w);
        *(u32x4*)(CAT + (size_t)(row0 + ll) * DM + 1024 + g * 512 + 8 * lane) = o;
    }
    __syncthreads();
}
__device__ __forceinline__ void attn_post(const Ptrs& P, int gw, int NGW) {
    int tq_ = threadIdx.x; asm volatile("" : "+v"(tq_)); const int lane = tq_ & 63;
    float d1 = 0.f, d2 = 0.f;
    for (int i = 0; i < 64; ++i) { d1 += P.in[4][i] * P.in[5][i]; d2 += P.in[6][i] * P.in[7][i]; }
    const float lam = expf(d1) - expf(d2) + LAM_INIT;
    const bf16_t* ATT = (const bf16_t*)(P.ws + WS_ATT); bf16_t* CAT = (bf16_t*)(P.ws + WS_CAT);
    const float* sw = P.in[8] + (lane & 7) * 16;
    float swv[16];
#pragma unroll
    for (int i = 0; i < 16; ++i) swv[i] = sw[i] * (1.0f - LAM_INIT);
    for (int t0 = gw; t0 < NTOK; t0 += 4 * NGW) {
        u32x4 ld[4][4];
#pragma unroll
        for (int k = 0; k < 4; ++k) { const int t = t0 + k * NGW; if (t < NTOK) {
            const u32x4* p0 = (const u32x4*)(ATT + (size_t)t * 2048 + lane * 16); const u32x4* p1 = (const u32x4*)(ATT + (size_t)t * 2048 + 1024 + lane * 16);
            ld[k][0] = p0[0]; ld[k][1] = p0[1]; ld[k][2] = p1[0]; ld[k][3] = p1[1]; } }
#pragma unroll
        for (int k = 0; k < 4; ++k) { const int t = t0 + k * NGW; if (t < NTOK) {
            const u32x4 a0 = ld[k][0], a1 = ld[k][1], b0 = ld[k][2], b1 = ld[k][3];
            float a[16];
            a[0] = bf_lo(a0.x) - lam * bf_lo(b0.x); a[1] = bf_hi(a0.x) - lam * bf_hi(b0.x); a[2] = bf_lo(a0.y) - lam * bf_lo(b0.y); a[3] = bf_hi(a0.y) - lam * bf_hi(b0.y);
            a[4] = bf_lo(a0.z) - lam * bf_lo(b0.z); a[5] = bf_hi(a0.z) - lam * bf_hi(b0.z); a[6] = bf_lo(a0.w) - lam * bf_lo(b0.w); a[7] = bf_hi(a0.w) - lam * bf_hi(b0.w);
            a[8] = bf_lo(a1.x) - lam * bf_lo(b1.x); a[9] = bf_hi(a1.x) - lam * bf_hi(b1.x); a[10] = bf_lo(a1.y) - lam * bf_lo(b1.y); a[11] = bf_hi(a1.y) - lam * bf_hi(b1.y);
            a[12] = bf_lo(a1.z) - lam * bf_lo(b1.z); a[13] = bf_hi(a1.z) - lam * bf_hi(b1.z); a[14] = bf_lo(a1.w) - lam * bf_lo(b1.w); a[15] = bf_hi(a1.w) - lam * bf_hi(b1.w);
            float ss = 0.f;
#pragma unroll
            for (int i = 0; i < 16; ++i) ss += a[i] * a[i];
            ss += __shfl_xor(ss, 1); ss += __shfl_xor(ss, 2); ss += __shfl_xor(ss, 4);
            const float rstd = rsqrtf_(ss * (1.f / 128.f) + EPS);
            float o[16];
#pragma unroll
            for (int i = 0; i < 16; ++i) o[i] = a[i] * rstd * swv[i];
            u32x4 w0, w1;
            w0.x = cvt_pk_bf16(o[0], o[1]); w0.y = cvt_pk_bf16(o[2], o[3]); w0.z = cvt_pk_bf16(o[4], o[5]); w0.w = cvt_pk_bf16(o[6], o[7]);
            w1.x = cvt_pk_bf16(o[8], o[9]); w1.y = cvt_pk_bf16(o[10], o[11]); w1.z = cvt_pk_bf16(o[12], o[13]); w1.w = cvt_pk_bf16(o[14], o[15]);
            u32x4* op = (u32x4*)(CAT + (size_t)t * DM + lane * 16); op[0] = w0; op[1] = w1; } }
    }
}
constexpr int R_RED = 0, R_SSQ = 8 * 4096, R_LOG = R_SSQ + 8 * 128, R_RSTD = R_LOG + 4096;
__device__ __forceinline__ void router_tile(const Ptrs& P, LAS unsigned char* lds, int tile) {
    int tid = threadIdx.x; asm volatile("" : "+v"(tid));
    const int lane = tid & 63, wid = __builtin_amdgcn_readfirstlane(tid >> 6), tt = lane & 31, kk = lane >> 5;
    unsigned char* ws = P.ws;
    const bf16_t* X1 = (const bf16_t*)(ws + WS_X1); bf16_t* H2 = (bf16_t*)(ws + WS_H2);
    const float* nw = P.in[16]; const float* rw = P.in[17]; const float* rb = P.in[18];
    int* TOPE = (int*)(ws + WS_ROUTE + RT_TOPE); float* TOPG = (float*)(ws + WS_ROUTE + RT_TOPG); int* LRANK = (int*)(ws + WS_ROUTE + RT_LRANK); int* HIST = (int*)(ws + WS_ROUTE + RT_HIST);
    LAS int* lhist = (LAS int*)(lds + LHIST_OFF);
    LAS float* red = (LAS float*)(lds + R_RED); LAS float* ssqp = (LAS float*)(lds + R_SSQ); LAS float* slog = (LAS float*)(lds + R_LOG); LAS float* srstd = (LAS float*)(lds + R_RSTD);
    const int t0 = tile * 32;
    if (tid < 32) lhist[tid] = 0;
    {
        f32x16 acc = f32x16{}; float ssq = 0.f;
        const int r32 = tt, hi = kk;
        const bf16_t* xp = X1 + (size_t)(t0 + r32) * DM + wid * 256 + 8 * hi;
        const float* wp = rw + (size_t)(wid * 256 + 8 * hi) * 32 + r32;
        const float* np = nw + wid * 256 + 8 * hi;
#pragma unroll 4
        for (int i = 0; i < 16; ++i) {
            const u32x4 xa = *(const u32x4*)(xp + 16 * i);
            const f32x4 n0 = *(const f32x4*)(np + 16 * i), n1 = *(const f32x4*)(np + 16 * i + 4);
            float w[8];
#pragma unroll
            for (int jx = 0; jx < 8; ++jx) w[jx] = wp[(16 * i + jx) * 32];
            w[0] *= n0.x; w[1] *= n0.y; w[2] *= n0.z; w[3] *= n0.w; w[4] *= n1.x; w[5] *= n1.y; w[6] *= n1.z; w[7] *= n1.w;
            u32x4 wh, wl;
            wh.x = cvt_pk_bf16(w[0], w[1]); wh.y = cvt_pk_bf16(w[2], w[3]); wh.z = cvt_pk_bf16(w[4], w[5]); wh.w = cvt_pk_bf16(w[6], w[7]);
            wl.x = cvt_pk_bf16(w[0] - bf_lo(wh.x), w[1] - bf_hi(wh.x)); wl.y = cvt_pk_bf16(w[2] - bf_lo(wh.y), w[3] - bf_hi(wh.y));
            wl.z = cvt_pk_bf16(w[4] - bf_lo(wh.z), w[5] - bf_hi(wh.z)); wl.w = cvt_pk_bf16(w[6] - bf_lo(wh.w), w[7] - bf_hi(wh.w));
            const bf16x8 af = __builtin_bit_cast(bf16x8, xa);
            acc = __builtin_amdgcn_mfma_f32_32x32x16_bf16(af, __builtin_bit_cast(bf16x8, wh), acc, 0, 0, 0);
            acc = __builtin_amdgcn_mfma_f32_32x32x16_bf16(af, __builtin_bit_cast(bf16x8, wl), acc, 0, 0, 0);
            const float x0 = bf_lo(xa.x), x1 = bf_hi(xa.x), x2 = bf_lo(xa.y), x3 = bf_hi(xa.y), x4 = bf_lo(xa.z), x5 = bf_hi(xa.z), x6 = bf_lo(xa.w), x7 = bf_hi(xa.w);
            ssq += ((x0 * x0 + x1 * x1) + (x2 * x2 + x3 * x3)) + ((x4 * x4 + x5 * x5) + (x6 * x6 + x7 * x7));
        }
        ssq += __shfl_xor(ssq, 32);
        if (kk == 0) ssqp[wid * 32 + tt] = ssq;
#pragma unroll
        for (int r = 0; r < 16; ++r) red[wid * 1024 + crow16(r, kk) * 32 + tt] = acc[r];
    }
    __syncthreads();
    if (tid < 32) { float s = 0.f;
#pragma unroll
        for (int w = 0; w < 8; ++w) s += ssqp[w * 32 + tid];
        srstd[tid] = rsqrtf_(s * (1.f / DM) + EPS); }
    __syncthreads();
    for (int q = tid; q < 1024; q += 512) { float s = 0.f;
#pragma unroll
        for (int w = 0; w < 8; ++w) s += red[w * 1024 + q];
        slog[q] = s * srstd[q >> 5] + rb[q & 31]; }
    __syncthreads();
#pragma unroll
    for (int it = 0; it < 2; ++it) {
        const int tl = wid * 4 + it * 2 + kk, t = t0 + tl;
        float v = slog[tl * 32 + tt];
        float tv[4]; int te[4];
#pragma unroll
        for (int j = 0; j < 4; ++j) {
            float bv = v; int be = tt;
#pragma unroll
            for (int o = 1; o < 32; o <<= 1) { const float ov = __shfl_xor(bv, o); const int oe = __shfl_xor(be, o); const bool take = (ov > bv) || (ov == bv && oe < be); bv = take ? ov : bv; be = take ? oe : be; }
            tv[j] = bv; te[j] = be; if (tt == be) v = -INFINITY;
        }
        const float e1 = fexp(tv[1] - tv[0]), e2 = fexp(tv[2] - tv[0]), e3 = fexp(tv[3] - tv[0]); const float inv = 1.f / (1.f + e1 + e2 + e3);
        if (tt < 4) {
            const int ej = tt == 0 ? te[0] : tt == 1 ? te[1] : tt == 2 ? te[2] : te[3];
            const float gj = (tt == 0 ? 1.f : tt == 1 ? e1 : tt == 2 ? e2 : e3) * inv;
            const int lr = atomicAdd((int*)(lhist + ej), 1);
            TOPE[t * 4 + tt] = ej; TOPG[t * 4 + tt] = gj; LRANK[t * 4 + tt] = lr;
        }
    }
    {
        u32x2 xb[4][8]; f32x4 wv[8];
#pragma unroll
        for (int q = 0; q < 8; ++q) wv[q] = ((const f32x4*)nw)[lane + 64 * q];
#pragma unroll
        for (int r = 0; r < 4; ++r)
#pragma unroll
            for (int q = 0; q < 8; ++q) xb[r][q] = ((const u32x2*)(X1 + (size_t)(t0 + wid * 4 + r) * DM))[lane + 64 * q];
#pragma unroll
        for (int r = 0; r < 4; ++r) {
            const int tl = wid * 4 + r; const float rs = srstd[tl];
            u32x2* o8 = (u32x2*)(H2 + (size_t)(t0 + tl) * DM) + lane;
#pragma unroll
            for (int q = 0; q < 8; ++q) { const f32x4 x = (f32x4){bf_lo(xb[r][q].x), bf_hi(xb[r][q].x), bf_lo(xb[r][q].y), bf_hi(xb[r][q].y)}; u32x2 o; o.x = cvt_pk_bf16(x.x * rs * wv[q].x, x.y * rs * wv[q].y); o.y = cvt_pk_bf16(x.z * rs * wv[q].z, x.w * rs * wv[q].w); o8[64 * q] = o; }
        }
    }
    __syncthreads();
    if (tid < 32) HIST[tile * 32 + tid] = lhist[tid];
    __syncthreads();
}
__device__ __forceinline__ void route_positions(const Ptrs& P, LAS unsigned char* lds, int tile) {
    unsigned char* ws = P.ws; const int tid = threadIdx.x;
    const int* HIST = (const int*)(ws + WS_ROUTE + RT_HIST); const int* TOPE = (const int*)(ws + WS_ROUTE + RT_TOPE); const int* LRANK = (const int*)(ws + WS_ROUTE + RT_LRANK);
    int* TOKPOS = (int*)(ws + WS_ROUTE + RT_TOKPOS); int* META = (int*)(ws + WS_ROUTE + RT_META); int* ROWTOK = (int*)(ws + WS_ROUTE + RT_ROWTOK);
    LAS int* sh = (LAS int*)lds;
    LAS int* stot = sh + 8192; LAS int* sbase = stot + 32; LAS int* sseg = sbase + 32;
    __syncthreads();
    for (int i = tid; i < 8192; i += 512) sh[i] = HIST[i];
    __syncthreads();
    if (tid < 32) { int tot = 0, base = 0; for (int i = 0; i < 256; ++i) { const int v = sh[i * 32 + tid]; if (i < tile) base += v; tot += v; } stot[tid] = tot; sbase[tid] = base; }
    __syncthreads();
    if (tid == 0) { int s = 0; for (int e = 0; e < 32; ++e) { sseg[e] = s; s += (stot[e] + 255) & ~255; } sseg[32] = s; }
    __syncthreads();
    if (tid < 128) { const int t = tile * 32 + (tid >> 2), j = tid & 3; const int e = TOPE[t * 4 + j]; const int pos = sseg[e] + sbase[e] + LRANK[t * 4 + j]; ROWTOK[pos] = t; TOKPOS[t * 4 + j] = pos; }
    if (tile < 32) { const int e = tile; for (int p = stot[e] + tid; p < ((stot[e] + 255) & ~255); p += 512) ROWTOK[sseg[e] + p] = 0; }
    if (tile == 0) {
        if (tid < 33) META[META_SEG + tid] = sseg[tid];
        if (tid == 0) META[META_NT] = sseg[32] >> 8;
        if (tid < 32) { const int e = tid; for (int T = sseg[e] >> 8; T < (sseg[e + 1] >> 8); ++T) META[META_TILE_E + T] = e; }
    }
    __syncthreads();
}
__device__ __forceinline__ void final_rows(const Ptrs& P, int gw, int NGW, int G_) {
    int tq_ = threadIdx.x; asm volatile("" : "+v"(tq_)); const int lane = tq_ & 63;
    unsigned char* ws = P.ws;
    const bf16_t* X1 = (const bf16_t*)(ws + WS_X1); const bf16_t* YS = (const bf16_t*)(ws + WS_YS);
    const int* TOKPOS = (const int*)(ws + WS_ROUTE + RT_TOKPOS); const float* TOPG = (const float*)(ws + WS_ROUTE + RT_TOPG);
    const float* nw = P.in[23];
    const bf16_t* YS2 = (const bf16_t*)(ws + WS_YS2);
    int sR_, sLt_; pg8::moe_split(((const int*)(ws + WS_ROUTE + RT_META))[META_NT], 8, G_, sR_, sLt_);
    const int pos2 = sR_ >= 0 ? sR_ * (G_ / 8) * pg8::BM : 0x7fffffff;
    for (int t = gw; t < NTOK; t += NGW) {
        f32x4 v[8];
#pragma unroll
        for (int q = 0; q < 8; ++q) { const u32x2 xb = ((const u32x2*)(X1 + (size_t)t * DM))[lane + 64 * q]; v[q] = (f32x4){bf_lo(xb.x), bf_hi(xb.x), bf_lo(xb.y), bf_hi(xb.y)}; }
#pragma unroll
        for (int j = 0; j < 4; ++j) {
            const int pos = TOKPOS[t * 4 + j]; const float gj = TOPG[t * 4 + j];
            const u32x2* yr = (const u32x2*)(YS + (size_t)pos * DM);
#pragma unroll
            for (int q = 0; q < 8; ++q) { const u32x2 y = yr[lane + 64 * q]; v[q].x += gj * bf_lo(y.x); v[q].y += gj * bf_hi(y.x); v[q].z += gj * bf_lo(y.y); v[q].w += gj * bf_hi(y.y); }
            if (__builtin_amdgcn_readfirstlane(pos) >= pos2) { const u32x2* yr2 = (const u32x2*)(YS2 + (size_t)pos * DM);
#pragma unroll
                for (int q = 0; q < 8; ++q) { const u32x2 y = yr2[lane + 64 * q]; v[q].x += gj * bf_lo(y.x); v[q].y += gj * bf_hi(y.x); v[q].z += gj * bf_lo(y.y); v[q].w += gj * bf_hi(y.y); } }
        }
        float s = 0.f;
#pragma unroll
        for (int q = 0; q < 8; ++q) s += (v[q].x * v[q].x + v[q].y * v[q].y) + (v[q].z * v[q].z + v[q].w * v[q].w);
        const float rstd = 1.0f / sqrtf(wave_sum(s) * (1.f / DM) + EPS);
#pragma unroll
        for (int q = 0; q < 8; ++q) { const f32x4 w = ((const f32x4*)nw)[lane + 64 * q]; ((f32x4*)(P.out + (size_t)t * DM))[lane + 64 * q] = v[q] * rstd * w; }
    }
}

constexpr int NPHASE = 12;
struct Args { Ptrs p; int ph_lo, ph_hi; };
__global__ void __launch_bounds__(NWAVES * 64, 2) hybrid_fwd(Args args) {
    extern __shared__ __attribute__((aligned(16))) unsigned char lds_raw[];
    LAS unsigned char* lds = (LAS unsigned char*)lds_raw;
    const int tid = threadIdx.x, wave = __builtin_amdgcn_readfirstlane(tid >> 6);
    const int G = gridDim.x; const int bx = blockIdx.x; const int vcu = (G % 8 == 0) ? (bx % 8) * (G / 8) + bx / 8 : bx;
    const Ptrs& P = args.p; unsigned char* ws = P.ws;
    unsigned* ctl = (unsigned*)(ws + WS_CTL);
    for (int u = tid; u < (LDS_BYTES - LDSCTL_OFF) / 4; u += NWAVES * 64) ((LAS unsigned*)(lds + LDSCTL_OFF))[u] = 0u;
    __syncthreads();
    volatile LAS unsigned* MISC = (volatile LAS unsigned*)(lds + MISC_OFF);
    XcdBarrier bar; bar.bar = ctl + CW_BAR; bar.x = 0; bar.st = nullptr;
    if (MK_N_LAUNCHES == 1) bar = xcd_barrier_post(ctl + CW_BAR, MISC + 8);
#define GRID_BAR() do { if (MK_N_LAUNCHES == 1) xcd_barrier(bar); } while (0)
    const int lo = args.ph_lo, hi_ = args.ph_hi;
#ifndef PHASE_MASK
#define PHASE_MASK 0xFFFF
#endif
#define IN(k) (((PHASE_MASK >> (k)) & 1) && lo <= (k) && (k) < hi_)
#define BOTH(k) (IN(k) && IN((k) + 1))
    const int gw = vcu * NWAVES + wave, NGW = G * NWAVES;

    if (IN(0)) { p0_prologue(P, lds, gw, NGW, wave); if (BOTH(0)) GRID_BAR(); }
    if (IN(1)) {
        pg8::SchedDense S; S.init(ws + WS_XN, ws + WS_WIN, NTOK, NPROJP, G, bx);
        pg8::EpiProj E{(bf16_t*)(ws + WS_PROJ), (float*)(ws + WS_DTRAW), (const float*)(ws + WS_ROPE)};
        pg8::gemm_phase<pg8::EpiProj, pg8::SchedDense>(lds, S, E);
        if (BOTH(1)) GRID_BAR();
    }
    if (IN(2)) {
        attn_body::attn_phase128((char*)lds_raw, (const bf16_t*)(ws + WS_PROJ), (bf16_t*)(ws + WS_ATT), G, vcu);
        __syncthreads();
    }
    if (IN(11)) {
        for (int u = vcu; u < NB * 16 * 2 * 2; u += G) { const int hh = u & 1, g = (u >> 1) & 1, c = (u >> 2) & 15, b = u >> 6; ssd_a_unit(P, lds, b, c, g, hh); }
        GRID_BAR();
    }
    if (IN(3)) { ssd_scan(P, vcu * 512 + tid, G * 512); if (BOTH(3)) GRID_BAR(); }
    if (IN(4)) {
#ifndef NO_SSDC
        for (int u = vcu; u < NB * 16 * 2 * 2; u += G) { const int rh = u & 1, g = (u >> 1) & 1, c = (u >> 2) & 15, b = u >> 6; ssd_c_unit(P, lds, b, c, g, rh); }
#endif
#ifndef NO_APOST
        attn_post(P, gw, NGW);
#endif
        if (BOTH(4)) GRID_BAR();
    }
    if (IN(5)) {
        pg8::SchedDense S; S.init(ws + WS_CAT, ws + WS_WOUT, NTOK, DM, G, bx);
        pg8::EpiRes E{P.in[0], (bf16_t*)(ws + WS_X1), DM};
        pg8::gemm_phase<pg8::EpiRes, pg8::SchedDense>(lds, S, E);
        if (BOTH(5)) GRID_BAR();
    }
    if (IN(6)) { for (int tile = vcu; tile < 256; tile += G) router_tile(P, lds, tile); if (BOTH(6)) GRID_BAR(); }
    if (IN(7)) { for (int tile = vcu; tile < 256; tile += G) route_positions(P, lds, tile); if (BOTH(7)) GRID_BAR(); }
    if (IN(8)) {
        const int* META = (const int*)(ws + WS_ROUTE + RT_META);
        typedef pg8::SchedMoeF<4096, 8192, true> SG;
        SG S; S.A = (const char*)(ws + WS_H2); S.W = P.in[19]; S.tile_e = META + META_TILE_E; S.rowtok = (const int*)(ws + WS_ROUTE + RT_ROWTOK);
        S.nT = META[META_NT]; S.nN = 16; S.G = G; S.c = vcu; S.sR = -1; S.sLt = 0;
        pg8::EpiGate E{(bf16_t*)(ws + WS_ACT), P.in[20], ctl + CW_TCNT};
        pg8::gemm_phase_fb<pg8::EpiGate, SG, 4096, 8192, true>(lds, S, E);
        if (MK_N_LAUNCHES != 1 && BOTH(8)) GRID_BAR();
    }
    if (IN(9)) {
        const int* META = (const int*)(ws + WS_ROUTE + RT_META);
        typedef pg8::SchedMoeF<2048, 512, false, true> SD;
        SD S; S.A = (const char*)(ws + WS_ACT); S.W = P.in[21]; S.tile_e = META + META_TILE_E; S.rowtok = nullptr;
        S.nT = META[META_NT]; S.nN = 8; S.G = G; pg8::moe_split(S.nT, 8, G, S.sR, S.sLt);
        { const int r8 = ((S.nT * 16) % G) & ~31; S.c = (MK_N_LAUNCHES == 1) ? (vcu - r8 + G) % G : vcu; }
        pg8::EpiDownK E{(bf16_t*)(ws + WS_YS), (bf16_t*)(ws + WS_YS2), P.in[22]};
        pg8::gemm_phase_fb<pg8::EpiDownK, SD, 2048, 512, false, MK_N_LAUNCHES == 1>(lds, S, E, ctl + CW_TCNT, 128u);
        if (BOTH(9)) GRID_BAR();
    }
    if (IN(10)) { final_rows(P, gw, NGW, G); }
#undef IN
#undef BOTH
#undef GRID_BAR
}

extern "C" void kernel_launch(void* const* d_in, const int* in_sizes, int n_in, void* d_out, int out_size, void* d_ws, size_t ws_size, hipStream_t stream) {
    static int grid = 0;
    if (grid == 0) {
        if (n_in != 24 || out_size != NTOK * DM || ws_size < WS_END) { fprintf(stderr, "kernel_launch: unexpected shapes (n_in %d, out %d, ws %zu)\n", n_in, out_size, ws_size); grid = -1; return; }
        int dev = 0, cus = 0, per_cu = 0;
        if (hipGetDevice(&dev) != hipSuccess || hipDeviceGetAttribute(&cus, hipDeviceAttributeMultiprocessorCount, dev) != hipSuccess) { grid = -1; return; }
        if (hipFuncSetAttribute((const void*)hybrid_fwd, hipFuncAttributeMaxDynamicSharedMemorySize, LDS_BYTES) != hipSuccess) { fprintf(stderr, "kernel_launch: hipFuncSetAttribute failed\n"); grid = -1; return; }
        if (hipOccupancyMaxActiveBlocksPerMultiprocessor(&per_cu, (const void*)hybrid_fwd, NWAVES * 64, LDS_BYTES) != hipSuccess || per_cu < 1) { fprintf(stderr, "kernel_launch: occupancy query says %d\n", per_cu); }
        (void)hipGetLastError();
        grid = cus;
    }
    if (grid < 0) return;
    (void)hipMemsetAsync((char*)d_ws + WS_CTL, 0, CTL_ZERO_BYTES, stream);
    Args a{};
    for (int i = 0; i < 24; ++i) a.p.in[i] = (const float*)d_in[i];
    a.p.out = (float*)d_out; a.p.ws = (unsigned char*)d_ws;
    if (MK_N_LAUNCHES == 1) {
        a.ph_lo = 0; a.ph_hi = NPHASE;
        hipLaunchKernelGGL(hybrid_fwd, dim3(grid), dim3(NWAVES * 64), LDS_BYTES, stream, a);
    } else {
        static const int order[NPHASE] = {0, 1, 2, 11, 3, 4, 5, 6, 7, 8, 9, 10};
        for (int q = 0; q < NPHASE; ++q) {
            const int ph = order[q];
            a.ph_lo = ph; a.ph_hi = ph + 1; hipLaunchKernelGGL(hybrid_fwd, dim3(grid), dim3(NWAVES * 64), LDS_BYTES, stream, a);
#if defined(PROBE_PHASE)
            if (ph == PROBE_PHASE) hipLaunchKernelGGL(hybrid_fwd, dim3(grid), dim3(NWAVES * 64), LDS_BYTES, stream, a);
#endif
        }
    }
}
```

```cpp
#include <hip/hip_runtime.h>
#include <hip/hip_bf16.h>
#include <cstdio>
#include <cstdint>
#include <cmath>

#ifndef MK_N_LAUNCHES
#define MK_N_LAUNCHES 1
#endif

#define LAS __attribute__((address_space(3)))
#define GAS __attribute__((address_space(1)))
typedef unsigned short bf16_t;
typedef short bf16x8 __attribute__((ext_vector_type(8)));
typedef float f32x2 __attribute__((ext_vector_type(2)));
typedef float f32x4 __attribute__((ext_vector_type(4)));
typedef float f32x16 __attribute__((ext_vector_type(16)));
typedef unsigned u32x2 __attribute__((ext_vector_type(2)));
typedef unsigned u32x4 __attribute__((ext_vector_type(4)));

constexpr int NB = 4, SEQ = 2048, NTOK = NB * SEQ, DM = 2048;
constexpr int NPROJ = 5648, NPROJP = 5888;
constexpr int C_Q = 0, C_K = 1024, C_V = 2048, C_Z = 3072, C_XBC = 4096, C_DT = 5632;
constexpr int NEXP = 32, FFD = 2048, MAXROWS = 40960, MAXTILES = 160;
constexpr float EPS = 1e-5f;
constexpr float ATT_C2 = 0.125f * 1.4426950408889634f;
constexpr float LAM_INIT = 0.2f;

constexpr size_t MiB = 1u << 20;
constexpr size_t WS_CTL = 0, CTL_ZERO_BYTES = 1 * MiB;
constexpr size_t WS_WIN = 2 * MiB;
constexpr size_t WS_WOUT = 26 * MiB;
constexpr size_t WS_ROPE = 34 * MiB;
constexpr size_t WS_DTRAW = 34 * MiB + 512 * 1024;
constexpr size_t WS_CS = 35 * MiB;
constexpr size_t WS_ROUTE = 36 * MiB;
constexpr size_t WS_XN = 40 * MiB;
constexpr size_t WS_PROJ = 72 * MiB;
constexpr size_t WS_ATT = 164 * MiB;
constexpr size_t WS_YDIAG = 196 * MiB;
constexpr size_t WS_STATES = 228 * MiB;
constexpr size_t WS_XCONV = 260 * MiB;
constexpr size_t WS_CCONV = 276 * MiB;
constexpr size_t WS_CAT = 280 * MiB;
constexpr size_t WS_X1 = 312 * MiB;
constexpr size_t WS_H2 = 376 * MiB;
constexpr size_t WS_ACT = 408 * MiB;
constexpr size_t WS_YS = 568 * MiB;
constexpr size_t WS_WGU = 728 * MiB;
constexpr size_t WS_WD = 1240 * MiB;
constexpr size_t WS_END = 1496 * MiB;
constexpr size_t RT_TOPE = 0, RT_TOPG = 128 * 1024, RT_LRANK = 256 * 1024, RT_TOKPOS = 384 * 1024, RT_HIST = 512 * 1024, RT_META = 544 * 1024, RT_ROWTOK = 576 * 1024;
constexpr int META_SEG = 0, META_NT = 40, META_TILE_E = 48;
constexpr int CW_BAR = 4096;
constexpr int CW_TCNT = 16384;

constexpr int RING_BYTES = 131072;
constexpr int LDSCTL_OFF = RING_BYTES, MISC_OFF = LDSCTL_OFF + 320;
constexpr int LHIST_OFF = LDSCTL_OFF + 1024;
constexpr int BIAS_OFF = LDSCTL_OFF + 2048 + 8192;
constexpr int VAN_OFF = LDSCTL_OFF + 2048;
constexpr int LDS_BYTES = 147456;
constexpr int NWAVES = 8;

__device__ __forceinline__ unsigned cvt_pk_bf16(float lo, float hi) { unsigned r; asm volatile("v_cvt_pk_bf16_f32 %0, %1, %2" : "=v"(r) : "v"(lo), "v"(hi)); return r; }
__device__ __forceinline__ float bf_lo(unsigned w) { return __uint_as_float(w << 16); }
__device__ __forceinline__ float bf_hi(unsigned w) { return __uint_as_float(w & 0xffff0000u); }
__device__ __forceinline__ float bf2f(bf16_t h) { return __uint_as_float((unsigned)h << 16); }
__device__ __forceinline__ bf16_t f2bf(float f) { return (bf16_t)(cvt_pk_bf16(f, 0.f) & 0xffffu); }
__device__ __forceinline__ float wave_sum(float v) {
#pragma unroll
    for (int o = 1; o < 64; o <<= 1) v += __shfl_xor(v, o);
    return v;
}
__device__ __forceinline__ float sigmoidf_(float x) { return __builtin_amdgcn_rcpf(1.f + __builtin_amdgcn_exp2f(-1.4426950408889634f * x)); }
__device__ __forceinline__ float rsqrtf_(float x) { return __builtin_amdgcn_rsqf(x); }
__device__ __forceinline__ float fexp(float x) { return __builtin_amdgcn_exp2f(1.4426950408889634f * x); }
#define LDS_WAIT() asm volatile("s_waitcnt lgkmcnt(0)" ::: "memory")
#define VM_WAIT() asm volatile("s_waitcnt vmcnt(0)" ::: "memory")

__device__ __forceinline__ const char* uni(const char* p) { const unsigned long long v = (unsigned long long)p; const unsigned lo = __builtin_amdgcn_readfirstlane((unsigned)v), hi = __builtin_amdgcn_readfirstlane((unsigned)(v >> 32)); return (const char*)(((unsigned long long)hi << 32) | lo); }
namespace pg8 {
constexpr int BM = 256, BK = 64, HALF = 128, HTB = HALF * BK * 2, STAGE_BYTES = 8 * HTB, NXCD = 8, WGM = 8, KD = 2048, NKT = KD / BK;
__host__ __device__ __forceinline__ int lds_byte(int r, int c) { const int st = (r >> 4) * 2 + (c >> 5), rr = r & 15, cc = c & 31, ob = rr * 64 + cc * 2; return st * 1024 + (ob ^ (((ob >> 9) & 1) << 5)); }
__host__ __device__ __forceinline__ void stage_rc(int b, int& R, int& C) { const int st = b / 1024, sb = b % 1024, swz = sb ^ (((sb >> 9) & 1) << 5); R = (st >> 1) * 16 + swz / 64; C = (st & 1) * 32 + (swz % 64) / 2; }
__host__ __device__ __forceinline__ int perm32(int rho) { const int n = rho >> 4, i = rho & 15; return 8 * (i >> 2) + 4 * n + (i & 3); }

struct Unit { const char* a; const char* b0; const char* b1; int pm, pn, e; };
struct UnitF { const char* a; const char* b; int pm, pn, e; };

struct SchedDense {
    const char* A; const char* Bt; int nM, nN, nwg, G, c;
    __device__ __forceinline__ void init(const void* A_, const void* Bt_, int M, int N, int G_, int c_) { A = (const char*)A_; Bt = (const char*)Bt_; nM = M / BM; nN = N / BM; nwg = nM * nN; G = G_; c = c_; }
    __device__ __forceinline__ bool get(int i, Unit& u) const {
        const long L = (long)i * G + c; if (L >= nwg) return false;
        int wgid = (int)L; { const int q = nwg / NXCD, r = nwg % NXCD, xcd = wgid % NXCD, off = wgid / NXCD; wgid = (xcd < r ? xcd * (q + 1) : r * (q + 1) + (xcd - r) * q) + off; }
        const int nig = WGM * nN, gid = wgid / nig, fm = gid * WGM, gsz = (nM - fm) < WGM ? (nM - fm) : WGM;
        u.pm = fm + ((wgid % nig) % gsz); u.pn = (wgid % nig) / gsz; u.e = 0;
        u.a = A; u.b0 = Bt + (size_t)u.pn * BM * KD * 2; u.b1 = u.b0 + (size_t)HALF * KD * 2; return true;
    }
    __device__ __forceinline__ unsigned aoff(const Unit& u, int h, int R, int C) const { return (unsigned)(((u.pm * BM + h * HALF + R) * KD + C) * 2); }
};
struct SchedMoe {
    const char* A; const char* Bt; const int* tile_e; const int* rowtok; int nT, nN, G, c; bool gu;
    __device__ __forceinline__ bool get(int i, Unit& u) const {
        const long L = (long)i * G + c; const int NU = nT * nN; if (L >= NU) return false;
        const int nTb = nT >> 2, full = nTb * 4 * nN; int T, nt;
        if ((int)L < full) { const int blk = (int)L >> 5, w = (int)L & 31, nb = nN >> 3, tb = blk / nb, nbk = blk % nb; T = tb * 4 + (w & 3); nt = nbk * 8 + (w >> 2); }
        else { const int Lp = (int)L - full, rT = nT & 3; T = nTb * 4 + Lp % rT; nt = Lp / rT; }
        const int e = tile_e[T]; u.pm = T; u.pn = nt; u.e = e; u.a = A;
        if (gu) { u.b0 = Bt + ((size_t)e * 4096 + (size_t)nt * 128) * KD * 2; u.b1 = u.b0 + (size_t)2048 * KD * 2; }
        else    { u.b0 = Bt + ((size_t)e * 2048 + (size_t)nt * 256) * KD * 2; u.b1 = u.b0 + (size_t)HALF * KD * 2; }
        return true;
    }
    __device__ __forceinline__ unsigned aoff(const Unit& u, int h, int R, int C) const { int row = u.pm * BM + h * HALF + R; if (rowtok) row = rowtok[row]; return (unsigned)((row * KD + C) * 2); }
};

struct EpiProj {
    static constexpr bool PERM = true;
    bf16_t* P; float* dtraw; const float* rope;
    __device__ __forceinline__ void operator()(const f32x4 (&acc)[2][2][4][2], const Unit& u, int wr, int wc, int fr, int fq) const {
        const int row0 = u.pm * BM + wr * 64 + fr;
        if (u.pn == 22) {
            if (wc == 0 && fq < 2) {
#pragma unroll
                for (int ai = 0; ai < 2; ++ai)
#pragma unroll
                    for (int m = 0; m < 4; ++m) { float* d = dtraw + (size_t)(row0 + ai * HALF + m * 16) * 16 + 8 * fq; *(f32x4*)d = acc[ai][0][m][0]; *(f32x4*)(d + 4) = acc[ai][0][m][1]; }
            }
            return;
        }
        const bool ropet = (u.pn < 8) && ((wc & 1) == 0);
        const float qs = (u.pn < 4) ? ATT_C2 : 1.f;
        const int col0 = u.pn * BM + wc * 32 + 8 * fq;
#pragma unroll
        for (int ai = 0; ai < 2; ++ai)
#pragma unroll
            for (int m = 0; m < 4; ++m) {
                const int row = row0 + ai * HALF + m * 16;
                f32x4 v[2][2];
#pragma unroll
                for (int bj = 0; bj < 2; ++bj)
#pragma unroll
                    for (int n = 0; n < 2; ++n) v[bj][n] = acc[ai][bj][m][n];
                if (ropet) {
                    const float* rp = rope + (size_t)row * 16;
                    const f32x4 c0 = *(const f32x4*)rp, c1 = *(const f32x4*)(rp + 4), s0 = *(const f32x4*)(rp + 8), s1 = *(const f32x4*)(rp + 12);
#pragma unroll
                    for (int bj = 0; bj < 2; ++bj)
#pragma unroll
                        for (int n = 0; n < 2; ++n)
#pragma unroll
                            for (int j = 0; j < 4; ++j) {
                                const float x = v[bj][n][j], o = __shfl_xor(x, 16);
                                const float cc = n ? c1[j] : c0[j], ss = n ? s1[j] : s0[j];
                                const float r = (fq == 0) ? (x * cc - o * ss) : (x * cc + o * ss);
                                v[bj][n][j] = (fq < 2) ? r : x;
                            }
                }
                bf16_t* rowp = P + (size_t)row * NPROJP + col0;
#pragma unroll
                for (int bj = 0; bj < 2; ++bj) {
                    const f32x4 v0 = v[bj][0] * qs, v1 = v[bj][1] * qs; u32x4 w;
                    w.x = cvt_pk_bf16(v0[0], v0[1]); w.y = cvt_pk_bf16(v0[2], v0[3]); w.z = cvt_pk_bf16(v1[0], v1[1]); w.w = cvt_pk_bf16(v1[2], v1[3]);
                    *(u32x4*)(rowp + bj * HALF) = w;
                }
            }
    }
};
struct EpiRes {
    static constexpr bool PERM = false;
    const float* base; bf16_t* out; int ldc;
    __device__ __forceinline__ void operator()(const f32x4 (&acc)[2][2][4][2], const Unit& u, int wr, int wc, int fr, int fq) const {
        const int row0 = u.pm * BM + wr * 64 + fr, col0 = u.pn * BM + wc * 32 + 4 * fq;
#pragma unroll
        for (int ai = 0; ai < 2; ++ai)
#pragma unroll
            for (int m = 0; m < 4; ++m) { const size_t off = (size_t)(row0 + ai * HALF + m * 16) * ldc + col0;
#pragma unroll
                for (int bj = 0; bj < 2; ++bj)
#pragma unroll
                    for (int n = 0; n < 2; ++n) { const f32x4 v = *(const f32x4*)(base + off + bj * HALF + n * 16) + acc[ai][bj][m][n]; u32x2 w; w.x = cvt_pk_bf16(v[0], v[1]); w.y = cvt_pk_bf16(v[2], v[3]); *(u32x2*)(out + off + bj * HALF + n * 16) = w; } }
    }
};
struct EpiGate {
    static constexpr bool PERM = true;
    bf16_t* O; const float* bgu;
    unsigned* cnt;
    __device__ __forceinline__ unsigned bias_off(const UnitF& u, int wc, int idx) const { const int fq = idx >> 4, k = (idx >> 2) & 3, cp = idx & 3; return (unsigned)((u.e * 4096 + (k >> 1) * 2048 + u.pn * 128 + wc * 32 + 8 * fq + 4 * (k & 1) + cp) * 4); }
    __device__ __forceinline__ const char* bias_base() const { return (const char*)bgu; }
    __device__ __forceinline__ void operator()(const f32x4 (&acc)[2][2][4][2], const Unit& u, int wr, int wc, int fr, int fq, const LAS float* bl = nullptr) const {
        const int row0 = u.pm * BM + wr * 64 + fr, colg = u.pn * 128 + wc * 32 + 8 * fq;
        f32x4 bg[2], bu[2];
        if (bl) { const LAS f32x4* q = (const LAS f32x4*)bl + fq * 4; bg[0] = q[0]; bg[1] = q[1]; bu[0] = q[2]; bu[1] = q[3]; }
        else { const float* bp = bgu + (size_t)u.e * 4096 + colg;
#pragma unroll
            for (int n = 0; n < 2; ++n) { bg[n] = *(const f32x4*)(bp + 4 * n); bu[n] = *(const f32x4*)(bp + 2048 + 4 * n); } }
        const __amdgpu_buffer_rsrc_t rsrc = __builtin_amdgcn_make_buffer_rsrc((void*)O, 0, MAXROWS * FFD * 2, 0x00020000);
#pragma unroll
        for (int ai = 0; ai < 2; ++ai)
#pragma unroll
            for (int m = 0; m < 4; ++m) {
                float a[8];
#pragma unroll
                for (int n = 0; n < 2; ++n)
#pragma unroll
                    for (int j = 0; j < 4; ++j) {
                        float g = acc[ai][0][m][n][j] + bg[n][j], up = acc[ai][1][m][n][j] + bu[n][j];
                        g = fminf(g, 7.0f); up = fminf(fmaxf(up, -7.0f), 7.0f);
                        a[4 * n + j] = g * sigmoidf_(1.702f * g) * (up + 1.0f);
                    }
                u32x4 w; w.x = cvt_pk_bf16(a[0], a[1]); w.y = cvt_pk_bf16(a[2], a[3]); w.z = cvt_pk_bf16(a[4], a[5]); w.w = cvt_pk_bf16(a[6], a[7]);
                __builtin_amdgcn_raw_buffer_store_b128(w, rsrc, (int)(((unsigned)(row0 + ai * HALF + m * 16) * FFD + colg) * 2u), 0, 16);
            }
        asm volatile("s_waitcnt vmcnt(0)" ::: "memory");
        if (fr == 0 && fq == 0) __hip_atomic_fetch_add(cnt + 64 * u.pm, 1u, __ATOMIC_RELAXED, __HIP_MEMORY_SCOPE_AGENT);
    }
};
struct EpiDown {
    static constexpr bool PERM = true;
    bf16_t* O; const float* bd;
    __device__ __forceinline__ unsigned bias_off(const UnitF& u, int wc, int idx) const { const int fq = idx >> 4, k = (idx >> 2) & 3, cp = idx & 3; return (unsigned)((u.e * DM + u.pn * BM + wc * 32 + 8 * fq + (k >> 1) * HALF + 4 * (k & 1) + cp) * 4); }
    __device__ __forceinline__ const char* bias_base() const { return (const char*)bd; }
    __device__ __forceinline__ void operator()(const f32x4 (&acc)[2][2][4][2], const Unit& u, int wr, int wc, int fr, int fq, const LAS float* bl = nullptr) const {
        const int row0 = u.pm * BM + wr * 64 + fr, col0 = u.pn * BM + wc * 32 + 8 * fq;
        f32x4 bv[2][2];
        if (bl) { const LAS f32x4* q = (const LAS f32x4*)bl + fq * 4; bv[0][0] = q[0]; bv[0][1] = q[1]; bv[1][0] = q[2]; bv[1][1] = q[3]; }
        else { const float* bp = bd + (size_t)u.e * DM + col0;
#pragma unroll
            for (int bj = 0; bj < 2; ++bj)
#pragma unroll
                for (int n = 0; n < 2; ++n) bv[bj][n] = *(const f32x4*)(bp + bj * HALF + 4 * n); }
#pragma unroll
        for (int ai = 0; ai < 2; ++ai)
#pragma unroll
            for (int m = 0; m < 4; ++m) { bf16_t* rowp = O + (size_t)(row0 + ai * HALF + m * 16) * DM + col0;
#pragma unroll
                for (int bj = 0; bj < 2; ++bj) { const f32x4 v0 = acc[ai][bj][m][0] + bv[bj][0], v1 = acc[ai][bj][m][1] + bv[bj][1]; u32x4 w;
                    w.x = cvt_pk_bf16(v0[0], v0[1]); w.y = cvt_pk_bf16(v0[2], v0[3]); w.z = cvt_pk_bf16(v1[0], v1[1]); w.w = cvt_pk_bf16(v1[2], v1[3]);
                    *(u32x4*)(rowp + bj * HALF) = w; } }
    }
};

template <class Epi, class Sched>
__device__ __forceinline__ void gemm_phase(LAS unsigned char* lds, const Sched& S, const Epi& E) {
    const int tid = threadIdx.x, wid = __builtin_amdgcn_readfirstlane(tid >> 6), lane = tid & 63, wr = wid >> 2, wc = wid & 3, fr = lane & 15, fq = lane >> 4;
    constexpr int nt = NKT;
    int Rr[2], Cc[2]; unsigned voffB[2];
#pragma unroll
    for (int i = 0; i < 2; ++i) { stage_rc(tid * 16 + i * 8192, Rr[i], Cc[i]); const int Rb = Epi::PERM ? ((Rr[i] & ~31) + perm32(Rr[i] & 31)) : Rr[i]; voffB[i] = (unsigned)(Rb * KD + Cc[i]) * 2u; }
    const size_t kstep = (size_t)(BK * 2);
    const unsigned ldsw = (unsigned)wid * 1024u;
    const int aoff = lds_byte(wr * 64 + fr, fq * 8), boff = lds_byte(wc * 32 + fr, fq * 8);
#define PG8_SA(b, h) (((b) * 2 + (h)) * HTB)
#define PG8_SB(b, h) ((4 + (b) * 2 + (h)) * HTB)
#define PG8_STAGE(bufoff, gbase, voff) do { _Pragma("unroll") for (int _i = 0; _i < 2; ++_i) \
        __builtin_amdgcn_global_load_lds((const unsigned*)((const char*)(gbase) + (voff)[_i]), (LAS unsigned*)(lds + (bufoff) + ldsw + _i * 8192), 16, 0, 0); } while (0)
#define PG8_LDA(dst, b, h) do { _Pragma("unroll") for (int m = 0; m < 4; ++m) _Pragma("unroll") for (int k = 0; k < 2; ++k) dst[m][k] = *(const LAS bf16x8*)(lds + PG8_SA(b, h) + aoff + m * 2048 + k * 1024); } while (0)
#define PG8_LDB(dst, b, h) do { _Pragma("unroll") for (int n = 0; n < 2; ++n) _Pragma("unroll") for (int k = 0; k < 2; ++k) dst[n][k] = *(const LAS bf16x8*)(lds + PG8_SB(b, h) + boff + n * 2048 + k * 1024); } while (0)
#define PG8_MMA(ai, bj, At, Bt) do { __builtin_amdgcn_s_setprio(1); _Pragma("unroll") for (int m = 0; m < 4; ++m) _Pragma("unroll") for (int n = 0; n < 2; ++n) _Pragma("unroll") for (int k = 0; k < 2; ++k) \
        acc[ai][bj][m][n] = __builtin_amdgcn_mfma_f32_16x16x32_bf16(Bt[n][k], At[m][k], acc[ai][bj][m][n], 0, 0, 0); __builtin_amdgcn_s_setprio(0); } while (0)
#define PG8_WAIT_V(n) asm volatile("s_waitcnt vmcnt(" #n ")" ::: "memory")
#define PG8_WAIT_L(n) asm volatile("s_waitcnt lgkmcnt(" #n ")" ::: "memory")
#define PG8_BAR __builtin_amdgcn_s_barrier()
#define PG8_SCHED __builtin_amdgcn_sched_barrier(0)
    Unit cur, nxt; int ui = 0;
    if (!S.get(0, cur)) return;
    unsigned vaC[2][2], vaN[2][2];
#pragma unroll
    for (int h = 0; h < 2; ++h)
#pragma unroll
        for (int i = 0; i < 2; ++i) vaC[h][i] = S.aoff(cur, h, Rr[i], Cc[i]);
    f32x4 acc[2][2][4][2];
#pragma unroll
    for (int a = 0; a < 2; ++a)
#pragma unroll
        for (int b = 0; b < 2; ++b)
#pragma unroll
            for (int m = 0; m < 4; ++m)
#pragma unroll
                for (int n = 0; n < 2; ++n) acc[a][b][m][n] = (f32x4){0.f, 0.f, 0.f, 0.f};
    bf16x8 At[4][2], B0[2][2], B1[2][2];
    PG8_STAGE(PG8_SB(0, 0), cur.b0, voffB); PG8_STAGE(PG8_SB(0, 1), cur.b1, voffB); PG8_STAGE(PG8_SA(0, 0), cur.a, vaC[0]); PG8_STAGE(PG8_SA(0, 1), cur.a, vaC[1]);
    if (wr == 1) PG8_BAR;
    PG8_WAIT_V(2); PG8_BAR;
    PG8_STAGE(PG8_SB(1, 0), cur.b0 + kstep, voffB); PG8_STAGE(PG8_SA(1, 0), cur.a + kstep, vaC[0]); PG8_STAGE(PG8_SB(1, 1), cur.b1 + kstep, voffB);
    PG8_WAIT_V(6); PG8_BAR;
    for (;;) {
        const bool has_next = S.get(ui + 1, nxt);
        if (has_next) {
#pragma unroll
            for (int h = 0; h < 2; ++h)
#pragma unroll
                for (int i = 0; i < 2; ++i) vaN[h][i] = S.aoff(nxt, h, Rr[i], Cc[i]);
        } else {
            nxt = cur;
#pragma unroll
            for (int h = 0; h < 2; ++h)
#pragma unroll
                for (int i = 0; i < 2; ++i) vaN[h][i] = vaC[h][i];
        }
        for (int t = 0; t < nt; t += 2) {
            const bool last = (t == nt - 2);
            const char* a1 = cur.a + (size_t)(t + 1) * kstep;
            const char* a2 = last ? nxt.a : cur.a + (size_t)(t + 2) * kstep;
            const char* b20 = last ? nxt.b0 : cur.b0 + (size_t)(t + 2) * kstep;
            const char* b21 = last ? nxt.b1 : cur.b1 + (size_t)(t + 2) * kstep;
            const char* a3 = a2 + kstep; const char* b30 = b20 + kstep; const char* b31 = b21 + kstep;
            unsigned v2[2][2];
#pragma unroll
            for (int h = 0; h < 2; ++h)
#pragma unroll
                for (int i = 0; i < 2; ++i) v2[h][i] = last ? vaN[h][i] : vaC[h][i];
            PG8_LDB(B0, 0, 0); PG8_LDB(B1, 0, 1); PG8_SCHED; PG8_LDA(At, 0, 0); PG8_STAGE(PG8_SA(1, 1), a1, vaC[1]);
            PG8_WAIT_V(8); PG8_WAIT_L(0); PG8_BAR; PG8_MMA(0, 0, At, B0); PG8_MMA(0, 1, At, B1); PG8_BAR; PG8_SCHED;
            PG8_LDA(At, 0, 1); PG8_STAGE(PG8_SB(0, 0), b20, voffB); PG8_STAGE(PG8_SB(0, 1), b21, voffB); PG8_STAGE(PG8_SA(0, 0), a2, v2[0]);
            PG8_WAIT_V(8); PG8_WAIT_L(0); PG8_BAR; PG8_MMA(1, 0, At, B0); PG8_MMA(1, 1, At, B1); PG8_BAR; PG8_SCHED;
            PG8_LDB(B0, 1, 0); PG8_LDB(B1, 1, 1); PG8_SCHED; PG8_LDA(At, 1, 0); PG8_STAGE(PG8_SA(0, 1), a2, v2[1]);
            PG8_WAIT_V(8); PG8_WAIT_L(0); PG8_BAR; PG8_MMA(0, 0, At, B0); PG8_MMA(0, 1, At, B1); PG8_BAR; PG8_SCHED;
            PG8_LDA(At, 1, 1); PG8_STAGE(PG8_SB(1, 0), b30, voffB); PG8_STAGE(PG8_SB(1, 1), b31, voffB); PG8_STAGE(PG8_SA(1, 0), a3, v2[0]);
            PG8_WAIT_V(8); PG8_WAIT_L(0); PG8_BAR; PG8_MMA(1, 0, At, B0); PG8_MMA(1, 1, At, B1); PG8_BAR; PG8_SCHED;
        }
        if (wr == 0) PG8_BAR;
        E(acc, cur, wr, wc, fr, fq);
        if (!has_next) break;
#pragma unroll
        for (int a = 0; a < 2; ++a)
#pragma unroll
            for (int b = 0; b < 2; ++b)
#pragma unroll
                for (int m = 0; m < 4; ++m)
#pragma unroll
                    for (int n = 0; n < 2; ++n) acc[a][b][m][n] = (f32x4){0.f, 0.f, 0.f, 0.f};
        cur = nxt; ++ui;
#pragma unroll
        for (int h = 0; h < 2; ++h)
#pragma unroll
            for (int i = 0; i < 2; ++i) vaC[h][i] = vaN[h][i];
        if (wr == 1) PG8_BAR;
    }
    PG8_WAIT_V(0);
    PG8_BAR;
#undef PG8_SA
#undef PG8_SB
#undef PG8_STAGE
#undef PG8_LDA
#undef PG8_LDB
#undef PG8_MMA
#undef PG8_WAIT_V
#undef PG8_WAIT_L
#undef PG8_BAR
#undef PG8_SCHED
}

template <int NP  , int HDELTA  , bool GATHER>
struct SchedMoeF {
    const char* A; const float* W; const int* tile_e; const int* rowtok; int nT, nN, G, c;
    __device__ __forceinline__ bool get(int i, UnitF& u) const {
        const long L = (long)i * G + c; const int NU = nT * nN; if (L >= NU) return false;
        const int q = (int)L >> (nN == 16 ? 4 : 3); const int inf = __builtin_amdgcn_readfirstlane(tile_e[q]);
        const int e = inf & 255, first = (inf >> 8) & 4095, ne = inf >> 20;
        const int Lw = (int)L - first * nN, per = 8 * ne; const int chunk = (Lw >= per) ? 1 : 0; const int rem = Lw - chunk * per;
        int j = 0;
#pragma unroll
        for (int k = 1; k < 8; ++k) j += (rem >= k * ne) ? 1 : 0;
        int T = first + (rem - j * ne), nt = chunk * 8 + j;
        T = __builtin_amdgcn_readfirstlane(T); nt = __builtin_amdgcn_readfirstlane(nt);
        u.pm = T; u.pn = nt; u.e = e;
        u.a = GATHER ? A : A + (size_t)T * BM * KD * 2;
        u.b = (const char*)(W + (size_t)e * 2048 * NP + (size_t)nt * (HDELTA == 512 ? 256 : 128));
        return true;
    }
    __device__ __forceinline__ unsigned aoff(const UnitF& u, int h, int R, int C) const { const int row = GATHER ? rowtok[u.pm * BM + h * HALF + R] : h * HALF + R; return (unsigned)((row * KD + C) * 2); }
};
typedef short s16x4_t __attribute__((ext_vector_type(4)));
__device__ __forceinline__ s16x4_t tr16(const LAS unsigned char* p) { return __builtin_bit_cast(s16x4_t, __builtin_amdgcn_ds_read_tr16_b64_v4i16((LAS s16x4_t*)p)); }
__device__ __forceinline__ void glds16s(const char* sbase, unsigned voff, unsigned lds_dst) { unsigned keep;
    asm volatile("s_mov_b32 %0, m0\n\ts_mov_b32 m0, %2\n\ts_nop 2\n\tglobal_load_lds_dwordx4 %1, %3\n\ts_mov_b32 m0, %0" : "=&s"(keep) : "v"(voff), "s"(lds_dst), "s"(sbase) : "memory"); }

__device__ __forceinline__ void glds4s(const char* sbase, unsigned voff, unsigned lds_dst) { unsigned keep;
    asm volatile("s_mov_b32 %0, m0\n\ts_mov_b32 m0, %2\n\ts_nop 2\n\tglobal_load_lds_dword %1, %3\n\ts_mov_b32 m0, %0" : "=&s"(keep) : "v"(voff), "s"(lds_dst), "s"(sbase) : "memory"); }

template <class Epi, class Sched, int NP, int HDELTA, bool GATHER, bool WAITA = false>
__device__ __forceinline__ void gemm_phase_fb(LAS unsigned char* lds, const Sched& S, const Epi& E, const unsigned* ready = nullptr, unsigned need = 0u) {
    static_assert(Epi::PERM, "the B image's column-slot permutation assumes a PERM epilogue");
    const int tid = threadIdx.x, wid = __builtin_amdgcn_readfirstlane(tid >> 6), lane = tid & 63, wr = wid >> 2, wc = wid & 3;
    constexpr int nt = NKT;
    constexpr size_t kstep = (size_t)(BK * 2);
    constexpr size_t BKT = (size_t)64 * NP * 4;
    constexpr size_t BR8 = (size_t)8 * NP * 4;
    const unsigned lds0 = (unsigned)__builtin_amdgcn_readfirstlane((unsigned)(size_t)lds);
    const unsigned ldsw = lds0 + (unsigned)wid * 1024u;
    const int aoff = lds_byte(wr * 64 + (lane & 15), (lane >> 4) * 8);
    const int bh = lane >> 5, c4 = lane & 31;
    const unsigned blane = (unsigned)(bh * HDELTA + wid * NP * 4 + c4 * 16);
    const int s4 = (c4 & ~7) + 4 * (c4 & 1) + ((c4 & 7) >> 1), ch16 = s4 >> 1, sub = s4 & 1;
    const int X0 = ((wid & 3) << 2) | (wid >> 2);
    const unsigned bw0 = (unsigned)(4 * HTB + bh * HTB + 256 * wid + 16 * (ch16 ^ X0) + 8 * sub);
    unsigned radr[2];
    { const int g = lane >> 4, q = (lane & 15) >> 2, p = lane & 3;
#pragma unroll
      for (int t = 0; t < 2; ++t) { const int row = 8 * g + 4 * t + q, X = ((row & 3) << 2) | ((row >> 2) & 3), ch = 2 * (2 * wc) + (p >> 1); radr[t] = (unsigned)(4 * HTB + 256 * row + 16 * (ch ^ X) + 8 * (p & 1)); } }
#define FB_SA(b, h) (((b) * 2 + (h)) * HTB)
#define FB_SB(b, h) (((b) * 2 + (h)) * HTB)
#define FB_STAGE(bufoff, sbase, voff) do { _Pragma("unroll") for (int _i = 0; _i < 2; ++_i) glds16s((sbase), (voff)[_i], ldsw + (unsigned)(bufoff) + _i * 8192u); } while (0)
#define FB_STAGEH(bufoff, sbase, vv, h) do { if constexpr (GATHER) { FB_STAGE(bufoff, sbase, (vv)[h]); } else { FB_STAGE(bufoff, (sbase) + (size_t)(h) * HALF * KD * 2, (vv)[0]); } } while (0)
#define FB_LDA(dst, b, h) do { _Pragma("unroll") for (int m = 0; m < 4; ++m) _Pragma("unroll") for (int k = 0; k < 2; ++k) dst[m][k] = *(const LAS bf16x8*)(lds + FB_SA(b, h) + aoff + m * 2048 + k * 1024); } while (0)
#define FB_LDB(dst, b, h) do { _Pragma("unroll") for (int n = 0; n < 2; ++n) _Pragma("unroll") for (int k = 0; k < 2; ++k) { \
        const s16x4_t lo_ = tr16(lds + FB_SB(b, h) + (radr[0] ^ (n ? 32u : 0u)) + k * 8192), hi_ = tr16(lds + FB_SB(b, h) + (radr[1] ^ (n ? 32u : 0u)) + k * 8192); \
        dst[n][k] = (bf16x8){lo_[0], lo_[1], lo_[2], lo_[3], hi_[0], hi_[1], hi_[2], hi_[3]}; } } while (0)
#define FB_BLOAD(LD, bsrc, hr, rj) do { _Pragma("unroll") for (int _i = 0; _i < 4; ++_i) { const char* sb_ = (const char*)(bsrc) + (size_t)((4 * (hr) + _i + (rj)) & 7) * BR8; \
        asm volatile("s_nop 4\n\tglobal_load_dwordx4 %0, %1, %2 sc0" : "=v"(LD[_i]) : "v"(blane), "s"(sb_) : "memory"); } } while (0)
#define FB_BWAIT(LD, n) asm volatile("s_waitcnt vmcnt(" #n ")" : "+v"(LD[0]), "+v"(LD[1]), "+v"(LD[2]), "+v"(LD[3]) :: "memory")
#define FB_BCW(LD, b, hr, rj) do { _Pragma("unroll") for (int _i = 0; _i < 4; ++_i) { u32x2 w_; w_.x = cvt_pk_bf16(LD[_i].x, LD[_i].y); w_.y = cvt_pk_bf16(LD[_i].z, LD[_i].w); \
        *(LAS u32x2*)(lds + FB_SB(b, 0) + ((_i & 1) ? (bw0 ^ 32u) : bw0) + 2048 * ((4 * (hr) + _i + (rj)) & 7)) = w_; } } while (0)
#define FB_BSTEP(LD, wb, whr, wrj, nsrc, nhr, nrj, nw) do { FB_BWAIT(LD, nw); FB_BCW(LD, wb, whr, wrj); FB_BLOAD(LD, nsrc, nhr, nrj); } while (0)
#define FB_BCONS(LD, wb, whr, wrj, nw) do { FB_BWAIT(LD, nw); FB_BCW(LD, wb, whr, wrj); } while (0)
#define FB_MMA(ai, bj, At, Bt) do { __builtin_amdgcn_s_setprio(1); _Pragma("unroll") for (int m = 0; m < 4; ++m) _Pragma("unroll") for (int n = 0; n < 2; ++n) _Pragma("unroll") for (int k = 0; k < 2; ++k) \
        acc[ai][bj][m][n] = __builtin_amdgcn_mfma_f32_16x16x32_bf16(Bt[n][k], At[m][k], acc[ai][bj][m][n], 0, 0, 0); __builtin_amdgcn_s_setprio(0); } while (0)
#define FB_WAIT_V(n) asm volatile("s_waitcnt vmcnt(" #n ")" ::: "memory")
#define FB_WAIT_L(n) asm volatile("s_waitcnt lgkmcnt(" #n ")" ::: "memory")
#define FB_BAR __builtin_amdgcn_s_barrier()
#define FB_SCHED __builtin_amdgcn_sched_barrier(0)
#define FB_AWAIT(T) do { if constexpr (WAITA) { if (wid == 0) { unsigned sp_ = 0; \
        while ((unsigned)__builtin_amdgcn_readfirstlane(__hip_atomic_load(ready + 64 * (T), __ATOMIC_RELAXED, __HIP_MEMORY_SCOPE_AGENT)) < need) { __builtin_amdgcn_s_sleep(2); if (++sp_ > (1u << 22)) break; } \
        __builtin_amdgcn_fence(__ATOMIC_ACQUIRE, "agent"); asm volatile("s_waitcnt vmcnt(0)" ::: "memory"); } \
        asm volatile("" ::: "memory"); __builtin_amdgcn_s_barrier(); asm volatile("" ::: "memory"); } } while (0)
#define FB_BIAS(u) do { int tq_ = threadIdx.x; asm volatile("" : "+v"(tq_)); glds4s(uni(E.bias_base()), E.bias_off((u), wc, tq_ & 63), lds0 + (unsigned)BIAS_OFF + (unsigned)wid * 256u); } while (0)
    UnitF cur, nxt; int ui = 0;
    if (!S.get(0, cur)) return;
    FB_AWAIT(cur.pm);
    FB_BIAS(cur);
    unsigned vaC[2][2];
    { int tq = threadIdx.x; asm volatile("" : "+v"(tq));
#pragma unroll
      for (int i = 0; i < 2; ++i) { int R_, C_; stage_rc(tq * 16 + i * 8192, R_, C_);
#pragma unroll
        for (int h = 0; h < 2; ++h) vaC[h][i] = S.aoff(cur, h, R_, C_); } }
    f32x4 acc[2][2][4][2];
#pragma unroll
    for (int a = 0; a < 2; ++a)
#pragma unroll
        for (int b = 0; b < 2; ++b)
#pragma unroll
            for (int m = 0; m < 4; ++m)
#pragma unroll
                for (int n = 0; n < 2; ++n) acc[a][b][m][n] = (f32x4){0.f, 0.f, 0.f, 0.f};
    bf16x8 At[4][2], B0[2][2], B1[2][2];
    f32x4 ldX[4], ldY[4];
    { const char* a0 = uni(cur.a); const char* bb = uni(cur.b);
    FB_STAGEH(FB_SA(0, 0), a0, vaC, 0); FB_STAGEH(FB_SA(0, 1), a0, vaC, 1); FB_STAGEH(FB_SA(1, 0), a0 + kstep, vaC, 0);
    const int j0 = 2 * (cur.pm & 3);
    FB_BLOAD(ldY, bb, 0, j0); FB_BLOAD(ldX, bb, 1, j0);
    FB_BSTEP(ldY, 0, 0, j0, bb + BKT, 0, j0, 4);
    FB_BSTEP(ldX, 0, 1, j0, bb + BKT, 1, j0, 4);
    FB_BSTEP(ldY, 1, 0, j0, bb + 2 * BKT, 0, j0, 4); }
    FB_WAIT_V(0); FB_WAIT_L(0);
    if (wr == 1) FB_BAR;
    FB_BAR;
    for (;;) {
        const bool has_next = S.get(ui + 1, nxt);
        if (!has_next) nxt = cur;
        if (ui > 0) FB_BIAS(cur);
        if constexpr (GATHER) {
            if (has_next) { int tq = threadIdx.x; asm volatile("" : "+v"(tq));
                int R0, C0, R1, C1; stage_rc(tq * 16, R0, C0); stage_rc(tq * 16 + 8192, R1, C1);
                const char* rtb = uni((const char*)(S.rowtok + nxt.pm * BM)); const unsigned sd = lds0 + (unsigned)VAN_OFF + (unsigned)wid * 1024u;
                glds4s(rtb, (unsigned)(R0 * 4), sd); glds4s(rtb, (unsigned)(R1 * 4), sd + 256u); glds4s(rtb, (unsigned)((HALF + R0) * 4), sd + 512u); glds4s(rtb, (unsigned)((HALF + R1) * 4), sd + 768u); }
        }
        const char* ca = uni(cur.a); const char* cb = uni(cur.b); const char* na = uni(nxt.a); const char* nb = uni(nxt.b);
        const int jc = 2 * (cur.pm & 3), jn = 2 * (nxt.pm & 3);
        for (int t = 0; t < nt; t += 2) {
            const bool last = (t == nt - 2);
            if (last && has_next) FB_AWAIT(nxt.pm);
            const char* a1 = ca + (size_t)(t + 1) * kstep;
            const char* a2 = last ? na : ca + (size_t)(t + 2) * kstep;
            const char* a3 = a2 + kstep;
            const char* b2 = last ? nb : cb + (size_t)(t + 2) * BKT;
            const char* b3 = b2 + BKT;
            const char* b4 = (t + 4 < nt) ? cb + (size_t)(t + 4) * BKT : nb + (size_t)(t + 4 - nt) * BKT;
            const int j2 = last ? jn : jc, j4 = (t + 4 < nt) ? jc : jn;
            FB_BCONS(ldX, 1, 1, jc, 6);
            FB_LDB(B0, 0, 0); FB_LDB(B1, 0, 1); FB_SCHED; FB_LDA(At, 0, 0); FB_STAGEH(FB_SA(1, 1), a1, vaC, 1);
            if constexpr (GATHER) { if (last && has_next) { int tq = threadIdx.x; asm volatile("" : "+v"(tq));
                int R0, C0, R1, C1; stage_rc(tq * 16, R0, C0); stage_rc(tq * 16 + 8192, R1, C1);
                const LAS unsigned* sp = (const LAS unsigned*)(lds + VAN_OFF + wid * 1024) + (tq & 63);
                vaC[0][0] = (sp[0] * KD + C0) * 2u; vaC[0][1] = (sp[64] * KD + C1) * 2u; vaC[1][0] = (sp[128] * KD + C0) * 2u; vaC[1][1] = (sp[192] * KD + C1) * 2u; } }
            FB_WAIT_V(8); FB_WAIT_L(0); FB_BAR; FB_MMA(0, 0, At, B0); FB_BLOAD(ldX, b2, 1, j2); FB_MMA(0, 1, At, B1); FB_BAR; FB_SCHED;
            FB_BCONS(ldY, 0, 0, j2, 6);
            FB_LDA(At, 0, 1); FB_STAGEH(FB_SA(0, 0), a2, vaC, 0);
            FB_WAIT_V(8); FB_WAIT_L(0); FB_BAR; FB_MMA(1, 0, At, B0); FB_BLOAD(ldY, b3, 0, j2); FB_MMA(1, 1, At, B1); FB_BAR; FB_SCHED;
            FB_BCONS(ldX, 0, 1, j2, 6);
            FB_LDB(B0, 1, 0); FB_LDB(B1, 1, 1); FB_SCHED; FB_LDA(At, 1, 0); FB_STAGEH(FB_SA(0, 1), a2, vaC, 1);
            FB_WAIT_V(8); FB_WAIT_L(0); FB_BAR; FB_MMA(0, 0, At, B0); FB_BLOAD(ldX, b3, 1, j2); FB_MMA(0, 1, At, B1); FB_BAR; FB_SCHED;
            FB_BCONS(ldY, 1, 0, j2, 6);
            FB_LDA(At, 1, 1); FB_STAGEH(FB_SA(1, 0), a3, vaC, 0);
            FB_WAIT_V(8); FB_WAIT_L(0); FB_BAR; FB_MMA(1, 0, At, B0); FB_BLOAD(ldY, b4, 0, j4); FB_MMA(1, 1, At, B1); FB_BAR; FB_SCHED;
        }
        if (wr == 0) FB_BAR;
        { Unit ue; ue.a = nullptr; ue.b0 = nullptr; ue.b1 = nullptr; ue.pm = cur.pm; ue.pn = cur.pn; ue.e = cur.e;
          int tq = threadIdx.x; asm volatile("" : "+v"(tq)); E(acc, ue, wr, wc, tq & 15, (tq & 63) >> 4, (const LAS float*)(lds + BIAS_OFF + wid * 256)); }
        if (!has_next) break;
#pragma unroll
        for (int a = 0; a < 2; ++a)
#pragma unroll
            for (int b = 0; b < 2; ++b)
#pragma unroll
                for (int m = 0; m < 4; ++m)
#pragma unroll
                    for (int n = 0; n < 2; ++n) acc[a][b][m][n] = (f32x4){0.f, 0.f, 0.f, 0.f};
        cur = nxt; ++ui;
        if (wr == 1) FB_BAR;
    }
    FB_WAIT_V(0);
    FB_BAR;
#undef FB_SA
#undef FB_SB
#undef FB_STAGE
#undef FB_STAGEH
#undef FB_BIAS
#undef FB_LDA
#undef FB_LDB
#undef FB_BLOAD
#undef FB_BWRITE
#undef FB_BCW
#undef FB_BWAIT
#undef FB_BSTEP
#undef FB_BCONS
#undef FB_MMA
#undef FB_WAIT_V
#undef FB_WAIT_L
#undef FB_BAR
#undef FB_SCHED
#undef FB_AWAIT
}
}

namespace attn_body {
using bf16 = __hip_bfloat16;
using s16x4 = __attribute__((ext_vector_type(4))) short;
constexpr int PQ = NPROJP, PO = 2048;
constexpr int NW = 8, QBLK = 32, QB = QBLK * NW, KVBLK = 64;
__device__ __forceinline__ int crow(int r, int hi) { return (r & 3) + 8 * (r >> 2) + 4 * hi; }
#define SBAR() __builtin_amdgcn_sched_barrier(0)
__device__ __forceinline__ void cmask(f32x16& p0, f32x16& p1, int jb, int qrel, int hi) {
  const float NEG = -INFINITY; int d = qrel - (64 * jb + 4 * hi); asm volatile("" : "+v"(d));
  #pragma unroll
  for (int r = 0; r < 16; ++r) { const int cc = (r & 3) + 8 * (r >> 2); if (cc > d) p0[r] = NEG; if (cc + 32 > d) p1[r] = NEG; }
}
constexpr int NSLOT = 3, SLOTB = 8192;
constexpr int LDS_K = 0, LDS_V = NSLOT * SLOTB, LDS_WS = 2 * NSLOT * SLOTB, LDS_OST = LDS_WS + NW * 64 * 4, LDS_BYTES_A = LDS_OST + NW * 4096;
__device__ __forceinline__ void glds16(const void* sbase, unsigned voff, unsigned lds_dst) { unsigned keep;
  asm volatile("s_mov_b32 %0, m0\n\ts_mov_b32 m0, %2\n\ts_nop 0\n\tglobal_load_lds_dwordx4 %1, %3\n\ts_mov_b32 m0, %0" : "=&s"(keep) : "v"(voff), "s"(lds_dst), "s"(sbase) : "memory"); }
__device__ __forceinline__ float max3f(float a, float b, float c) { float r; asm("v_max3_f32 %0, %1, %2, %3" : "=v"(r) : "v"(a), "v"(b), "v"(c)); return r; }
__device__ __forceinline__ float max2f(float a, float b) { float r; asm("v_max_f32_e32 %0, %1, %2" : "=v"(r) : "v"(a), "v"(b)); return r; }
__device__ __forceinline__ float fadd_s(float a, float b) { float r; asm("v_add_f32_e32 %0, %1, %2" : "=v"(r) : "v"(a), "v"(b)); return r; }
__device__ __forceinline__ float fsub_s(float a, float b) { float r; asm("v_sub_f32_e32 %0, %1, %2" : "=v"(r) : "v"(a), "v"(b)); return r; }
typedef float f32x2_t __attribute__((ext_vector_type(2))); typedef __bf16 bf16x2_t __attribute__((ext_vector_type(2)));
__device__ __forceinline__ unsigned cvtpk_s(float lo, float hi) { f32x2_t v = {lo, hi}; bf16x2_t b = __builtin_convertvector(v, bf16x2_t); return __builtin_bit_cast(unsigned, b); }
#define WAIT_BAR(N) asm volatile("s_waitcnt vmcnt(" #N ") lgkmcnt(0)\n\ts_barrier" ::: "memory")
__device__ __forceinline__ void qkt(f32x16& p0, f32x16& p1, const char* Kslot, const bf16x8* qr, const f32x16& negm, int r32, int hi) {
  const char* kb = Kslot + hi * 1024 + r32 * 16;
  #pragma unroll
  for (int d0 = 0; d0 < 4; ++d0) {
    const bf16x8 b0 = *reinterpret_cast<const bf16x8*>(kb + d0 * 2048);
    const bf16x8 b1 = *reinterpret_cast<const bf16x8*>(kb + d0 * 2048 + 512);
    if (d0 == 0) { p0 = __builtin_amdgcn_mfma_f32_32x32x16_bf16(b0, qr[0], negm, 0, 0, 0); p1 = __builtin_amdgcn_mfma_f32_32x32x16_bf16(b1, qr[0], negm, 0, 0, 0); }
    else { p0 = __builtin_amdgcn_mfma_f32_32x32x16_bf16(b0, qr[d0], p0, 0, 0, 0); p1 = __builtin_amdgcn_mfma_f32_32x32x16_bf16(b1, qr[d0], p1, 0, 0, 0); } }
}
typedef __attribute__((address_space(3))) const char* lds_cptr;
typedef short v4i16_t __attribute__((ext_vector_type(4)));
__device__ __forceinline__ void kload8(bf16x8* kf, lds_cptr kp) {
  kf[0] = *(const __attribute__((address_space(3))) bf16x8*)(kp);        kf[1] = *(const __attribute__((address_space(3))) bf16x8*)(kp + 512);
  kf[2] = *(const __attribute__((address_space(3))) bf16x8*)(kp + 2048); kf[3] = *(const __attribute__((address_space(3))) bf16x8*)(kp + 2560);
  kf[4] = *(const __attribute__((address_space(3))) bf16x8*)(kp + 4096); kf[5] = *(const __attribute__((address_space(3))) bf16x8*)(kp + 4608);
  kf[6] = *(const __attribute__((address_space(3))) bf16x8*)(kp + 6144); kf[7] = *(const __attribute__((address_space(3))) bf16x8*)(kp + 6656);
}
__device__ __forceinline__ void kload2(bf16x8* kf, lds_cptr kp, int j) { kf[2 * j] = *(const __attribute__((address_space(3))) bf16x8*)(kp + j * 2048); kf[2 * j + 1] = *(const __attribute__((address_space(3))) bf16x8*)(kp + j * 2048 + 512); }
__device__ __forceinline__ s16x4 vtr(lds_cptr p) { return __builtin_bit_cast(s16x4, __builtin_amdgcn_ds_read_tr16_b64_v4i16((__attribute__((address_space(3))) v4i16_t*)p)); }
__device__ __forceinline__ float rowmax(const f32x16& p0, const f32x16& p1) {
  float a = max3f(p0[0], p0[1], p1[0]), b = max3f(p0[2], p0[3], p1[1]); a = max3f(a, p1[2], p1[3]);
  #pragma unroll
  for (int r = 4; r < 16; r += 4) { a = max3f(a, p0[r], p0[r + 1]); b = max3f(b, p0[r + 2], p0[r + 3]); a = max3f(a, p1[r], p1[r + 1]); b = max3f(b, p1[r + 2], p1[r + 3]); }
  const float m = max2f(a, b);
  auto rr = __builtin_amdgcn_permlane32_swap(__float_as_uint(m), __float_as_uint(m), false, false);
  return max2f(__uint_as_float(rr[0]), __uint_as_float(rr[1]));
}
__device__ __forceinline__ void pv(f32x16* o, int vb, bf16x8 pa0, bf16x8 pa1, bf16x8 pa2, bf16x8 pa3) {
  #pragma unroll
  for (int d0 = 0; d0 < 2; ++d0) { s16x4 lo[4], hi[4];
    #pragma unroll
    for (int ks = 0; ks < 4; ++ks) {
      asm volatile("ds_read_b64_tr_b16 %0,%1 offset:%c2" : "=&v"(lo[ks]) : "v"(vb), "i"(d0 * 4096 + ks * 1024) : "memory");
      asm volatile("ds_read_b64_tr_b16 %0,%1 offset:%c2" : "=&v"(hi[ks]) : "v"(vb), "i"(d0 * 4096 + ks * 1024 + 512) : "memory"); }
    asm volatile("s_waitcnt lgkmcnt(0)" ::: "memory"); SBAR();
    #define PK(k) (bf16x8){lo[k][0], lo[k][1], lo[k][2], lo[k][3], hi[k][0], hi[k][1], hi[k][2], hi[k][3]}
    o[d0] = __builtin_amdgcn_mfma_f32_32x32x16_bf16(pa0, PK(0), o[d0], 0, 0, 0);
    o[d0] = __builtin_amdgcn_mfma_f32_32x32x16_bf16(pa1, PK(1), o[d0], 0, 0, 0);
    o[d0] = __builtin_amdgcn_mfma_f32_32x32x16_bf16(pa2, PK(2), o[d0], 0, 0, 0);
    o[d0] = __builtin_amdgcn_mfma_f32_32x32x16_bf16(pa3, PK(3), o[d0], 0, 0, 0);
    #undef PK
  }
}
#define ATTN_STORE16(p, v) (*(u32x4*)(p) = (v))
template <int THRL> __device__ __forceinline__ void attn_unit(long rowbase, int qb, const bf16* Qh, const bf16* __restrict__ Kh0, const bf16* __restrict__ Vh0, bf16* Oh, char* shm) {
  const int tid = threadIdx.x, lane = tid & 63, r32 = lane & 31, hi = lane >> 5; const int wid = __builtin_amdgcn_readfirstlane(tid >> 6);
  const int q0 = qb * QB;
  const bf16* Qw = Qh + (rowbase + q0 + wid * QBLK) * PQ;
  const bf16* Kh = Kh0 + rowbase * PQ, *Vh = Vh0 + rowbase * PQ;
  const unsigned lds0 = (unsigned)(uintptr_t)shm;
  float* wsf = (float*)(shm + LDS_WS) + wid * 64;
  const unsigned koff = (unsigned)((lane * PQ + wid * 8) * 2);
  const unsigned voff = (unsigned)(((16 * (wid & 3) + (lane >> 2)) * PQ + (wid >> 2) * 32 + (lane & 3) * 8) * 2);
  const unsigned kdst = lds0 + LDS_K + wid * 1024, vdst = lds0 + LDS_V + wid * 1024;
  #define DMA_K(t, slot) glds16((const char*)Kh + (size_t)(t) * (KVBLK * PQ * 2), koff, (unsigned)__builtin_amdgcn_readfirstlane(kdst + (slot)))
  #define DMA_V(t, slot) glds16((const char*)Vh + (size_t)(t) * (KVBLK * PQ * 2), voff, (unsigned)__builtin_amdgcn_readfirstlane(vdst + (slot)))
  const int vb0 = (int)(lds0 + LDS_V) + ((lane >> 4) & 1) * 32 + (lane & 3) * 8 + (4 * hi + ((lane & 15) >> 2)) * 64;
  const char* Kbase = shm + LDS_K; bf16x8 kf[8];
  const lds_cptr shm3 = (lds_cptr)shm; const lds_cptr kp0 = shm3 + LDS_K + hi * 1024 + r32 * 16; const lds_cptr vp0 = shm3 + LDS_V + ((lane >> 4) & 1) * 32 + (lane & 3) * 8 + (4 * hi + ((lane & 15) >> 2)) * 64;
  const int NT = (q0 + QB) / KVBLK;
  DMA_K(0, 0); DMA_V(0, 0); DMA_K(1, SLOTB);
  bf16x8 qr[4];
  #pragma unroll
  for (int d0 = 0; d0 < 4; ++d0) qr[d0] = *reinterpret_cast<const bf16x8*>(&Qw[(long)r32 * PQ + d0 * 16 + hi * 8]);
  float mhat = 0.f, l_reg = 0.f; f32x16 o[2]; o[0] = f32x16{}; o[1] = f32x16{}; asm volatile("" : "+v"(o[0]), "+v"(o[1])); f32x16 negm = f32x16{}; asm volatile("" : "+v"(negm));
  const int qrel = wid * QBLK + r32;
  #define CMASK(P0, P1, t) do { int jb_ = (t) - (NT - 4); if (jb_ >= 0) cmask(P0, P1, jb_, qrel, hi); } while (0)
  bool resc = false;
  #define START(P0, P1) do { const float rm = rowmax(P0, P1); resc = false; \
    { const float dl = rm; mhat = fadd_s(mhat, dl); \
      _Pragma("unroll") for (int r = 0; r < 16; ++r) { P0[r] = fsub_s(P0[r], dl); P1[r] = fsub_s(P1[r], dl); } \
      _Pragma("unroll") for (int r = 0; r < 16; ++r) negm[r] = -mhat; asm volatile("" : "+v"(negm)); } \
    _Pragma("unroll") for (int r = 0; r < 16; ++r) P0[r] = __builtin_amdgcn_exp2f(P0[r]); } while (0)
  #define RESC() do { if (resc) { asm volatile("s_waitcnt lgkmcnt(0)" ::: "memory"); \
      _Pragma("unroll") for (int d_ = 0; d_ < 2; ++d_) _Pragma("unroll") for (int r = 0; r < 16; ++r) o[d_][r] *= wsf[crow(r, hi)]; } } while (0)
  f32x16 pA0, pA1, pB0, pB1;
  int sl_prev = 0, sl_cur = 0, sl_next = SLOTB;
  #define ROT() do { sl_prev = sl_cur; sl_cur = sl_next; sl_next = (sl_next == (NSLOT - 1) * SLOTB) ? 0 : sl_next + SLOTB; } while (0)
  DMA_K(2, 2 * SLOTB);
  WAIT_BAR(3);
  qkt(pA0, pA1, Kbase, qr, negm, r32, hi); asm volatile("s_nop 15\n\ts_nop 7" : "+v"(pA0), "+v"(pA1)); CMASK(pA0, pA1, 0);
  START(pA0, pA1);
  _Pragma("unroll") for (int r = 0; r < 16; ++r) pA1[r] = __builtin_amdgcn_exp2f(pA1[r]);
  WAIT_BAR(0);
  DMA_K(3, 0); DMA_V(1, SLOTB);
  ROT();
  kload8(kf, kp0 + sl_cur);
  WAIT_BAR(2);
  s16x4 vlo[8], vhi[8]; u32x4 pw0, pw1, pw2, pw3;
  #define PKW(P, B) cvtpk_s(P[B], P[B + 1])
  #define PAF(k) __builtin_bit_cast(bf16x8, pw##k)
  #define VFR(i) (bf16x8){vlo[i][0], vlo[i][1], vlo[i][2], vlo[i][3], vhi[i][0], vhi[i][1], vhi[i][2], vhi[i][3]}
  #define PIN(x) asm volatile("" : "+v"(x))
  #define MX3(a, b, c) __builtin_fmaxf(__builtin_fmaxf((a), (b)), (c))
  #define GAPA(MF, A0, A1, A2, A3, W0, W1, PW) do { MF; sacc += A0; sacc += A1; sacc += A2; sacc += A3; PIN(sacc); W0; W1; PIN(PW); SBAR(); } while (0)
  #define EX(v) __builtin_amdgcn_exp2f(v)
  #define GAPB(MF, X, B) do { MF; X[B] = EX(X[B]); X[B + 1] = EX(X[B + 1]); X[B + 2] = EX(X[B + 2]); X[B + 3] = EX(X[B + 3]); PIN(X); SBAR(); } while (0)
  #define VRD(i) do { vlo[i] = vtr(vp_ + (((i) >> 2) * 4096 + ((i) & 3) * 1024)); vhi[i] = vtr(vp_ + (((i) >> 2) * 4096 + ((i) & 3) * 1024 + 512)); } while (0)
  #define KRD(G, j) do { if (G) { kload2(kf, kp0 + sl_next, j); SBAR(); } } while (0)
  #define STEP(C0, C1, P0, P1, t, GK, GV, GL) do { SBAR(); \
    const lds_cptr vp_ = vp0 + sl_prev; \
    VRD(0); SBAR(); float sacc = (P0[0] + P0[1]); \
    GAPA(C0 = __builtin_amdgcn_mfma_f32_32x32x16_bf16(kf[0], qr[0], negm, 0, 0, 0), P0[2], P0[3], P0[4], P0[5],     pw0[0] = PKW(P0, 0), pw0[1] = PKW(P0, 2), pw0); \
    VRD(4); SBAR(); GAPA(C1 = __builtin_amdgcn_mfma_f32_32x32x16_bf16(kf[1], qr[0], negm, 0, 0, 0), P0[6], P0[7], P0[8], P0[9],     pw0[2] = PKW(P0, 4), pw0[3] = PKW(P0, 6), pw0); \
    VRD(1); SBAR(); GAPA(C0 = __builtin_amdgcn_mfma_f32_32x32x16_bf16(kf[2], qr[1], C0, 0, 0, 0),   P0[10], P0[11], P0[12], P0[13], pw1[0] = PKW(P0, 8), pw1[1] = PKW(P0, 10), pw1); \
    VRD(5); SBAR(); GAPA(C1 = __builtin_amdgcn_mfma_f32_32x32x16_bf16(kf[3], qr[1], C1, 0, 0, 0),   P0[14], P0[15], P1[0], P1[1],   pw1[2] = PKW(P0, 12), pw1[3] = PKW(P0, 14), pw1); \
    VRD(2); SBAR(); GAPA(C0 = __builtin_amdgcn_mfma_f32_32x32x16_bf16(kf[4], qr[2], C0, 0, 0, 0),   P1[2], P1[3], P1[4], P1[5],     pw2[0] = PKW(P1, 0), pw2[1] = PKW(P1, 2), pw2); \
    VRD(6); SBAR(); GAPA(C1 = __builtin_amdgcn_mfma_f32_32x32x16_bf16(kf[5], qr[2], C1, 0, 0, 0),   P1[6], P1[7], P1[8], P1[9],     pw2[2] = PKW(P1, 4), pw2[3] = PKW(P1, 6), pw2); \
    VRD(3); SBAR(); GAPA(C0 = __builtin_amdgcn_mfma_f32_32x32x16_bf16(kf[6], qr[3], C0, 0, 0, 0),   P1[10], P1[11], P1[12], P1[13], pw3[0] = PKW(P1, 8), pw3[1] = PKW(P1, 10), pw3); \
    VRD(7); SBAR(); GAPA(C1 = __builtin_amdgcn_mfma_f32_32x32x16_bf16(kf[7], qr[3], C1, 0, 0, 0),   P1[14], P1[15], 0.f, 0.f,       pw3[2] = PKW(P1, 12), pw3[3] = PKW(P1, 14), pw3); \
    l_reg += sacc; \
    if (GK) { DMA_K((t) + 3, sl_cur); } if (GV) { DMA_V((t) + 1, sl_next); } \
    CMASK(C0, C1, t); \
    { float a = MX3(C0[0], C0[1], C1[0]), b = MX3(C0[2], C0[3], C1[1]); a = MX3(a, C1[2], C1[3]); \
      _Pragma("unroll") for (int r = 4; r < 16; r += 4) { a = MX3(a, C0[r], C0[r + 1]); b = MX3(b, C0[r + 2], C0[r + 3]); a = MX3(a, C1[r], C1[r + 1]); b = MX3(b, C1[r + 2], C1[r + 3]); } \
      float rm = __builtin_fmaxf(a, b); { auto rr = __builtin_amdgcn_permlane32_swap(__float_as_uint(rm), __float_as_uint(rm), false, false); rm = __builtin_fmaxf(__uint_as_float(rr[0]), __uint_as_float(rr[1])); } \
      resc = false; \
      if (__builtin_expect(__any(rm > (float)THRL), 0)) { const float dl = __builtin_fmaxf(rm, 0.f); mhat += dl; \
        _Pragma("unroll") for (int r = 0; r < 16; ++r) { C0[r] -= dl; C1[r] -= dl; } \
        _Pragma("unroll") for (int r = 0; r < 16; ++r) negm[r] = -mhat; asm volatile("" : "+v"(negm)); \
        const float f = __builtin_amdgcn_exp2f(-dl); l_reg *= f; if (hi == 0) wsf[r32] = f; resc = true; } } \
    SBAR(); \
    GAPB(o[0] = __builtin_amdgcn_mfma_f32_32x32x16_bf16(PAF(0), VFR(0), o[0], 0, 0, 0), C0, 0); \
    GAPB(o[1] = __builtin_amdgcn_mfma_f32_32x32x16_bf16(PAF(0), VFR(4), o[1], 0, 0, 0), C0, 4); \
    KRD(GL, 0); GAPB(o[0] = __builtin_amdgcn_mfma_f32_32x32x16_bf16(PAF(1), VFR(1), o[0], 0, 0, 0), C0, 8); \
    KRD(GL, 1); GAPB(o[1] = __builtin_amdgcn_mfma_f32_32x32x16_bf16(PAF(1), VFR(5), o[1], 0, 0, 0), C0, 12); \
    KRD(GL, 2); GAPB(o[0] = __builtin_amdgcn_mfma_f32_32x32x16_bf16(PAF(2), VFR(2), o[0], 0, 0, 0), C1, 0); \
    KRD(GL, 3); GAPB(o[1] = __builtin_amdgcn_mfma_f32_32x32x16_bf16(PAF(2), VFR(6), o[1], 0, 0, 0), C1, 4); \
    GAPB(o[0] = __builtin_amdgcn_mfma_f32_32x32x16_bf16(PAF(3), VFR(3), o[0], 0, 0, 0), C1, 8); \
    GAPB(o[1] = __builtin_amdgcn_mfma_f32_32x32x16_bf16(PAF(3), VFR(7), o[1], 0, 0, 0), C1, 12); \
    } while (0)
  int t = 1;
  #undef CMASK
  #define CMASK(P0, P1, t) do {} while (0)
  for (; t + 5 < NT; t += 2) {
    STEP(pB0, pB1, pA0, pA1, t, true, true, true);     WAIT_BAR(2); RESC(); ROT();
    STEP(pA0, pA1, pB0, pB1, t + 1, true, true, true); WAIT_BAR(2); RESC(); ROT();
  }
  #undef CMASK
  #define CMASK(P0, P1, t) do { int jb_ = (t) - (NT - 4); if (jb_ >= 0) cmask(P0, P1, jb_, qrel, hi); } while (0)
  #define ENDW(tt) do { if ((tt) + 3 < NT) { WAIT_BAR(2); } else if ((tt) + 2 < NT) { WAIT_BAR(1); } else { WAIT_BAR(0); } } while (0)
  for (; t + 1 < NT; t += 2) {
    STEP(pB0, pB1, pA0, pA1, t, (t + 3 < NT), (t + 1 < NT), (t + 1 < NT));         ENDW(t);     RESC(); ROT();
    STEP(pA0, pA1, pB0, pB1, t + 1, (t + 4 < NT), (t + 2 < NT), (t + 2 < NT));     ENDW(t + 1); RESC(); ROT();
  }
  STEP(pB0, pB1, pA0, pA1, NT - 1, false, false, false); RESC();
  { float sacc = pB0[0] + pB0[1]; _Pragma("unroll") for (int r = 2; r < 16; ++r) sacc += pB0[r]; _Pragma("unroll") for (int r = 0; r < 16; ++r) sacc += pB1[r]; l_reg += sacc;
    pw0 = (u32x4){PKW(pB0, 0), PKW(pB0, 2), PKW(pB0, 4), PKW(pB0, 6)}; pw1 = (u32x4){PKW(pB0, 8), PKW(pB0, 10), PKW(pB0, 12), PKW(pB0, 14)}; pw2 = (u32x4){PKW(pB1, 0), PKW(pB1, 2), PKW(pB1, 4), PKW(pB1, 6)}; pw3 = (u32x4){PKW(pB1, 8), PKW(pB1, 10), PKW(pB1, 12), PKW(pB1, 14)};
    SBAR(); pv(o, vb0 + sl_cur, PAF(0), PAF(1), PAF(2), PAF(3)); }
  #undef PKW
  #undef PAF
  #undef VFR
  #undef PIN
  #undef MX3
  #undef GAPA
  #undef GAPB
  #undef EX
  #undef VRD
  #undef KRD
  #undef STEP
  #undef ENDW
  { auto rr = __builtin_amdgcn_permlane32_swap(__float_as_uint(l_reg), __float_as_uint(l_reg), false, false); l_reg = __uint_as_float(rr[0]) + __uint_as_float(rr[1]); }
  if (hi == 0) wsf[32 + r32] = l_reg; asm volatile("s_waitcnt lgkmcnt(0)" ::: "memory");
  float rli[16];
  #pragma unroll
  for (int r = 0; r < 16; ++r) rli[r] = __builtin_amdgcn_rcpf(wsf[32 + crow(r, hi)]);
  bf16* Ow = Oh + (rowbase + q0 + wid * QBLK) * PO;
  { bf16* stg = (bf16*)(shm + LDS_OST) + wid * 2048;
    #pragma unroll
    for (int r = 0; r < 16; ++r) { const int orow = crow(r, hi);
      #pragma unroll
      for (int d0 = 0; d0 < 2; ++d0) stg[orow * 64 + d0 * 32 + r32] = __float2bfloat16(o[d0][r] * rli[r]); }
    asm volatile("s_waitcnt lgkmcnt(0)" ::: "memory");
    #pragma unroll
    for (int i = 0; i < 4; ++i) { const int row = i * 8 + (lane >> 3), ch = lane & 7; const u32x4 v = *(const u32x4*)(stg + row * 64 + ch * 8); ATTN_STORE16(Ow + (long)row * PO + ch * 8, v); } }
  asm volatile("s_waitcnt lgkmcnt(0)\n\ts_barrier" ::: "memory");
  #undef DMA_K
  #undef DMA_V
  #undef CMASK
  #undef START
  #undef RESC
  #undef ROT
}
template <int THRL> __device__ __forceinline__ void attn_unit128(long rowbase, int qb, const bf16* Qh, const bf16* __restrict__ Kh0, const bf16* __restrict__ Vh0, bf16* Oh, char* shm) {
  int tid = threadIdx.x; asm volatile("" : "+v"(tid));
  const int lane = tid & 63, r32 = lane & 31, hi = lane >> 5; const int wid = __builtin_amdgcn_readfirstlane(tid >> 6);
  const int q0 = qb * QB;
  const bf16* Qw = Qh + (rowbase + q0 + wid * QBLK) * PQ;
  const bf16* Kh = Kh0 + rowbase * PQ, *Vh = Vh0 + rowbase * PQ;
  const unsigned lds0 = (unsigned)(uintptr_t)shm;
  constexpr int LDS_WS2 = LDS_V + NSLOT * 2 * SLOTB, LDS_OST2 = LDS_WS2 + NW * 64 * 4;
  float* wsf = (float*)(shm + LDS_WS2) + wid * 64;
  const unsigned koff = (unsigned)((lane * PQ + wid * 8) * 2);
  const unsigned voff = (unsigned)(((16 * (wid & 3) + (lane >> 2)) * PQ + (wid >> 2) * 32 + (lane & 3) * 8) * 2);
  const unsigned kdst = lds0 + LDS_K + wid * 1024, vdst = lds0 + LDS_V + wid * 1024;
  #define DMA_K(t, slot) glds16((const char*)Kh + (size_t)(t) * (KVBLK * PQ * 2), koff, (unsigned)__builtin_amdgcn_readfirstlane(kdst + (slot)))
  #define DMA_V(t, slot) do { glds16((const char*)Vh + (size_t)(t) * (KVBLK * PQ * 2), voff, (unsigned)__builtin_amdgcn_readfirstlane(vdst + 2 * (slot))); \
    glds16((const char*)Vh + (size_t)(t) * (KVBLK * PQ * 2) + 128, voff, (unsigned)__builtin_amdgcn_readfirstlane(vdst + 2 * (slot) + 8192)); } while (0)
  const int vb0 = (int)(lds0 + LDS_V) + ((lane >> 4) & 1) * 32 + (lane & 3) * 8 + (4 * hi + ((lane & 15) >> 2)) * 64;
  const char* Kbase = shm + LDS_K; bf16x8 kf[8];
  const lds_cptr shm3 = (lds_cptr)shm; const lds_cptr kp0 = shm3 + LDS_K + hi * 1024 + r32 * 16; const lds_cptr vp0 = shm3 + LDS_V + ((lane >> 4) & 1) * 32 + (lane & 3) * 8 + (4 * hi + ((lane & 15) >> 2)) * 64;
  const int NT = (q0 + QB) / KVBLK;
  DMA_K(0, 0); DMA_V(0, 0); DMA_K(1, SLOTB);
  const lds_cptr qp0 = shm3 + LDS_OST2 + wid * 4096 + lane * 16;
  {
  #pragma unroll
  for (int d0 = 0; d0 < 4; ++d0) { const bf16x8 qv = *reinterpret_cast<const bf16x8*>(&Qw[(long)r32 * PQ + d0 * 16 + hi * 8]); *(__attribute__((address_space(3))) bf16x8*)(shm3 + LDS_OST2 + wid * 4096 + d0 * 1024 + lane * 16) = qv; }
  asm volatile("s_waitcnt lgkmcnt(0)" ::: "memory");
  }
  #define QR(d0) (*(const __attribute__((address_space(3))) bf16x8*)(qp0 + (d0) * 1024))
  float mhat = 0.f, l_reg = 0.f; f32x16 o[4]; o[0] = f32x16{}; o[1] = f32x16{}; o[2] = f32x16{}; o[3] = f32x16{}; asm volatile("" : "+v"(o[0]), "+v"(o[1]), "+v"(o[2]), "+v"(o[3]));
  const int qrel = wid * QBLK + r32;
  #define CMASK(P0, P1, t) do { int jb_ = (t) - (NT - 4); if (jb_ >= 0) cmask(P0, P1, jb_, qrel, hi); } while (0)
  bool resc = false;
  #define START(P0, P1) do { const float rm = rowmax(P0, P1); resc = false; \
    { const float dl = rm; mhat = fadd_s(mhat, dl); \
      _Pragma("unroll") for (int r = 0; r < 16; ++r) { P0[r] = fsub_s(P0[r], dl); P1[r] = fsub_s(P1[r], dl); } } \
    _Pragma("unroll") for (int r = 0; r < 16; ++r) P0[r] = __builtin_amdgcn_exp2f(P0[r]); } while (0)
  #define RESC() do { if (resc) { asm volatile("s_waitcnt lgkmcnt(0)" ::: "memory"); \
      _Pragma("unroll") for (int d_ = 0; d_ < 4; ++d_) _Pragma("unroll") for (int r = 0; r < 16; ++r) o[d_][r] *= wsf[crow(r, hi)]; } } while (0)
  f32x16 pA0, pA1, pB0, pB1;
  int sl_prev = 0, sl_cur = 0, sl_next = SLOTB;
  #define ROT() do { sl_prev = sl_cur; sl_cur = sl_next; sl_next = (sl_next == (NSLOT - 1) * SLOTB) ? 0 : sl_next + SLOTB; } while (0)
  DMA_K(2, 2 * SLOTB);
  WAIT_BAR(4);
  { bf16x8 qr_[4] = {QR(0), QR(1), QR(2), QR(3)}; qkt(pA0, pA1, Kbase, qr_, f32x16{}, r32, hi); } asm volatile("s_nop 15\n\ts_nop 7" : "+v"(pA0), "+v"(pA1)); CMASK(pA0, pA1, 0);
  START(pA0, pA1);
  _Pragma("unroll") for (int r = 0; r < 16; ++r) pA1[r] = __builtin_amdgcn_exp2f(pA1[r]);
  WAIT_BAR(0);
  DMA_K(3, 0); DMA_V(1, SLOTB);
  ROT();
  kload8(kf, kp0 + sl_cur);
  WAIT_BAR(3);
  s16x4 vlo[8], vhi[8]; u32x4 pw0, pw1, pw2, pw3;
  #define PKW(P, B) cvtpk_s(P[B], P[B + 1])
  #define PAF(k) __builtin_bit_cast(bf16x8, pw##k)
  #define VFR(i) (bf16x8){vlo[i][0], vlo[i][1], vlo[i][2], vlo[i][3], vhi[i][0], vhi[i][1], vhi[i][2], vhi[i][3]}
  #define PIN(x) asm volatile("" : "+v"(x))
  #define MX3(a, b, c) __builtin_fmaxf(__builtin_fmaxf((a), (b)), (c))
  #define GAPA(MF, A0, A1, A2, A3, W0, W1, PW) do { MF; sacc += A0; sacc += A1; sacc += A2; sacc += A3; PIN(sacc); W0; W1; PIN(PW); SBAR(); } while (0)
  #define EX(v) __builtin_amdgcn_exp2f(v)
  #define GAPB(MF, X, B) do { MF; X[B] = EX(X[B]); X[B + 1] = EX(X[B + 1]); X[B + 2] = EX(X[B + 2]); X[B + 3] = EX(X[B + 3]); PIN(X); SBAR(); } while (0)
  #define GAPC(MF, X, B, RD) do { MF; X[B] = EX(X[B]); X[B + 1] = EX(X[B + 1]); PIN(X); RD; SBAR(); } while (0)
  #define VRD(i) do { vlo[i] = vtr(vp_ + (((i) >> 2) * 4096 + ((i) & 3) * 1024)); vhi[i] = vtr(vp_ + (((i) >> 2) * 4096 + ((i) & 3) * 1024 + 512)); } while (0)
  #define VRD2(i) do { vlo[i] = vtr(vp_ + (8192 + ((i) >> 2) * 4096 + ((i) & 3) * 1024)); vhi[i] = vtr(vp_ + (8192 + ((i) >> 2) * 4096 + ((i) & 3) * 1024 + 512)); } while (0)
  #define KRD(G, j) do { if (G) { kload2(kf, kp0 + sl_next, j); SBAR(); } } while (0)
  #define STEP(C0, C1, P0, P1, t, GK, GV, GL) do { SBAR(); \
    const lds_cptr vp_ = vp0 + 2 * sl_prev; \
    VRD(0); SBAR(); float sacc = (P0[0] + P0[1]); \
    GAPA(C0 = __builtin_amdgcn_mfma_f32_32x32x16_bf16(kf[0], QR(0), f32x16{}, 0, 0, 0), P0[2], P0[3], P0[4], P0[5],     pw0[0] = PKW(P0, 0), pw0[1] = PKW(P0, 2), pw0); \
    VRD(4); SBAR(); GAPA(C1 = __builtin_amdgcn_mfma_f32_32x32x16_bf16(kf[1], QR(0), f32x16{}, 0, 0, 0), P0[6], P0[7], P0[8], P0[9],     pw0[2] = PKW(P0, 4), pw0[3] = PKW(P0, 6), pw0); \
    VRD(1); SBAR(); GAPA(C0 = __builtin_amdgcn_mfma_f32_32x32x16_bf16(kf[2], QR(1), C0, 0, 0, 0),   P0[10], P0[11], P0[12], P0[13], pw1[0] = PKW(P0, 8), pw1[1] = PKW(P0, 10), pw1); \
    VRD(5); SBAR(); GAPA(C1 = __builtin_amdgcn_mfma_f32_32x32x16_bf16(kf[3], QR(1), C1, 0, 0, 0),   P0[14], P0[15], P1[0], P1[1],   pw1[2] = PKW(P0, 12), pw1[3] = PKW(P0, 14), pw1); \
    VRD(2); SBAR(); GAPA(C0 = __builtin_amdgcn_mfma_f32_32x32x16_bf16(kf[4], QR(2), C0, 0, 0, 0),   P1[2], P1[3], P1[4], P1[5],     pw2[0] = PKW(P1, 0), pw2[1] = PKW(P1, 2), pw2); \
    VRD(6); SBAR(); GAPA(C1 = __builtin_amdgcn_mfma_f32_32x32x16_bf16(kf[5], QR(2), C1, 0, 0, 0),   P1[6], P1[7], P1[8], P1[9],     pw2[2] = PKW(P1, 4), pw2[3] = PKW(P1, 6), pw2); \
    VRD(3); SBAR(); GAPA(C0 = __builtin_amdgcn_mfma_f32_32x32x16_bf16(kf[6], QR(3), C0, 0, 0, 0),   P1[10], P1[11], P1[12], P1[13], pw3[0] = PKW(P1, 8), pw3[1] = PKW(P1, 10), pw3); \
    VRD(7); SBAR(); GAPA(C1 = __builtin_amdgcn_mfma_f32_32x32x16_bf16(kf[7], QR(3), C1, 0, 0, 0),   P1[14], P1[15], 0.f, 0.f,       pw3[2] = PKW(P1, 12), pw3[3] = PKW(P1, 14), pw3); \
    l_reg += sacc; \
    _Pragma("unroll") for (int r = 0; r < 16; ++r) { C0[r] -= mhat; C1[r] -= mhat; } \
    if (GK) { DMA_K((t) + 3, sl_cur); } if (GV) { DMA_V((t) + 1, sl_next); } \
    CMASK(C0, C1, t); \
    { float a = MX3(C0[0], C0[1], C1[0]), b = MX3(C0[2], C0[3], C1[1]); a = MX3(a, C1[2], C1[3]); \
      _Pragma("unroll") for (int r = 4; r < 16; r += 4) { a = MX3(a, C0[r], C0[r + 1]); b = MX3(b, C0[r + 2], C0[r + 3]); a = MX3(a, C1[r], C1[r + 1]); b = MX3(b, C1[r + 2], C1[r + 3]); } \
      float rm = __builtin_fmaxf(a, b); { auto rr = __builtin_amdgcn_permlane32_swap(__float_as_uint(rm), __float_as_uint(rm), false, false); rm = __builtin_fmaxf(__uint_as_float(rr[0]), __uint_as_float(rr[1])); } \
      resc = false; \
      if (__builtin_expect(__any(rm > (float)THRL), 0)) { const float dl = __builtin_fmaxf(rm, 0.f); mhat += dl; \
        _Pragma("unroll") for (int r = 0; r < 16; ++r) { C0[r] -= dl; C1[r] -= dl; } \
        const float f = __builtin_amdgcn_exp2f(-dl); l_reg *= f; if (hi == 0) wsf[r32] = f; resc = true; } } \
    SBAR(); \
    GAPC(o[0] = __builtin_amdgcn_mfma_f32_32x32x16_bf16(PAF(0), VFR(0), o[0], 0, 0, 0), C0, 0, VRD2(0)); \
    GAPC(o[1] = __builtin_amdgcn_mfma_f32_32x32x16_bf16(PAF(0), VFR(4), o[1], 0, 0, 0), C0, 2, VRD2(4)); \
    KRD(GL, 0); GAPC(o[0] = __builtin_amdgcn_mfma_f32_32x32x16_bf16(PAF(1), VFR(1), o[0], 0, 0, 0), C0, 4, VRD2(1)); \
    KRD(GL, 1); GAPC(o[1] = __builtin_amdgcn_mfma_f32_32x32x16_bf16(PAF(1), VFR(5), o[1], 0, 0, 0), C0, 6, VRD2(5)); \
    KRD(GL, 2); GAPC(o[0] = __builtin_amdgcn_mfma_f32_32x32x16_bf16(PAF(2), VFR(2), o[0], 0, 0, 0), C0, 8, VRD2(2)); \
    KRD(GL, 3); GAPC(o[1] = __builtin_amdgcn_mfma_f32_32x32x16_bf16(PAF(2), VFR(6), o[1], 0, 0, 0), C0, 10, VRD2(6)); \
    GAPC(o[0] = __builtin_amdgcn_mfma_f32_32x32x16_bf16(PAF(3), VFR(3), o[0], 0, 0, 0), C0, 12, VRD2(3)); \
    GAPC(o[1] = __builtin_amdgcn_mfma_f32_32x32x16_bf16(PAF(3), VFR(7), o[1], 0, 0, 0), C0, 14, VRD2(7)); \
    GAPC(o[2] = __builtin_amdgcn_mfma_f32_32x32x16_bf16(PAF(0), VFR(0), o[2], 0, 0, 0), C1, 0, (void)0); \
    GAPC(o[3] = __builtin_amdgcn_mfma_f32_32x32x16_bf16(PAF(0), VFR(4), o[3], 0, 0, 0), C1, 2, (void)0); \
    GAPC(o[2] = __builtin_amdgcn_mfma_f32_32x32x16_bf16(PAF(1), VFR(1), o[2], 0, 0, 0), C1, 4, (void)0); \
    GAPC(o[3] = __builtin_amdgcn_mfma_f32_32x32x16_bf16(PAF(1), VFR(5), o[3], 0, 0, 0), C1, 6, (void)0); \
    GAPC(o[2] = __builtin_amdgcn_mfma_f32_32x32x16_bf16(PAF(2), VFR(2), o[2], 0, 0, 0), C1, 8, (void)0); \
    GAPC(o[3] = __builtin_amdgcn_mfma_f32_32x32x16_bf16(PAF(2), VFR(6), o[3], 0, 0, 0), C1, 10, (void)0); \
    GAPC(o[2] = __builtin_amdgcn_mfma_f32_32x32x16_bf16(PAF(3), VFR(3), o[2], 0, 0, 0), C1, 12, (void)0); \
    GAPC(o[3] = __builtin_amdgcn_mfma_f32_32x32x16_bf16(PAF(3), VFR(7), o[3], 0, 0, 0), C1, 14, (void)0); \
    } while (0)
  int t = 1;
  #undef CMASK
  #define CMASK(P0, P1, t) do {} while (0)
  for (; t + 5 < NT; t += 2) {
    STEP(pB0, pB1, pA0, pA1, t, true, true, true);     WAIT_BAR(3); RESC(); ROT();
    STEP(pA0, pA1, pB0, pB1, t + 1, true, true, true); WAIT_BAR(3); RESC(); ROT();
  }
  #undef CMASK
  #define CMASK(P0, P1, t) do { int jb_ = (t) - (NT - 4); if (jb_ >= 0) cmask(P0, P1, jb_, qrel, hi); } while (0)
  #define ENDW(tt) do { if ((tt) + 3 < NT) { WAIT_BAR(3); } else if ((tt) + 2 < NT) { WAIT_BAR(2); } else { WAIT_BAR(0); } } while (0)
  for (; t + 1 < NT; t += 2) {
    STEP(pB0, pB1, pA0, pA1, t, (t + 3 < NT), (t + 1 < NT), (t + 1 < NT));         ENDW(t);     RESC(); ROT();
    STEP(pA0, pA1, pB0, pB1, t + 1, (t + 4 < NT), (t + 2 < NT), (t + 2 < NT));     ENDW(t + 1); RESC(); ROT();
  }
  STEP(pB0, pB1, pA0, pA1, NT - 1, false, false, false); RESC();
  { float sacc = pB0[0] + pB0[1]; _Pragma("unroll") for (int r = 2; r < 16; ++r) sacc += pB0[r]; _Pragma("unroll") for (int r = 0; r < 16; ++r) sacc += pB1[r]; l_reg += sacc;
    pw0 = (u32x4){PKW(pB0, 0), PKW(pB0, 2), PKW(pB0, 4), PKW(pB0, 6)}; pw1 = (u32x4){PKW(pB0, 8), PKW(pB0, 10), PKW(pB0, 12), PKW(pB0, 14)}; pw2 = (u32x4){PKW(pB1, 0), PKW(pB1, 2), PKW(pB1, 4), PKW(pB1, 6)}; pw3 = (u32x4){PKW(pB1, 8), PKW(pB1, 10), PKW(pB1, 12), PKW(pB1, 14)};
    SBAR(); pv(o, vb0 + 2 * sl_cur, PAF(0), PAF(1), PAF(2), PAF(3)); pv(o + 2, vb0 + 2 * sl_cur + 8192, PAF(0), PAF(1), PAF(2), PAF(3)); }
  #undef PKW
  #undef PAF
  #undef VFR
  #undef PIN
  #undef MX3
  #undef GAPA
  #undef GAPB
  #undef GAPC
  #undef EX
  #undef VRD
  #undef VRD2
  #undef KRD
  #undef STEP
  #undef ENDW
  { auto rr = __builtin_amdgcn_permlane32_swap(__float_as_uint(l_reg), __float_as_uint(l_reg), false, false); l_reg = __uint_as_float(rr[0]) + __uint_as_float(rr[1]); }
  if (hi == 0) wsf[32 + r32] = l_reg; asm volatile("s_waitcnt lgkmcnt(0)" ::: "memory");
  float rli[16];
  #pragma unroll
  for (int r = 0; r < 16; ++r) rli[r] = __builtin_amdgcn_rcpf(wsf[32 + crow(r, hi)]);
  bf16* Ow = Oh + (rowbase + q0 + wid * QBLK) * PO;
  { bf16* stg = (bf16*)(shm + LDS_OST2) + wid * 2048;
    int te_ = threadIdx.x; asm volatile("" : "+v"(te_)); const int lane = te_ & 63;
    #pragma unroll
    for (int hv = 0; hv < 2; ++hv) {
      #pragma unroll
      for (int r = 0; r < 16; ++r) { const int orow = crow(r, hi);
        #pragma unroll
        for (int d0 = 0; d0 < 2; ++d0) stg[orow * 64 + d0 * 32 + r32] = __float2bfloat16(o[2 * hv + d0][r] * rli[r]); }
      asm volatile("s_waitcnt lgkmcnt(0)" ::: "memory");
      #pragma unroll
      for (int i = 0; i < 4; ++i) { const int row = i * 8 + (lane >> 3), ch = lane & 7; const u32x4 v = *(const u32x4*)(stg + row * 64 + ch * 8); ATTN_STORE16(Ow + (long)row * PO + hv * 64 + ch * 8, v); }
      asm volatile("s_waitcnt lgkmcnt(0)" ::: "memory");
    } }
  asm volatile("s_waitcnt lgkmcnt(0)\n\ts_barrier" ::: "memory");
  #undef QR
  #undef DMA_K
  #undef DMA_V
  #undef CMASK
  #undef START
  #undef RESC
  #undef ROT
}
__device__ __forceinline__ void attn_phase128(char* lds, const bf16_t* proj, bf16_t* att, int G, int vcu) {
  for (int i = 0;; ++i) {
    const int L = i * G + vcu; if (L >= 512) break;
    const int k = L >> 8, w = L & 255, ph = w >> 2, sq = w & 3;
    const int qb = (k == 0) ? (7 - sq) : sq;
    const int b = ph >> 4, rem = ph & 15, h = rem >> 1, c = rem & 1;
    const bf16* P = (const bf16*)proj;
    attn_unit128<8>((long)b * SEQ, qb, P + C_Q + (2 * h + c) * 64, P + C_K + (2 * h + c) * 64, P + C_V + h * 128, (bf16*)att + c * 1024 + h * 128, lds);
  }
}

__device__ __forceinline__ void attn_phase(char* lds, const bf16_t* proj, bf16_t* att, int G, int vcu) {
  for (int i = 0;; ++i) {
    const int L = i * G + vcu; if (L >= 1024) break;
    const int k = L >> 8, w = L & 255, ph = w >> 1, set = w & 1;
    const int qb = (k == 0) ? (7 - set) : (k == 1) ? set : (k == 2) ? (4 + set) : (3 - set);
    const int b = ph >> 5, rem = ph & 31, h = rem >> 2, c = (rem >> 1) & 1, vh = rem & 1;
    const bf16* P = (const bf16*)proj;
    attn_unit<8>((long)b * SEQ, qb, P + C_Q + (2 * h + c) * 64, P + C_K + (2 * h + c) * 64, P + C_V + h * 128 + vh * 64, (bf16*)att + c * 1024 + h * 128 + vh * 64, lds);
  }
}
#undef SBAR
#undef WAIT_BAR
}

#define XB_TMO      128
#define XB_XCNT(j)  (256  + 64 * (j))
#define XB_XSUB(j)  (1280 + 64 * (j))
#define XB_XGEN(j)  (2304 + 64 * (j))
#define XB_TOP      3328
#define XB_TOPGEN   3392
#define XCD_BAR_WORDS 3456
#define XB_SPIN_CAP (1u << 18)
__device__ __forceinline__ unsigned xb_ld(unsigned* p)              { return __hip_atomic_load(p, __ATOMIC_RELAXED, __HIP_MEMORY_SCOPE_AGENT); }
__device__ __forceinline__ unsigned xb_add(unsigned* p, unsigned v) { return __hip_atomic_fetch_add(p, v, __ATOMIC_RELAXED, __HIP_MEMORY_SCOPE_AGENT); }
__device__ __forceinline__ unsigned xb_xcc_id() { return (unsigned)__builtin_amdgcn_s_getreg((3 << 11) | 20) & 0xFu; }
#define XB_SPIN(cond, bar) do { unsigned _sp = 0; while (cond) { __builtin_amdgcn_s_sleep(1); \
    if ((++_sp & 255u) == 0u) { if (xb_ld(&(bar)[XB_TMO])) break; if (_sp > XB_SPIN_CAP) { atomicAdd(&(bar)[XB_TMO], 1u); break; } } } } while (0)
struct XcdBarrier { unsigned* bar; unsigned x; volatile LAS unsigned* st; };
__device__ __forceinline__ XcdBarrier xcd_barrier_post(unsigned* bar, volatile LAS unsigned* st) {
    XcdBarrier b; b.bar = bar; b.x = xb_xcc_id(); b.st = st;
    if (threadIdx.x == 0) (void)xb_add(&bar[XB_XCNT(b.x)], 1u);
    return b;
}
__device__ __forceinline__ void xcd_barrier_complete(unsigned* bar, unsigned x, unsigned& nloc, unsigned& nx) {
    const unsigned G = gridDim.x * gridDim.y * gridDim.z;
    unsigned sum, cnt, mine, sp = 0u;
    for (;;) {
        sum = 0u; cnt = 0u; mine = 0u;
#pragma unroll
        for (unsigned j = 0; j < 16; ++j) { const unsigned c = xb_ld(&bar[XB_XCNT(j)]); sum += c; cnt += (c > 0u) ? 1u : 0u; mine = (j == x) ? c : mine; }
        if (sum == G) break;
        __builtin_amdgcn_s_sleep(1);
        if ((++sp & 255u) == 0u) { if (xb_ld(&bar[XB_TMO])) break; if (sp > XB_SPIN_CAP) { atomicAdd(&bar[XB_TMO], 1u); break; } }
    }
    nloc = mine > 0u ? mine : 1u; nx = cnt > 0u ? cnt : 1u;
}
__device__ __forceinline__ void xcd_barrier(const XcdBarrier& b) {
    asm volatile("s_waitcnt vmcnt(0)" ::: "memory");
    __syncthreads();
    if (threadIdx.x == 0) {
        unsigned* bar = b.bar;
        __builtin_amdgcn_s_waitcnt(0);
        unsigned nloc = b.st[0], nx = b.st[1];
        if (nloc == 0u) { xcd_barrier_complete(bar, b.x, nloc, nx); b.st[0] = nloc; b.st[1] = nx; }
        const unsigned old = xb_add(&bar[XB_XSUB(b.x)], 1u);
        const unsigned gen = old / nloc;
        if (old + 1u == (gen + 1u) * nloc) {
            __builtin_amdgcn_fence(__ATOMIC_RELEASE, "agent");
            asm volatile("s_waitcnt vmcnt(0)" ::: "memory");
            const unsigned og = xb_add(&bar[XB_TOP], 1u);
            const unsigned tg = og / nx;
            if (og + 1u == (tg + 1u) * nx) xb_add(&bar[XB_TOPGEN], 1u);
            else XB_SPIN(xb_ld(&bar[XB_TOPGEN]) == tg, bar);
            __builtin_amdgcn_fence(__ATOMIC_ACQUIRE, "agent");
            xb_add(&bar[XB_XGEN(b.x)], 1u);
            asm volatile("s_waitcnt vmcnt(0)" ::: "memory");
        } else {
            XB_SPIN(xb_ld(&bar[XB_XGEN(b.x)]) == gen, bar);
            __builtin_amdgcn_fence(__ATOMIC_ACQUIRE, "agent");
            asm volatile("s_waitcnt vmcnt(0)" ::: "memory");
        }
    }
    __syncthreads();
}

struct Ptrs {
    const float* in[24]; float* out; unsigned char* ws;
};
__device__ __forceinline__ void p0_transpose_item(const float* W, int K, int N, int Nvalid, bf16_t* WT, LAS float* scr, int item, int nblk, int lane) {
    const int kb = item / nblk, nb = item % nblk, k0 = 64 * kb, n0 = 32 * nb;
    const int nn = n0 + (lane & 31); const bool ok = nn < Nvalid;
    float v[32];
#pragma unroll
    for (int i = 0; i < 32; ++i) { const int kk = 2 * i + (lane >> 5); v[i] = ok ? W[(size_t)(k0 + kk) * N + nn] : 0.f; }
#pragma unroll
    for (int i = 0; i < 32; ++i) { const int kk = 2 * i + (lane >> 5); scr[kk * 33 + (lane & 31)] = v[i]; }
    LDS_WAIT(); asm volatile("" ::: "memory");
    const int c = lane & 7;
#pragma unroll
    for (int j = 0; j < 4; ++j) { const int n = (lane >> 3) + 8 * j; const LAS float* s = scr + (8 * c) * 33 + n;
        u32x4 o; o.x = cvt_pk_bf16(s[0 * 33], s[1 * 33]); o.y = cvt_pk_bf16(s[2 * 33], s[3 * 33]); o.z = cvt_pk_bf16(s[4 * 33], s[5 * 33]); o.w = cvt_pk_bf16(s[6 * 33], s[7 * 33]);
        *(u32x4*)(WT + (size_t)(n0 + n) * K + k0 + 8 * c) = o; }
    LDS_WAIT(); asm volatile("" ::: "memory");
}
__device__ __forceinline__ void p0_prologue(const Ptrs& P, LAS unsigned char* lds, int gw, int NGW, int wave) {
    int tq_ = threadIdx.x; asm volatile("" : "+v"(tq_)); const int lane = tq_ & 63;
    LAS float* scr = (LAS float*)(lds + wave * 16384);
    unsigned char* ws = P.ws;
    constexpr int I_IN = 32 * (NPROJP / 32), I_OUT = 32 * 64;
    constexpr int NITEMS = I_IN + I_OUT;
    for (int it = gw; it < NITEMS; it += NGW) {
        int r = it;
        if (r < I_IN) { p0_transpose_item(P.in[3], DM, NPROJ, NPROJ, (bf16_t*)(ws + WS_WIN), scr, r, NPROJP / 32, lane); continue; } r -= I_IN;
        p0_transpose_item(P.in[15], DM, DM, DM, (bf16_t*)(ws + WS_WOUT), scr, r, 64, lane);
    }
    const float* x = P.in[0]; const float* nw = P.in[2]; bf16_t* XN = (bf16_t*)(ws + WS_XN);
    for (int m = gw; m < NTOK; m += NGW) {
        const f32x4* xr = (const f32x4*)(x + (size_t)m * DM) + lane; f32x4 v[8]; float s = 0.f;
#pragma unroll
        for (int j = 0; j < 8; ++j) { v[j] = xr[64 * j]; s += (v[j].x * v[j].x + v[j].y * v[j].y) + (v[j].z * v[j].z + v[j].w * v[j].w); }
        const float rstd = 1.0f / sqrtf(wave_sum(s) * (1.f / DM) + EPS);
        u32x2* o8 = (u32x2*)(XN + (size_t)m * DM) + lane;
#pragma unroll
        for (int j = 0; j < 8; ++j) { const f32x4 w = ((const f32x4*)nw)[lane + 64 * j]; u32x2 o; o.x = cvt_pk_bf16(v[j].x * rstd * w.x, v[j].y * rstd * w.y); o.y = cvt_pk_bf16(v[j].z * rstd * w.z, v[j].w * rstd * w.w); o8[64 * j] = o; }
    }
    const int* pos = (const int*)P.in[1]; float* rope = (float*)(ws + WS_ROPE);
    for (int idx = gw * 64 + lane; idx < NTOK * 8; idx += NGW * 64) {
        const int t = idx >> 3, i = idx & 7;
        const float inv = powf(500000.0f, -(float)(2 * i) / 16.0f);
        const float ang = (float)pos[t] * inv;
        rope[t * 16 + i] = (float)cos((double)ang); rope[t * 16 + 8 + i] = (float)sin((double)ang);
    }
}

constexpr int SP = 272;
constexpr int L_BN = 0, L_CN = 128 * SP, L_BT = 2 * 128 * SP, L_XT = 3 * 128 * SP, L_DT = L_XT + 64 * SP, L_CSV = L_DT + 512, L_DA = L_CSV + 512;
static_assert(L_DA + 512 <= RING_BYTES, "ssd lds");
static_assert(VAN_OFF + 512 * 16 <= BIAS_OFF && BIAS_OFF + 2048 <= LDS_BYTES, "lds map");
__device__ __forceinline__ int crow16(int r, int hi) { return (r & 3) + 8 * (r >> 2) + 4 * hi; }
template <bool SWA, bool SWB>
__device__ __forceinline__ f32x16 mm32_k128(const LAS unsigned char* As, int m0, const LAS unsigned char* Bs, int n0, int r32, int hi) {
    f32x16 acc = f32x16{};
    const int ra = m0 + r32, rbw = n0 + r32, xa = SWA ? ((ra >> 3) & 15) : 0, xb = SWB ? ((rbw >> 3) & 15) : 0;
#pragma unroll
    for (int k0 = 0; k0 < 128; k0 += 16) {
        const int kc = (k0 >> 3) + hi;
        const bf16x8 a = *(const LAS bf16x8*)(As + ra * SP + ((kc ^ xa) << 4));
        const bf16x8 b = *(const LAS bf16x8*)(Bs + rbw * SP + ((kc ^ xb) << 4));
        acc = __builtin_amdgcn_mfma_f32_32x32x16_bf16(a, b, acc, 0, 0, 0);
    }
    return acc;
}
constexpr int LA_BN = 0, LA_CN = 128 * SP, LA_BT = 2 * 128 * SP, LA_XT1 = LA_CN, LA_XT2 = LA_CN + 64 * SP, LA_DT = 3 * 128 * SP, LA_CSV = LA_DT + 2048, LA_TMP = LA_CSV + 2048;
static_assert(LA_TMP + 64 <= RING_BYTES, "ssd-a lds");
__device__ __forceinline__ void ssd_a_unit(const Ptrs& P, LAS unsigned char* lds, int b, int c, int g, int hh) {
    int tid = threadIdx.x; asm volatile("" : "+v"(tid));
    const int lane = tid & 63, wid = __builtin_amdgcn_readfirstlane(tid >> 6), r32 = lane & 31, hi = lane >> 5;
    unsigned char* ws = P.ws;
    const bf16_t* proj = (const bf16_t*)(ws + WS_PROJ);
    const float* dtraw = (const float*)(ws + WS_DTRAW);
    float* CS = (float*)(ws + WS_CS);
    const float* conv_w = P.in[9]; const float* conv_b = P.in[10];
    bf16_t* XCONV = (bf16_t*)(ws + WS_XCONV); bf16_t* CCONV = (bf16_t*)(ws + WS_CCONV);
    const int row0 = b * SEQ + c * 128, h0 = g * 8 + hh * 4;
    LAS float* sDT = (LAS float*)(lds + LA_DT); LAS float* sCS = (LAS float*)(lds + LA_CSV); LAS float* sTMP = (LAS float*)(lds + LA_TMP);
    const int hq = wid >> 1, stp = tid & 127;
    const float raw_q = dtraw[(size_t)(row0 + stp) * 16 + h0 + hq];
    if (tid < 384) {
        const int rb = tid >> 5, grp = tid & 31;
        const int ch = grp < 16 ? 1024 + g * 128 + 8 * grp : 1280 + g * 128 + 8 * (grp - 16);
        const int l0 = rb * 11, nrow = (l0 + 11 <= 128) ? 11 : 128 - l0;
        u32x4 v[14];
#pragma unroll
        for (int j = 0; j < 14; ++j) {
            const int ls = c * 128 + l0 - 3 + j;
            v[j] = (ls >= 0 && j < nrow + 3) ? *(const u32x4*)(proj + (size_t)(b * SEQ + ls) * NPROJP + C_XBC + ch) : (u32x4){0u, 0u, 0u, 0u};
        }
        f32x4 w[4][2];
#pragma unroll
        for (int j = 0; j < 4; ++j) { w[j][0] = *(const f32x4*)(conv_w + j * 1536 + ch); w[j][1] = *(const f32x4*)(conv_w + j * 1536 + ch + 4); }
        const f32x4 cb0 = *(const f32x4*)(conv_b + ch), cb1 = *(const f32x4*)(conv_b + ch + 4);
#pragma unroll
        for (int r = 0; r < 11; ++r) {
            if (r < nrow) {
                const int l = l0 + r;
                float a[8] = {cb0.x, cb0.y, cb0.z, cb0.w, cb1.x, cb1.y, cb1.z, cb1.w};
#pragma unroll
                for (int j = 0; j < 4; ++j) {
                    const u32x4 x = v[r + j];
                    a[0] += w[j][0].x * bf_lo(x.x); a[1] += w[j][0].y * bf_hi(x.x); a[2] += w[j][0].z * bf_lo(x.y); a[3] += w[j][0].w * bf_hi(x.y);
                    a[4] += w[j][1].x * bf_lo(x.z); a[5] += w[j][1].y * bf_hi(x.z); a[6] += w[j][1].z * bf_lo(x.w); a[7] += w[j][1].w * bf_hi(x.w);
                }
#pragma unroll
                for (int q = 0; q < 8; ++q) a[q] = a[q] * sigmoidf_(a[q]);
                u32x4 pk; pk.x = cvt_pk_bf16(a[0], a[1]); pk.y = cvt_pk_bf16(a[2], a[3]); pk.z = cvt_pk_bf16(a[4], a[5]); pk.w = cvt_pk_bf16(a[6], a[7]);
                if (grp < 16) {
                    const int n0 = 8 * grp;
                    *(LAS u32x4*)(lds + LA_BN + l * SP + n0 * 2) = pk;
                    const unsigned tb = (unsigned)(LA_BT + n0 * SP + (((l >> 3) ^ grp) << 4) + (l & 7) * 2);
                    *(LAS bf16_t*)(lds + tb + 0 * SP) = (bf16_t)(pk.x & 0xffffu); *(LAS bf16_t*)(lds + tb + 1 * SP) = (bf16_t)(pk.x >> 16);
                    *(LAS bf16_t*)(lds + tb + 2 * SP) = (bf16_t)(pk.y & 0xffffu); *(LAS bf16_t*)(lds + tb + 3 * SP) = (bf16_t)(pk.y >> 16);
                    *(LAS bf16_t*)(lds + tb + 4 * SP) = (bf16_t)(pk.z & 0xffffu); *(LAS bf16_t*)(lds + tb + 5 * SP) = (bf16_t)(pk.z >> 16);
                    *(LAS bf16_t*)(lds + tb + 6 * SP) = (bf16_t)(pk.w & 0xffffu); *(LAS bf16_t*)(lds + tb + 7 * SP) = (bf16_t)(pk.w >> 16);
                } else {
                    const int n0 = 8 * (grp - 16);
                    *(LAS u32x4*)(lds + LA_CN + l * SP + n0 * 2) = pk;
                    if (hh == 0) *(u32x4*)(CCONV + (size_t)(row0 + l) * 256 + g * 128 + n0) = pk;
                }
            }
        }
    }
    __syncthreads();
    f32x16 cbt[2];
#pragma unroll
    for (int q = 0; q < 2; ++q) { const int t = wid * 2 + q, mi = t >> 2, ni = t & 3; cbt[q] = mm32_k128<false, false>(lds + LA_CN, 32 * mi, lds + LA_BN, 32 * ni, r32, hi); }
    {
        const int h = h0 + hq;
        const float raw = raw_q + P.in[11][h];
        const float dtv = raw > 20.f ? raw : log1pf(expf(raw));
        float s_ = dtv * (-expf(P.in[12][h]));
#pragma unroll
        for (int o = 1; o < 64; o <<= 1) { const float t = __shfl_up(s_, o); if (lane >= o) s_ += t; }
        if ((tid & 127) == 63) sTMP[hq] = s_;
        __syncthreads();
        if (tid & 64) s_ += sTMP[hq];
        sDT[hq * 128 + stp] = dtv; sCS[hq * 128 + stp] = s_; CS[(size_t)(row0 + stp) * 16 + h] = s_;
        __syncthreads();
    }
#pragma unroll 1
    for (int i = 0; i < 4; ++i) {
        const int h = h0 + i;
        const int l2 = tid >> 3, grp = tid & 7, chx = h * 64 + 8 * grp, lx = 2 * l2;
        u32x4 xv[5];
#pragma unroll
        for (int j = 0; j < 5; ++j) { const int ls = c * 128 + lx - 3 + j; xv[j] = (ls >= 0) ? *(const u32x4*)(proj + (size_t)(b * SEQ + ls) * NPROJP + C_XBC + chx) : (u32x4){0u, 0u, 0u, 0u}; }
        LAS float* sDTh = sDT + i * 128; LAS float* sCSh = sCS + i * 128;
        const float cs_last = sCSh[127];
        {
            f32x4 w[4][2];
#pragma unroll
            for (int j = 0; j < 4; ++j) { w[j][0] = *(const f32x4*)(conv_w + j * 1536 + chx); w[j][1] = *(const f32x4*)(conv_w + j * 1536 + chx + 4); }
            const f32x4 cb0 = *(const f32x4*)(conv_b + chx), cb1 = *(const f32x4*)(conv_b + chx + 4);
#pragma unroll
            for (int r = 0; r < 2; ++r) {
                const int l = lx + r;
                float a[8] = {cb0.x, cb0.y, cb0.z, cb0.w, cb1.x, cb1.y, cb1.z, cb1.w};
#pragma unroll
                for (int j = 0; j < 4; ++j) {
                    const u32x4 x = xv[r + j];
                    a[0] += w[j][0].x * bf_lo(x.x); a[1] += w[j][0].y * bf_hi(x.x); a[2] += w[j][0].z * bf_lo(x.y); a[3] += w[j][0].w * bf_hi(x.y);
                    a[4] += w[j][1].x * bf_lo(x.z); a[5] += w[j][1].y * bf_hi(x.z); a[6] += w[j][1].z * bf_lo(x.w); a[7] += w[j][1].w * bf_hi(x.w);
                }
#pragma unroll
                for (int q = 0; q < 8; ++q) a[q] = a[q] * sigmoidf_(a[q]);
                u32x4 pk; pk.x = cvt_pk_bf16(a[0], a[1]); pk.y = cvt_pk_bf16(a[2], a[3]); pk.z = cvt_pk_bf16(a[4], a[5]); pk.w = cvt_pk_bf16(a[6], a[7]);
                *(u32x4*)(XCONV + (size_t)(row0 + l) * 1024 + chx) = pk;
                const float dt = sDTh[l], dw = dt * fexp(cs_last - sCSh[l]);
                const unsigned tb = (unsigned)((8 * grp) * SP + (((l >> 3) ^ grp) << 4) + (l & 7) * 2);
#pragma unroll
                for (int q = 0; q < 8; q += 2) {
                    const unsigned p1 = cvt_pk_bf16(a[q] * dt, a[q + 1] * dt), p2 = cvt_pk_bf16(a[q] * dw, a[q + 1] * dw);
                    *(LAS bf16_t*)(lds + LA_XT1 + tb + q * SP) = (bf16_t)(p1 & 0xffffu); *(LAS bf16_t*)(lds + LA_XT1 + tb + (q + 1) * SP) = (bf16_t)(p1 >> 16);
                    *(LAS bf16_t*)(lds + LA_XT2 + tb + q * SP) = (bf16_t)(p2 & 0xffffu); *(LAS bf16_t*)(lds + LA_XT2 + tb + (q + 1) * SP) = (bf16_t)(p2 >> 16);
                }
            }
        }
#pragma unroll
        for (int q = 0; q < 2; ++q) {
            const int t = wid * 2 + q, mi = t >> 2, ni = t & 3; const int s_ = 32 * ni + r32; const float css = sCSh[s_];
#pragma unroll
            for (int r = 0; r < 16; ++r) { const int l = 32 * mi + crow16(r, hi); const float m = (s_ <= l) ? cbt[q][r] * fexp(sCSh[l] - css) : 0.f; *(LAS bf16_t*)(lds + LA_BN + l * SP + s_ * 2) = f2bf(m); }
        }
        __syncthreads();
        {
            const int mi = wid >> 2, ni = wid & 3;
            const f32x16 acc = mm32_k128<true, true>(lds + LA_XT2, 32 * mi, lds + LA_BT, 32 * ni, r32, hi);
            float* st = (float*)(ws + WS_STATES) + ((size_t)((b * 16 + c) * 16 + h)) * 8192;
#pragma unroll
            for (int r = 0; r < 16; ++r) st[(32 * mi + crow16(r, hi)) * 128 + 32 * ni + r32] = acc[r];
        }
        {
            const int mi = wid >> 1, ni = wid & 1;
            const f32x16 acc = mm32_k128<false, true>(lds + LA_BN, 32 * mi, lds + LA_XT1, 32 * ni, r32, hi);
            float* yd = (float*)(ws + WS_YDIAG);
#pragma unroll
            for (int r = 0; r < 16; ++r) yd[(size_t)(row0 + 32 * mi + crow16(r, hi)) * 1024 + h * 64 + 32 * ni + r32] = acc[r];
        }
        __syncthreads();
    }
}
__device__ __forceinline__ void ssd_scan(const Ptrs& P, int gtid, int nthr) {
    float* st = (float*)(P.ws + WS_STATES); const float* CS = (const float*)(P.ws + WS_CS);
    for (int e4 = gtid; e4 < NB * 16 * 2048; e4 += nthr) {
        const int bh = e4 >> 11, off = e4 & 2047, b = bh >> 4, h = bh & 15;
        f32x4 sv[16]; float dec[16];
#pragma unroll
        for (int c = 0; c < 16; ++c) { sv[c] = *((const f32x4*)(st + ((size_t)((b * 16 + c) * 16 + h)) * 8192) + off); dec[c] = CS[(size_t)(b * SEQ + c * 128 + 127) * 16 + h]; }
        f32x4 carry = (f32x4){0.f, 0.f, 0.f, 0.f};
#pragma unroll
        for (int c = 0; c < 16; ++c) {
            *((f32x4*)(st + ((size_t)((b * 16 + c) * 16 + h)) * 8192) + off) = carry;
            carry = carry * fexp(dec[c]) + sv[c];
        }
    }
}
constexpr int L2_CS = 0, L2_PV = 64 * SP, L2_Y = L2_PV + 2 * 64 * SP, YP = 1040;
static_assert(L2_Y + 64 * YP <= RING_BYTES, "ssd-c lds");
__device__ __forceinline__ void ssd_c_unit(const Ptrs& P, LAS unsigned char* lds, int b, int c, int g, int rh) {
    int tid = threadIdx.x; asm volatile("" : "+v"(tid));
    const int lane = tid & 63, wid = __builtin_amdgcn_readfirstlane(tid >> 6), r32 = lane & 31, hi = lane >> 5;
    unsigned char* ws = P.ws;
    const int row0 = b * SEQ + c * 128 + rh * 64;
    const bf16_t* CCONV = (const bf16_t*)(ws + WS_CCONV); const bf16_t* XCONV = (const bf16_t*)(ws + WS_XCONV); const bf16_t* proj = (const bf16_t*)(ws + WS_PROJ);
    const float* st = (const float*)(ws + WS_STATES); const float* CS = (const float*)(ws + WS_CS); const float* yd = (const float*)(ws + WS_YDIAG);
    bf16_t* CAT = (bf16_t*)(ws + WS_CAT);
    for (int q = tid; q < 64 * 16; q += 512) { const int l = q >> 4, n8 = q & 15; *(LAS u32x4*)(lds + L2_CS + l * SP + n8 * 16) = *(const u32x4*)(CCONV + (size_t)(row0 + l) * 256 + g * 128 + n8 * 8); }
    const int hw = wid >> 2, tile = wid & 3, mi = tile >> 1, ni = tile & 1;
    for (int hp = 0; hp < 4; ++hp) {
        __syncthreads();
        const int h0 = g * 8 + 2 * hp;
        const int h = h0 + hw;
        const unsigned rowA = (unsigned)(row0 + 32 * mi + 4 * hi), col = (unsigned)(h * 64 + 32 * ni + r32);
        float e_yd[16], e_cs[16]; bf16_t e_xc[16], e_z[16];
#pragma unroll
        for (int r = 0; r < 16; ++r) { const unsigned row = rowA + 8 * (r >> 2) + (r & 3);
            e_yd[r] = yd[row * 1024u + col]; e_cs[r] = CS[row * 16u + (unsigned)h]; e_xc[r] = XCONV[row * 1024u + col]; e_z[r] = proj[row * (unsigned)NPROJP + (unsigned)C_Z + col]; }
#pragma unroll
        for (int q = 0; q < 4; ++q) {
            const int idx = tid + 512 * q, hh = idx >> 10, rem = idx & 1023, p = rem >> 4, n8 = rem & 15;
            const float* src = st + ((size_t)((b * 16 + c) * 16 + h0 + hh)) * 8192 + p * 128 + n8 * 8;
            const f32x4 v0 = *(const f32x4*)src, v1 = *(const f32x4*)(src + 4);
            u32x4 pk; pk.x = cvt_pk_bf16(v0.x, v0.y); pk.y = cvt_pk_bf16(v0.z, v0.w); pk.z = cvt_pk_bf16(v1.x, v1.y); pk.w = cvt_pk_bf16(v1.z, v1.w);
            *(LAS u32x4*)(lds + L2_PV + (hh * 64 + p) * SP + n8 * 16) = pk;
        }
        __syncthreads();
        const f32x16 acc = mm32_k128<false, false>(lds + L2_CS, 32 * mi, lds + L2_PV + hw * 64 * SP, 32 * ni, r32, hi);
        const float dsk = P.in[13][h];
        const unsigned ybase = (unsigned)(L2_Y + (32 * mi + 4 * hi) * YP + ((2 * hp + hw) * 64 + 32 * ni + r32) * 2);
#pragma unroll
        for (int r = 0; r < 16; ++r) {
            float y = acc[r] * fexp(e_cs[r]) + e_yd[r] + dsk * bf2f(e_xc[r]);
            const float z = bf2f(e_z[r]);
            y *= z * sigmoidf_(z);
            *(LAS bf16_t*)(lds + ybase + (8 * (r >> 2) + (r & 3)) * YP) = f2bf(y);
        }
    }
    __syncthreads();
    const float* nw = P.in[14] + g * 512 + 8 * lane;
    const f32x4 nw0 = *(const f32x4*)nw, nw1 = *(const f32x4*)(nw + 4);
    for (int i = 0; i < 8; ++i) {
        const int ll = wid * 8 + i;
        const u32x4 v = *(const LAS u32x4*)(lds + L2_Y + ll * YP + lane * 16);
        float a[8] = {bf_lo(v.x), bf_hi(v.x), bf_lo(v.y), bf_hi(v.y), bf_lo(v.z), bf_hi(v.z), bf_lo(v.w), bf_hi(v.w)};
        float ss = 0.f;
#pragma unroll
        for (int k = 0; k < 8; ++k) ss += a[k] * a[k];
        const float rstd = rsqrtf_(wave_sum(ss) * (1.f / 512.f) + EPS);
        u32x4 o; o.x = cvt_pk_bf16(a[0] * rstd * nw0.x, a[1] * rstd * nw0.y); o.y = cvt_pk_bf16(a[2] * rstd * nw0.z, a[3] * rstd * nw0.w);
        o.z = cvt_pk_bf16(a[4] * rstd * nw1.x, a[5] * rstd * nw1.y); o.w = cvt_pk_bf16(a[6] * rstd * nw1.z, a[7] * rstd * nw1.w);
        *(u32x4*)(CAT + (size_t)(row0 + ll) * DM + 1024 + g * 512 + 8 * lane) = o;
    }
    __syncthreads();
}
__device__ __forceinline__ void attn_post(const Ptrs& P, int gw, int NGW) {
    int tq_ = threadIdx.x; asm volatile("" : "+v"(tq_)); const int lane = tq_ & 63;
    float d1 = 0.f, d2 = 0.f;
    for (int i = 0; i < 64; ++i) { d1 += P.in[4][i] * P.in[5][i]; d2 += P.in[6][i] * P.in[7][i]; }
    const float lam = expf(d1) - expf(d2) + LAM_INIT;
    const bf16_t* ATT = (const bf16_t*)(P.ws + WS_ATT); bf16_t* CAT = (bf16_t*)(P.ws + WS_CAT);
    const float* sw = P.in[8] + (lane & 7) * 16;
    float swv[16];
#pragma unroll
    for (int i = 0; i < 16; ++i) swv[i] = sw[i] * (1.0f - LAM_INIT);
    for (int t0 = gw; t0 < NTOK; t0 += 4 * NGW) {
        u32x4 ld[4][4];
#pragma unroll
        for (int k = 0; k < 4; ++k) { const int t = t0 + k * NGW; if (t < NTOK) {
            const u32x4* p0 = (const u32x4*)(ATT + (size_t)t * 2048 + lane * 16); const u32x4* p1 = (const u32x4*)(ATT + (size_t)t * 2048 + 1024 + lane * 16);
            ld[k][0] = p0[0]; ld[k][1] = p0[1]; ld[k][2] = p1[0]; ld[k][3] = p1[1]; } }
#pragma unroll
        for (int k = 0; k < 4; ++k) { const int t = t0 + k * NGW; if (t < NTOK) {
            const u32x4 a0 = ld[k][0], a1 = ld[k][1], b0 = ld[k][2], b1 = ld[k][3];
            float a[16];
            a[0] = bf_lo(a0.x) - lam * bf_lo(b0.x); a[1] = bf_hi(a0.x) - lam * bf_hi(b0.x); a[2] = bf_lo(a0.y) - lam * bf_lo(b0.y); a[3] = bf_hi(a0.y) - lam * bf_hi(b0.y);
            a[4] = bf_lo(a0.z) - lam * bf_lo(b0.z); a[5] = bf_hi(a0.z) - lam * bf_hi(b0.z); a[6] = bf_lo(a0.w) - lam * bf_lo(b0.w); a[7] = bf_hi(a0.w) - lam * bf_hi(b0.w);
            a[8] = bf_lo(a1.x) - lam * bf_lo(b1.x); a[9] = bf_hi(a1.x) - lam * bf_hi(b1.x); a[10] = bf_lo(a1.y) - lam * bf_lo(b1.y); a[11] = bf_hi(a1.y) - lam * bf_hi(b1.y);
            a[12] = bf_lo(a1.z) - lam * bf_lo(b1.z); a[13] = bf_hi(a1.z) - lam * bf_hi(b1.z); a[14] = bf_lo(a1.w) - lam * bf_lo(b1.w); a[15] = bf_hi(a1.w) - lam * bf_hi(b1.w);
            float ss = 0.f;
#pragma unroll
            for (int i = 0; i < 16; ++i) ss += a[i] * a[i];
            ss += __shfl_xor(ss, 1); ss += __shfl_xor(ss, 2); ss += __shfl_xor(ss, 4);
            const float rstd = rsqrtf_(ss * (1.f / 128.f) + EPS);
            float o[16];
#pragma unroll
            for (int i = 0; i < 16; ++i) o[i] = a[i] * rstd * swv[i];
            u32x4 w0, w1;
            w0.x = cvt_pk_bf16(o[0], o[1]); w0.y = cvt_pk_bf16(o[2], o[3]); w0.z = cvt_pk_bf16(o[4], o[5]); w0.w = cvt_pk_bf16(o[6], o[7]);
            w1.x = cvt_pk_bf16(o[8], o[9]); w1.y = cvt_pk_bf16(o[10], o[11]); w1.z = cvt_pk_bf16(o[12], o[13]); w1.w = cvt_pk_bf16(o[14], o[15]);
            u32x4* op = (u32x4*)(CAT + (size_t)t * DM + lane * 16); op[0] = w0; op[1] = w1; } }
    }
}
constexpr int R_RED = 0, R_SSQ = 8 * 4096, R_LOG = R_SSQ + 8 * 128, R_RSTD = R_LOG + 4096;
__device__ __forceinline__ void router_tile(const Ptrs& P, LAS unsigned char* lds, int tile) {
    int tid = threadIdx.x; asm volatile("" : "+v"(tid));
    const int lane = tid & 63, wid = __builtin_amdgcn_readfirstlane(tid >> 6), tt = lane & 31, kk = lane >> 5;
    unsigned char* ws = P.ws;
    const bf16_t* X1 = (const bf16_t*)(ws + WS_X1); bf16_t* H2 = (bf16_t*)(ws + WS_H2);
    const float* nw = P.in[16]; const float* rw = P.in[17]; const float* rb = P.in[18];
    int* TOPE = (int*)(ws + WS_ROUTE + RT_TOPE); float* TOPG = (float*)(ws + WS_ROUTE + RT_TOPG); int* LRANK = (int*)(ws + WS_ROUTE + RT_LRANK); int* HIST = (int*)(ws + WS_ROUTE + RT_HIST);
    LAS int* lhist = (LAS int*)(lds + LHIST_OFF);
    LAS float* red = (LAS float*)(lds + R_RED); LAS float* ssqp = (LAS float*)(lds + R_SSQ); LAS float* slog = (LAS float*)(lds + R_LOG); LAS float* srstd = (LAS float*)(lds + R_RSTD);
    const int t0 = tile * 32;
    if (tid < 32) lhist[tid] = 0;
    {
        f32x16 acc = f32x16{}; float ssq = 0.f;
        const int r32 = tt, hi = kk;
        const bf16_t* xp = X1 + (size_t)(t0 + r32) * DM + wid * 256 + 8 * hi;
        const float* wp = rw + (size_t)(wid * 256 + 8 * hi) * 32 + r32;
        const float* np = nw + wid * 256 + 8 * hi;
#pragma unroll 4
        for (int i = 0; i < 16; ++i) {
            const u32x4 xa = *(const u32x4*)(xp + 16 * i);
            const f32x4 n0 = *(const f32x4*)(np + 16 * i), n1 = *(const f32x4*)(np + 16 * i + 4);
            float w[8];
#pragma unroll
            for (int jx = 0; jx < 8; ++jx) w[jx] = wp[(16 * i + jx) * 32];
            w[0] *= n0.x; w[1] *= n0.y; w[2] *= n0.z; w[3] *= n0.w; w[4] *= n1.x; w[5] *= n1.y; w[6] *= n1.z; w[7] *= n1.w;
            u32x4 wh, wl;
            wh.x = cvt_pk_bf16(w[0], w[1]); wh.y = cvt_pk_bf16(w[2], w[3]); wh.z = cvt_pk_bf16(w[4], w[5]); wh.w = cvt_pk_bf16(w[6], w[7]);
            wl.x = cvt_pk_bf16(w[0] - bf_lo(wh.x), w[1] - bf_hi(wh.x)); wl.y = cvt_pk_bf16(w[2] - bf_lo(wh.y), w[3] - bf_hi(wh.y));
            wl.z = cvt_pk_bf16(w[4] - bf_lo(wh.z), w[5] - bf_hi(wh.z)); wl.w = cvt_pk_bf16(w[6] - bf_lo(wh.w), w[7] - bf_hi(wh.w));
            const bf16x8 af = __builtin_bit_cast(bf16x8, xa);
            acc = __builtin_amdgcn_mfma_f32_32x32x16_bf16(af, __builtin_bit_cast(bf16x8, wh), acc, 0, 0, 0);
            acc = __builtin_amdgcn_mfma_f32_32x32x16_bf16(af, __builtin_bit_cast(bf16x8, wl), acc, 0, 0, 0);
            const float x0 = bf_lo(xa.x), x1 = bf_hi(xa.x), x2 = bf_lo(xa.y), x3 = bf_hi(xa.y), x4 = bf_lo(xa.z), x5 = bf_hi(xa.z), x6 = bf_lo(xa.w), x7 = bf_hi(xa.w);
            ssq += ((x0 * x0 + x1 * x1) + (x2 * x2 + x3 * x3)) + ((x4 * x4 + x5 * x5) + (x6 * x6 + x7 * x7));
        }
        ssq += __shfl_xor(ssq, 32);
        if (kk == 0) ssqp[wid * 32 + tt] = ssq;
#pragma unroll
        for (int r = 0; r < 16; ++r) red[wid * 1024 + crow16(r, kk) * 32 + tt] = acc[r];
    }
    __syncthreads();
    if (tid < 32) { float s = 0.f;
#pragma unroll
        for (int w = 0; w < 8; ++w) s += ssqp[w * 32 + tid];
        srstd[tid] = rsqrtf_(s * (1.f / DM) + EPS); }
    __syncthreads();
    for (int q = tid; q < 1024; q += 512) { float s = 0.f;
#pragma unroll
        for (int w = 0; w < 8; ++w) s += red[w * 1024 + q];
        slog[q] = s * srstd[q >> 5] + rb[q & 31]; }
    __syncthreads();
#pragma unroll
    for (int it = 0; it < 2; ++it) {
        const int tl = wid * 4 + it * 2 + kk, t = t0 + tl;
        float v = slog[tl * 32 + tt];
        float tv[4]; int te[4];
#pragma unroll
        for (int j = 0; j < 4; ++j) {
            float bv = v; int be = tt;
#pragma unroll
            for (int o = 1; o < 32; o <<= 1) { const float ov = __shfl_xor(bv, o); const int oe = __shfl_xor(be, o); const bool take = (ov > bv) || (ov == bv && oe < be); bv = take ? ov : bv; be = take ? oe : be; }
            tv[j] = bv; te[j] = be; if (tt == be) v = -INFINITY;
        }
        const float e1 = fexp(tv[1] - tv[0]), e2 = fexp(tv[2] - tv[0]), e3 = fexp(tv[3] - tv[0]); const float inv = 1.f / (1.f + e1 + e2 + e3);
        if (tt < 4) {
            const int ej = tt == 0 ? te[0] : tt == 1 ? te[1] : tt == 2 ? te[2] : te[3];
            const float gj = (tt == 0 ? 1.f : tt == 1 ? e1 : tt == 2 ? e2 : e3) * inv;
            const int lr = atomicAdd((int*)(lhist + ej), 1);
            TOPE[t * 4 + tt] = ej; TOPG[t * 4 + tt] = gj; LRANK[t * 4 + tt] = lr;
        }
    }
    {
        u32x2 xb[4][8]; f32x4 wv[8];
#pragma unroll
        for (int q = 0; q < 8; ++q) wv[q] = ((const f32x4*)nw)[lane + 64 * q];
#pragma unroll
        for (int r = 0; r < 4; ++r)
#pragma unroll
            for (int q = 0; q < 8; ++q) xb[r][q] = ((const u32x2*)(X1 + (size_t)(t0 + wid * 4 + r) * DM))[lane + 64 * q];
#pragma unroll
        for (int r = 0; r < 4; ++r) {
            const int tl = wid * 4 + r; const float rs = srstd[tl];
            u32x2* o8 = (u32x2*)(H2 + (size_t)(t0 + tl) * DM) + lane;
#pragma unroll
            for (int q = 0; q < 8; ++q) { const f32x4 x = (f32x4){bf_lo(xb[r][q].x), bf_hi(xb[r][q].x), bf_lo(xb[r][q].y), bf_hi(xb[r][q].y)}; u32x2 o; o.x = cvt_pk_bf16(x.x * rs * wv[q].x, x.y * rs * wv[q].y); o.y = cvt_pk_bf16(x.z * rs * wv[q].z, x.w * rs * wv[q].w); o8[64 * q] = o; }
        }
    }
    __syncthreads();
    if (tid < 32) HIST[tile * 32 + tid] = lhist[tid];
    __syncthreads();
}
__device__ __forceinline__ void route_positions(const Ptrs& P, LAS unsigned char* lds, int tile) {
    unsigned char* ws = P.ws; const int tid = threadIdx.x;
    const int* HIST = (const int*)(ws + WS_ROUTE + RT_HIST); const int* TOPE = (const int*)(ws + WS_ROUTE + RT_TOPE); const int* LRANK = (const int*)(ws + WS_ROUTE + RT_LRANK);
    int* TOKPOS = (int*)(ws + WS_ROUTE + RT_TOKPOS); int* META = (int*)(ws + WS_ROUTE + RT_META); int* ROWTOK = (int*)(ws + WS_ROUTE + RT_ROWTOK);
    LAS int* sh = (LAS int*)lds;
    LAS int* stot = sh + 8192; LAS int* sbase = stot + 32; LAS int* sseg = sbase + 32;
    __syncthreads();
    for (int i = tid; i < 8192; i += 512) sh[i] = HIST[i];
    __syncthreads();
    if (tid < 32) { int tot = 0, base = 0; for (int i = 0; i < 256; ++i) { const int v = sh[i * 32 + tid]; if (i < tile) base += v; tot += v; } stot[tid] = tot; sbase[tid] = base; }
    __syncthreads();
    if (tid == 0) { int s = 0; for (int e = 0; e < 32; ++e) { sseg[e] = s; s += (stot[e] + 255) & ~255; } sseg[32] = s; }
    __syncthreads();
    if (tid < 128) { const int t = tile * 32 + (tid >> 2), j = tid & 3; const int e = TOPE[t * 4 + j]; const int pos = sseg[e] + sbase[e] + LRANK[t * 4 + j]; ROWTOK[pos] = t; TOKPOS[t * 4 + j] = pos; }
    if (tile < 32) { const int e = tile; for (int p = stot[e] + tid; p < ((stot[e] + 255) & ~255); p += 512) ROWTOK[sseg[e] + p] = 0; }
    if (tile == 0) {
        if (tid < 33) META[META_SEG + tid] = sseg[tid];
        if (tid == 0) META[META_NT] = sseg[32] >> 8;
        if (tid < 32) { const int e = tid, first = sseg[e] >> 8, ne = (sseg[e + 1] >> 8) - first; for (int T = first; T < first + ne; ++T) META[META_TILE_E + T] = e | (first << 8) | (ne << 20); }
    }
    __syncthreads();
}
__device__ __forceinline__ void final_rows(const Ptrs& P, int gw, int NGW) {
    int tq_ = threadIdx.x; asm volatile("" : "+v"(tq_)); const int lane = tq_ & 63;
    unsigned char* ws = P.ws;
    const bf16_t* X1 = (const bf16_t*)(ws + WS_X1); const bf16_t* YS = (const bf16_t*)(ws + WS_YS);
    const int* TOKPOS = (const int*)(ws + WS_ROUTE + RT_TOKPOS); const float* TOPG = (const float*)(ws + WS_ROUTE + RT_TOPG);
    const float* nw = P.in[23];
    for (int t = gw; t < NTOK; t += NGW) {
        f32x4 v[8];
#pragma unroll
        for (int q = 0; q < 8; ++q) { const u32x2 xb = ((const u32x2*)(X1 + (size_t)t * DM))[lane + 64 * q]; v[q] = (f32x4){bf_lo(xb.x), bf_hi(xb.x), bf_lo(xb.y), bf_hi(xb.y)}; }
#pragma unroll
        for (int j = 0; j < 4; ++j) {
            const int pos = TOKPOS[t * 4 + j]; const float gj = TOPG[t * 4 + j];
            const u32x2* yr = (const u32x2*)(YS + (size_t)pos * DM);
#pragma unroll
            for (int q = 0; q < 8; ++q) { const u32x2 y = yr[lane + 64 * q]; v[q].x += gj * bf_lo(y.x); v[q].y += gj * bf_hi(y.x); v[q].z += gj * bf_lo(y.y); v[q].w += gj * bf_hi(y.y); }
        }
        float s = 0.f;
#pragma unroll
        for (int q = 0; q < 8; ++q) s += (v[q].x * v[q].x + v[q].y * v[q].y) + (v[q].z * v[q].z + v[q].w * v[q].w);
        const float rstd = 1.0f / sqrtf(wave_sum(s) * (1.f / DM) + EPS);
#pragma unroll
        for (int q = 0; q < 8; ++q) { const f32x4 w = ((const f32x4*)nw)[lane + 64 * q]; ((f32x4*)(P.out + (size_t)t * DM))[lane + 64 * q] = v[q] * rstd * w; }
    }
}

constexpr int NPHASE = 12;
struct Args { Ptrs p; int ph_lo, ph_hi; };
__global__ void __launch_bounds__(NWAVES * 64, 2) hybrid_fwd(Args args) {
    extern __shared__ __attribute__((aligned(16))) unsigned char lds_raw[];
    LAS unsigned char* lds = (LAS unsigned char*)lds_raw;
    const int tid = threadIdx.x, wave = __builtin_amdgcn_readfirstlane(tid >> 6);
    const int G = gridDim.x; const int bx = blockIdx.x; const int vcu = (G % 8 == 0) ? (bx % 8) * (G / 8) + bx / 8 : bx;
    const Ptrs& P = args.p; unsigned char* ws = P.ws;
    unsigned* ctl = (unsigned*)(ws + WS_CTL);
    for (int u = tid; u < (LDS_BYTES - LDSCTL_OFF) / 4; u += NWAVES * 64) ((LAS unsigned*)(lds + LDSCTL_OFF))[u] = 0u;
    __syncthreads();
    volatile LAS unsigned* MISC = (volatile LAS unsigned*)(lds + MISC_OFF);
    XcdBarrier bar; bar.bar = ctl + CW_BAR; bar.x = 0; bar.st = nullptr;
    if (MK_N_LAUNCHES == 1) bar = xcd_barrier_post(ctl + CW_BAR, MISC + 8);
#define GRID_BAR() do { if (MK_N_LAUNCHES == 1) xcd_barrier(bar); } while (0)
    const int lo = args.ph_lo, hi_ = args.ph_hi;
#ifndef PHASE_MASK
#define PHASE_MASK 0xFFFF
#endif
#define IN(k) (((PHASE_MASK >> (k)) & 1) && lo <= (k) && (k) < hi_)
#define BOTH(k) (IN(k) && IN((k) + 1))
    const int gw = vcu * NWAVES + wave, NGW = G * NWAVES;

    if (IN(0)) { p0_prologue(P, lds, gw, NGW, wave); if (BOTH(0)) GRID_BAR(); }
    if (IN(1)) {
        pg8::SchedDense S; S.init(ws + WS_XN, ws + WS_WIN, NTOK, NPROJP, G, bx);
        pg8::EpiProj E{(bf16_t*)(ws + WS_PROJ), (float*)(ws + WS_DTRAW), (const float*)(ws + WS_ROPE)};
        pg8::gemm_phase<pg8::EpiProj, pg8::SchedDense>(lds, S, E);
        if (BOTH(1)) GRID_BAR();
    }
    if (IN(2)) {
        attn_body::attn_phase128((char*)lds_raw, (const bf16_t*)(ws + WS_PROJ), (bf16_t*)(ws + WS_ATT), G, vcu);
        __syncthreads();
    }
    if (IN(11)) {
        for (int u = vcu; u < NB * 16 * 2 * 2; u += G) { const int hh = u & 1, g = (u >> 1) & 1, c = (u >> 2) & 15, b = u >> 6; ssd_a_unit(P, lds, b, c, g, hh); }
        GRID_BAR();
    }
    if (IN(3)) { ssd_scan(P, vcu * 512 + tid, G * 512); if (BOTH(3)) GRID_BAR(); }
    if (IN(4)) {
#ifndef NO_SSDC
        for (int u = vcu; u < NB * 16 * 2 * 2; u += G) { const int rh = u & 1, g = (u >> 1) & 1, c = (u >> 2) & 15, b = u >> 6; ssd_c_unit(P, lds, b, c, g, rh); }
#endif
#ifndef NO_APOST
        attn_post(P, gw, NGW);
#endif
        if (BOTH(4)) GRID_BAR();
    }
    if (IN(5)) {
        pg8::SchedDense S; S.init(ws + WS_CAT, ws + WS_WOUT, NTOK, DM, G, bx);
        pg8::EpiRes E{P.in[0], (bf16_t*)(ws + WS_X1), DM};
        pg8::gemm_phase<pg8::EpiRes, pg8::SchedDense>(lds, S, E);
        if (BOTH(5)) GRID_BAR();
    }
    if (IN(6)) { for (int tile = vcu; tile < 256; tile += G) router_tile(P, lds, tile); if (BOTH(6)) GRID_BAR(); }
    if (IN(7)) { for (int tile = vcu; tile < 256; tile += G) route_positions(P, lds, tile); if (BOTH(7)) GRID_BAR(); }
    if (IN(8)) {
        const int* META = (const int*)(ws + WS_ROUTE + RT_META);
        typedef pg8::SchedMoeF<4096, 8192, true> SG;
        SG S; S.A = (const char*)(ws + WS_H2); S.W = P.in[19]; S.tile_e = META + META_TILE_E; S.rowtok = (const int*)(ws + WS_ROUTE + RT_ROWTOK);
        S.nT = META[META_NT]; S.nN = 16; S.G = G; S.c = vcu;
        pg8::EpiGate E{(bf16_t*)(ws + WS_ACT), P.in[20], ctl + CW_TCNT};
        pg8::gemm_phase_fb<pg8::EpiGate, SG, 4096, 8192, true>(lds, S, E);
        if (MK_N_LAUNCHES != 1 && BOTH(8)) GRID_BAR();
    }
    if (IN(9)) {
        const int* META = (const int*)(ws + WS_ROUTE + RT_META);
        typedef pg8::SchedMoeF<2048, 512, false> SD;
        SD S; S.A = (const char*)(ws + WS_ACT); S.W = P.in[21]; S.tile_e = META + META_TILE_E; S.rowtok = nullptr;
        S.nT = META[META_NT]; S.nN = 8; S.G = G;
        { const int r8 = ((S.nT * 16) % G) & ~31; S.c = (MK_N_LAUNCHES == 1) ? (vcu - r8 + G) % G : vcu; }
        pg8::EpiDown E{(bf16_t*)(ws + WS_YS), P.in[22]};
        pg8::gemm_phase_fb<pg8::EpiDown, SD, 2048, 512, false, MK_N_LAUNCHES == 1>(lds, S, E, ctl + CW_TCNT, 128u);
        if (BOTH(9)) GRID_BAR();
    }
    if (IN(10)) { final_rows(P, gw, NGW); }
#undef IN
#undef BOTH
#undef GRID_BAR
}

extern "C" void kernel_launch(void* const* d_in, const int* in_sizes, int n_in, void* d_out, int out_size, void* d_ws, size_t ws_size, hipStream_t stream) {
    static int grid = 0;
    if (grid == 0) {
        if (n_in != 24 || out_size != NTOK * DM || ws_size < WS_END) { fprintf(stderr, "kernel_launch: unexpected shapes (n_in %d, out %d, ws %zu)\n", n_in, out_size, ws_size); grid = -1; return; }
        int dev = 0, cus = 0, per_cu = 0;
        if (hipGetDevice(&dev) != hipSuccess || hipDeviceGetAttribute(&cus, hipDeviceAttributeMultiprocessorCount, dev) != hipSuccess) { grid = -1; return; }
        if (hipFuncSetAttribute((const void*)hybrid_fwd, hipFuncAttributeMaxDynamicSharedMemorySize, LDS_BYTES) != hipSuccess) { fprintf(stderr, "kernel_launch: hipFuncSetAttribute failed\n"); grid = -1; return; }
        if (hipOccupancyMaxActiveBlocksPerMultiprocessor(&per_cu, (const void*)hybrid_fwd, NWAVES * 64, LDS_BYTES) != hipSuccess || per_cu < 1) { fprintf(stderr, "kernel_launch: occupancy query says %d\n", per_cu); }
        (void)hipGetLastError();
        grid = cus;
    }
    if (grid < 0) return;
    (void)hipMemsetAsync((char*)d_ws + WS_CTL, 0, CTL_ZERO_BYTES, stream);
    Args a{};
    for (int i = 0; i < 24; ++i) a.p.in[i] = (const float*)d_in[i];
    a.p.out = (float*)d_out; a.p.ws = (unsigned char*)d_ws;
    if (MK_N_LAUNCHES == 1) {
        a.ph_lo = 0; a.ph_hi = NPHASE;
        hipLaunchKernelGGL(hybrid_fwd, dim3(grid), dim3(NWAVES * 64), LDS_BYTES, stream, a);
    } else {
        static const int order[NPHASE] = {0, 1, 2, 11, 3, 4, 5, 6, 7, 8, 9, 10};
        for (int q = 0; q < NPHASE; ++q) {
            const int ph = order[q];
            a.ph_lo = ph; a.ph_hi = ph + 1; hipLaunchKernelGGL(hybrid_fwd, dim3(grid), dim3(NWAVES * 64), LDS_BYTES, stream, a);
#if defined(PROBE_PHASE)
            if (ph == PROBE_PHASE) hipLaunchKernelGGL(hybrid_fwd, dim3(grid), dim3(NWAVES * 64), LDS_BYTES, stream, a);
#endif
        }
    }
}
```

```cpp
#include <hip/hip_runtime.h>
#include <hip/hip_bf16.h>
#include <cstdio>
#include <cstdint>
#include <cmath>

#ifndef MK_N_LAUNCHES
#define MK_N_LAUNCHES 1
#endif

#define LAS __attribute__((address_space(3)))
#define GAS __attribute__((address_space(1)))
typedef unsigned short bf16_t;
typedef short bf16x8 __attribute__((ext_vector_type(8)));
typedef float f32x2 __attribute__((ext_vector_type(2)));
typedef float f32x4 __attribute__((ext_vector_type(4)));
typedef float f32x16 __attribute__((ext_vector_type(16)));
typedef unsigned u32x2 __attribute__((ext_vector_type(2)));
typedef unsigned u32x4 __attribute__((ext_vector_type(4)));

constexpr int NB = 4, SEQ = 2048, NTOK = NB * SEQ, DM = 2048;
constexpr int NPROJ = 5648, NPROJP = 5888;
constexpr int C_Q = 0, C_K = 1024, C_V = 2048, C_Z = 3072, C_XBC = 4096, C_DT = 5632;
constexpr int NEXP = 32, FFD = 2048, MAXROWS = 40960, MAXTILES = 160;
constexpr float EPS = 1e-5f;
constexpr float ATT_C2 = 0.125f * 1.4426950408889634f;
constexpr float LAM_INIT = 0.2f;

constexpr size_t MiB = 1u << 20;
constexpr size_t WS_CTL = 0, CTL_ZERO_BYTES = 1 * MiB;
constexpr size_t WS_WIN = 2 * MiB;
constexpr size_t WS_WOUT = 26 * MiB;
constexpr size_t WS_ROPE = 34 * MiB;
constexpr size_t WS_DTRAW = 34 * MiB + 512 * 1024;
constexpr size_t WS_CS = 35 * MiB;
constexpr size_t WS_ROUTE = 36 * MiB;
constexpr size_t WS_XN = 40 * MiB;
constexpr size_t WS_PROJ = 72 * MiB;
constexpr size_t WS_ATT = 164 * MiB;
constexpr size_t WS_YDIAG = 196 * MiB;
constexpr size_t WS_STATES = 228 * MiB;
constexpr size_t WS_XCONV = 260 * MiB;
constexpr size_t WS_CCONV = 276 * MiB;
constexpr size_t WS_CAT = 280 * MiB;
constexpr size_t WS_X1 = 312 * MiB;
constexpr size_t WS_H2 = 376 * MiB;
constexpr size_t WS_ACT = 408 * MiB;
constexpr size_t WS_YS = 568 * MiB;
constexpr size_t WS_WGU = 728 * MiB;
constexpr size_t WS_WD = 1240 * MiB;
constexpr size_t WS_STIN = 1241 * MiB;
constexpr size_t WS_ZROW = 1240 * MiB;
constexpr int ZROW = (int)((WS_ZROW - WS_H2) / 4096);
constexpr size_t WS_END = 1496 * MiB;
constexpr size_t RT_TOPE = 0, RT_TOPG = 128 * 1024, RT_LRANK = 256 * 1024, RT_TOKPOS = 384 * 1024, RT_HIST = 512 * 1024, RT_META = 544 * 1024, RT_ROWTOK = 576 * 1024;
constexpr int META_SEG = 0, META_NT = 40, META_TILE_E = 48;
constexpr int CW_BAR = 4096;
constexpr int CW_TCNT = 16384;

constexpr int RING_BYTES = 131072;
constexpr int LDSCTL_OFF = RING_BYTES, MISC_OFF = LDSCTL_OFF + 320;
constexpr int LHIST_OFF = LDSCTL_OFF + 1024;
constexpr int BIAS_OFF = LDSCTL_OFF + 2048 + 8192;
constexpr int VAN_OFF = LDSCTL_OFF + 2048;
constexpr int LDS_BYTES = 147456;
constexpr int NWAVES = 8;

__device__ __forceinline__ unsigned cvt_pk_bf16(float lo, float hi) { unsigned r; asm volatile("v_cvt_pk_bf16_f32 %0, %1, %2" : "=v"(r) : "v"(lo), "v"(hi)); return r; }
__device__ __forceinline__ float bf_lo(unsigned w) { return __uint_as_float(w << 16); }
__device__ __forceinline__ float bf_hi(unsigned w) { return __uint_as_float(w & 0xffff0000u); }
__device__ __forceinline__ float bf2f(bf16_t h) { return __uint_as_float((unsigned)h << 16); }
__device__ __forceinline__ bf16_t f2bf(float f) { return (bf16_t)(cvt_pk_bf16(f, 0.f) & 0xffffu); }
__device__ __forceinline__ float wave_sum(float v) {
#pragma unroll
    for (int o = 1; o < 64; o <<= 1) v += __shfl_xor(v, o);
    return v;
}
__device__ __forceinline__ float sigmoidf_(float x) { return __builtin_amdgcn_rcpf(1.f + __builtin_amdgcn_exp2f(-1.4426950408889634f * x)); }
__device__ __forceinline__ float rsqrtf_(float x) { return __builtin_amdgcn_rsqf(x); }
__device__ __forceinline__ float fexp(float x) { return __builtin_amdgcn_exp2f(1.4426950408889634f * x); }
#define LDS_WAIT() asm volatile("s_waitcnt lgkmcnt(0)" ::: "memory")
#define VM_WAIT() asm volatile("s_waitcnt vmcnt(0)" ::: "memory")

__device__ __forceinline__ const char* uni(const char* p) { const unsigned long long v = (unsigned long long)p; const unsigned lo = __builtin_amdgcn_readfirstlane((unsigned)v), hi = __builtin_amdgcn_readfirstlane((unsigned)(v >> 32)); return (const char*)(((unsigned long long)hi << 32) | lo); }
namespace pg8 {
constexpr int BM = 256, BK = 64, HALF = 128, HTB = HALF * BK * 2, STAGE_BYTES = 8 * HTB, NXCD = 8, WGM = 8, KD = 2048, NKT = KD / BK;
__host__ __device__ __forceinline__ int lds_byte(int r, int c) { const int st = (r >> 4) * 2 + (c >> 5), rr = r & 15, cc = c & 31, ob = rr * 64 + cc * 2; return st * 1024 + (ob ^ (((ob >> 9) & 1) << 5)); }
__host__ __device__ __forceinline__ void stage_rc(int b, int& R, int& C) { const int st = b / 1024, sb = b % 1024, swz = sb ^ (((sb >> 9) & 1) << 5); R = (st >> 1) * 16 + swz / 64; C = (st & 1) * 32 + (swz % 64) / 2; }
__host__ __device__ __forceinline__ int perm32(int rho) { const int n = rho >> 4, i = rho & 15; return 8 * (i >> 2) + 4 * n + (i & 3); }

struct Unit { const char* a; const char* b0; const char* b1; int pm, pn, e; };
struct UnitF { const char* a; const char* b; int pm, pn, e, nv; };

struct SchedDense {
    const char* A; const char* Bt; int nM, nN, nwg, G, c;
    __device__ __forceinline__ void init(const void* A_, const void* Bt_, int M, int N, int G_, int c_) { A = (const char*)A_; Bt = (const char*)Bt_; nM = M / BM; nN = N / BM; nwg = nM * nN; G = G_; c = c_; }
    __device__ __forceinline__ bool get(int i, Unit& u) const {
        const long L = (long)i * G + c; if (L >= nwg) return false;
        int wgid = (int)L; { const int q = nwg / NXCD, r = nwg % NXCD, xcd = wgid % NXCD, off = wgid / NXCD; wgid = (xcd < r ? xcd * (q + 1) : r * (q + 1) + (xcd - r) * q) + off; }
        const int nig = WGM * nN, gid = wgid / nig, fm = gid * WGM, gsz = (nM - fm) < WGM ? (nM - fm) : WGM;
        u.pm = fm + ((wgid % nig) % gsz); u.pn = (wgid % nig) / gsz; u.e = 0;
        u.a = A; u.b0 = Bt + (size_t)u.pn * BM * KD * 2; u.b1 = u.b0 + (size_t)HALF * KD * 2; return true;
    }
    __device__ __forceinline__ unsigned aoff(const Unit& u, int h, int R, int C) const { return (unsigned)(((u.pm * BM + h * HALF + R) * KD + C) * 2); }
};
struct SchedMoe {
    const char* A; const char* Bt; const int* tile_e; const int* rowtok; int nT, nN, G, c; bool gu;
    __device__ __forceinline__ bool get(int i, Unit& u) const {
        const long L = (long)i * G + c; const int NU = nT * nN; if (L >= NU) return false;
        const int nTb = nT >> 2, full = nTb * 4 * nN; int T, nt;
        if ((int)L < full) { const int blk = (int)L >> 5, w = (int)L & 31, nb = nN >> 3, tb = blk / nb, nbk = blk % nb; T = tb * 4 + (w & 3); nt = nbk * 8 + (w >> 2); }
        else { const int Lp = (int)L - full, rT = nT & 3; T = nTb * 4 + Lp % rT; nt = Lp / rT; }
        const int e = tile_e[T]; u.pm = T; u.pn = nt; u.e = e; u.a = A;
        if (gu) { u.b0 = Bt + ((size_t)e * 4096 + (size_t)nt * 128) * KD * 2; u.b1 = u.b0 + (size_t)2048 * KD * 2; }
        else    { u.b0 = Bt + ((size_t)e * 2048 + (size_t)nt * 256) * KD * 2; u.b1 = u.b0 + (size_t)HALF * KD * 2; }
        return true;
    }
    __device__ __forceinline__ unsigned aoff(const Unit& u, int h, int R, int C) const { int row = u.pm * BM + h * HALF + R; if (rowtok) row = rowtok[row]; return (unsigned)((row * KD + C) * 2); }
};

struct EpiProj {
    static constexpr bool PERM = true;
    bf16_t* P; float* dtraw; const float* rope;
    __device__ __forceinline__ void operator()(const f32x4 (&acc)[2][2][4][2], const Unit& u, int wr, int wc, int fr, int fq) const {
        const int row0 = u.pm * BM + wr * 64 + fr;
        if (u.pn == 22) {
            if (wc == 0 && fq < 2) {
#pragma unroll
                for (int ai = 0; ai < 2; ++ai)
#pragma unroll
                    for (int m = 0; m < 4; ++m) { float* d = dtraw + (size_t)(row0 + ai * HALF + m * 16) * 16 + 8 * fq; *(f32x4*)d = acc[ai][0][m][0]; *(f32x4*)(d + 4) = acc[ai][0][m][1]; }
            }
            return;
        }
        const bool ropet = (u.pn < 8) && ((wc & 1) == 0);
        const float qs = (u.pn < 4) ? ATT_C2 : 1.f;
        const int col0 = u.pn * BM + wc * 32 + 8 * fq;
#pragma unroll
        for (int ai = 0; ai < 2; ++ai)
#pragma unroll
            for (int m = 0; m < 4; ++m) {
                const int row = row0 + ai * HALF + m * 16;
                f32x4 v[2][2];
#pragma unroll
                for (int bj = 0; bj < 2; ++bj)
#pragma unroll
                    for (int n = 0; n < 2; ++n) v[bj][n] = acc[ai][bj][m][n];
                if (ropet) {
                    const float* rp = rope + (size_t)row * 16;
                    const f32x4 c0 = *(const f32x4*)rp, c1 = *(const f32x4*)(rp + 4), s0 = *(const f32x4*)(rp + 8), s1 = *(const f32x4*)(rp + 12);
#pragma unroll
                    for (int bj = 0; bj < 2; ++bj)
#pragma unroll
                        for (int n = 0; n < 2; ++n)
#pragma unroll
                            for (int j = 0; j < 4; ++j) {
                                const float x = v[bj][n][j], o = __shfl_xor(x, 16);
                                const float cc = n ? c1[j] : c0[j], ss = n ? s1[j] : s0[j];
                                const float r = (fq == 0) ? (x * cc - o * ss) : (x * cc + o * ss);
                                v[bj][n][j] = (fq < 2) ? r : x;
                            }
                }
                bf16_t* rowp = P + (size_t)row * NPROJP + col0;
#pragma unroll
                for (int bj = 0; bj < 2; ++bj) {
                    const f32x4 v0 = v[bj][0] * qs, v1 = v[bj][1] * qs; u32x4 w;
                    w.x = cvt_pk_bf16(v0[0], v0[1]); w.y = cvt_pk_bf16(v0[2], v0[3]); w.z = cvt_pk_bf16(v1[0], v1[1]); w.w = cvt_pk_bf16(v1[2], v1[3]);
                    *(u32x4*)(rowp + bj * HALF) = w;
                }
            }
    }
};
struct EpiRes {
    static constexpr bool PERM = false;
    const float* base; bf16_t* out; int ldc;
    __device__ __forceinline__ void operator()(const f32x4 (&acc)[2][2][4][2], const Unit& u, int wr, int wc, int fr, int fq) const {
        const int row0 = u.pm * BM + wr * 64 + fr, col0 = u.pn * BM + wc * 32 + 4 * fq;
#pragma unroll
        for (int ai = 0; ai < 2; ++ai)
#pragma unroll
            for (int m = 0; m < 4; ++m) { const size_t off = (size_t)(row0 + ai * HALF + m * 16) * ldc + col0;
#pragma unroll
                for (int bj = 0; bj < 2; ++bj)
#pragma unroll
                    for (int n = 0; n < 2; ++n) { const f32x4 v = *(const f32x4*)(base + off + bj * HALF + n * 16) + acc[ai][bj][m][n]; u32x2 w; w.x = cvt_pk_bf16(v[0], v[1]); w.y = cvt_pk_bf16(v[2], v[3]); *(u32x2*)(out + off + bj * HALF + n * 16) = w; } }
    }
};
struct EpiGate {
    static constexpr bool PERM = true;
    bf16_t* O; const float* bgu;
    unsigned* cnt;
    __device__ __forceinline__ unsigned bias_off(const UnitF& u, int wc, int idx) const { const int fq = idx >> 4, k = (idx >> 2) & 3, cp = idx & 3; return (unsigned)((u.e * 4096 + (k >> 1) * 2048 + u.pn * 128 + wc * 32 + 8 * fq + 4 * (k & 1) + cp) * 4); }
    __device__ __forceinline__ const char* bias_base() const { return (const char*)bgu; }
    __device__ __forceinline__ void operator()(const f32x4 (&acc)[2][2][4][2], const Unit& u, int wr, int wc, int fr, int fq, const LAS float* bl = nullptr) const {
        const int row0 = u.pm * BM + wr * 64 + fr, colg = u.pn * 128 + wc * 32 + 8 * fq;
        f32x4 bg[2], bu[2];
        if (bl) { const LAS f32x4* q = (const LAS f32x4*)bl + fq * 4; bg[0] = q[0]; bg[1] = q[1]; bu[0] = q[2]; bu[1] = q[3]; }
        else { const float* bp = bgu + (size_t)u.e * 4096 + colg;
#pragma unroll
            for (int n = 0; n < 2; ++n) { bg[n] = *(const f32x4*)(bp + 4 * n); bu[n] = *(const f32x4*)(bp + 2048 + 4 * n); } }
        const __amdgpu_buffer_rsrc_t rsrc = __builtin_amdgcn_make_buffer_rsrc((void*)O, 0, (u.pm * BM + (u.e >> 8)) * FFD * 2, 0x00020000);
#pragma unroll
        for (int ai = 0; ai < 2; ++ai)
#pragma unroll
            for (int m = 0; m < 4; ++m) {
                float a[8];
#pragma unroll
                for (int n = 0; n < 2; ++n)
#pragma unroll
                    for (int j = 0; j < 4; ++j) {
                        float g = acc[ai][0][m][n][j] + bg[n][j], up = acc[ai][1][m][n][j] + bu[n][j];
                        g = fminf(g, 7.0f); up = fminf(fmaxf(up, -7.0f), 7.0f);
                        const float gs = g * __builtin_amdgcn_rcpf(1.f + __builtin_amdgcn_exp2f(-2.4554669595930156f * g));
                        a[4 * n + j] = __builtin_fmaf(gs, up, gs);
                    }
                u32x4 w; w.x = cvt_pk_bf16(a[0], a[1]); w.y = cvt_pk_bf16(a[2], a[3]); w.z = cvt_pk_bf16(a[4], a[5]); w.w = cvt_pk_bf16(a[6], a[7]);
                __builtin_amdgcn_raw_buffer_store_b128(w, rsrc, (int)(((unsigned)(row0 + ai * HALF + m * 16) * FFD + colg) * 2u), 0, 16);
            }
        asm volatile("s_waitcnt vmcnt(0)" ::: "memory");
        if (fr == 0 && fq == 0) __hip_atomic_fetch_add(cnt + 64 * u.pm, 1u, __ATOMIC_RELAXED, __HIP_MEMORY_SCOPE_AGENT);
    }
};
struct EpiDown {
    static constexpr bool PERM = true;
    bf16_t* O; const float* bd;
    __device__ __forceinline__ unsigned bias_off(const UnitF& u, int wc, int idx) const { const int fq = idx >> 4, k = (idx >> 2) & 3, cp = idx & 3; return (unsigned)((u.e * DM + u.pn * BM + wc * 32 + 8 * fq + (k >> 1) * HALF + 4 * (k & 1) + cp) * 4); }
    __device__ __forceinline__ const char* bias_base() const { return (const char*)bd; }
    __device__ __forceinline__ void operator()(const f32x4 (&acc)[2][2][4][2], const Unit& u, int wr, int wc, int fr, int fq, const LAS float* bl = nullptr) const {
        const int row0 = u.pm * BM + wr * 64 + fr, col0 = u.pn * BM + wc * 32 + 8 * fq;
        const __amdgpu_buffer_rsrc_t rsrc = __builtin_amdgcn_make_buffer_rsrc((void*)O, 0, (u.pm * BM + (u.e >> 8)) * DM * 2, 0x00020000);
        f32x4 bv[2][2];
        if (bl) { const LAS f32x4* q = (const LAS f32x4*)bl + fq * 4; bv[0][0] = q[0]; bv[0][1] = q[1]; bv[1][0] = q[2]; bv[1][1] = q[3]; }
        else { const float* bp = bd + (size_t)u.e * DM + col0;
#pragma unroll
            for (int bj = 0; bj < 2; ++bj)
#pragma unroll
                for (int n = 0; n < 2; ++n) bv[bj][n] = *(const f32x4*)(bp + bj * HALF + 4 * n); }
#pragma unroll
        for (int ai = 0; ai < 2; ++ai)
#pragma unroll
            for (int m = 0; m < 4; ++m) { const unsigned ro = ((unsigned)(row0 + ai * HALF + m * 16) * DM + col0) * 2u;
#pragma unroll
                for (int bj = 0; bj < 2; ++bj) { const f32x4 v0 = acc[ai][bj][m][0] + bv[bj][0], v1 = acc[ai][bj][m][1] + bv[bj][1]; u32x4 w;
                    w.x = cvt_pk_bf16(v0[0], v0[1]); w.y = cvt_pk_bf16(v0[2], v0[3]); w.z = cvt_pk_bf16(v1[0], v1[1]); w.w = cvt_pk_bf16(v1[2], v1[3]);
                    if (bl) __builtin_amdgcn_raw_buffer_store_b128(w, rsrc, (int)(ro + bj * HALF * 2u), 0, 0); else *(u32x4*)((char*)O + ro + bj * HALF * 2u) = w; } }
    }
};

template <class Epi, class Sched>
__device__ __forceinline__ void gemm_phase(LAS unsigned char* lds, const Sched& S, const Epi& E) {
    const int tid = threadIdx.x, wid = __builtin_amdgcn_readfirstlane(tid >> 6), lane = tid & 63, wr = wid >> 2, wc = wid & 3, fr = lane & 15, fq = lane >> 4;
    constexpr int nt = NKT;
    int Rr[2], Cc[2]; unsigned voffB[2];
#pragma unroll
    for (int i = 0; i < 2; ++i) { stage_rc(tid * 16 + i * 8192, Rr[i], Cc[i]); const int Rb = Epi::PERM ? ((Rr[i] & ~31) + perm32(Rr[i] & 31)) : Rr[i]; voffB[i] = (unsigned)(Rb * KD + Cc[i]) * 2u; }
    const size_t kstep = (size_t)(BK * 2);
    const unsigned ldsw = (unsigned)wid * 1024u;
    const int aoff = lds_byte(wr * 64 + fr, fq * 8), boff = lds_byte(wc * 32 + fr, fq * 8);
#define PG8_SA(b, h) (((b) * 2 + (h)) * HTB)
#define PG8_SB(b, h) ((4 + (b) * 2 + (h)) * HTB)
#define PG8_STAGE(bufoff, gbase, voff) do { _Pragma("unroll") for (int _i = 0; _i < 2; ++_i) \
        __builtin_amdgcn_global_load_lds((const unsigned*)((const char*)(gbase) + (voff)[_i]), (LAS unsigned*)(lds + (bufoff) + ldsw + _i * 8192), 16, 0, 0); } while (0)
#define PG8_LDA(dst, b, h) do { _Pragma("unroll") for (int m = 0; m < 4; ++m) _Pragma("unroll") for (int k = 0; k < 2; ++k) dst[m][k] = *(const LAS bf16x8*)(lds + PG8_SA(b, h) + aoff + m * 2048 + k * 1024); } while (0)
#define PG8_LDB(dst, b, h) do { _Pragma("unroll") for (int n = 0; n < 2; ++n) _Pragma("unroll") for (int k = 0; k < 2; ++k) dst[n][k] = *(const LAS bf16x8*)(lds + PG8_SB(b, h) + boff + n * 2048 + k * 1024); } while (0)
#define PG8_MMA(ai, bj, At, Bt) do { __builtin_amdgcn_s_setprio(1); _Pragma("unroll") for (int m = 0; m < 4; ++m) _Pragma("unroll") for (int n = 0; n < 2; ++n) _Pragma("unroll") for (int k = 0; k < 2; ++k) \
        acc[ai][bj][m][n] = __builtin_amdgcn_mfma_f32_16x16x32_bf16(Bt[n][k], At[m][k], acc[ai][bj][m][n], 0, 0, 0); __builtin_amdgcn_s_setprio(0); } while (0)
#define PG8_WAIT_V(n) asm volatile("s_waitcnt vmcnt(" #n ")" ::: "memory")
#define PG8_WAIT_L(n) asm volatile("s_waitcnt lgkmcnt(" #n ")" ::: "memory")
#define PG8_BAR __builtin_amdgcn_s_barrier()
#define PG8_SCHED __builtin_amdgcn_sched_barrier(0)
    Unit cur, nxt; int ui = 0;
    if (!S.get(0, cur)) return;
    unsigned vaC[2][2], vaN[2][2];
#pragma unroll
    for (int h = 0; h < 2; ++h)
#pragma unroll
        for (int i = 0; i < 2; ++i) vaC[h][i] = S.aoff(cur, h, Rr[i], Cc[i]);
    f32x4 acc[2][2][4][2];
#pragma unroll
    for (int a = 0; a < 2; ++a)
#pragma unroll
        for (int b = 0; b < 2; ++b)
#pragma unroll
            for (int m = 0; m < 4; ++m)
#pragma unroll
                for (int n = 0; n < 2; ++n) acc[a][b][m][n] = (f32x4){0.f, 0.f, 0.f, 0.f};
    bf16x8 At[4][2], B0[2][2], B1[2][2];
    PG8_STAGE(PG8_SB(0, 0), cur.b0, voffB); PG8_STAGE(PG8_SB(0, 1), cur.b1, voffB); PG8_STAGE(PG8_SA(0, 0), cur.a, vaC[0]); PG8_STAGE(PG8_SA(0, 1), cur.a, vaC[1]);
    if (wr == 1) PG8_BAR;
    PG8_WAIT_V(2); PG8_BAR;
    PG8_STAGE(PG8_SB(1, 0), cur.b0 + kstep, voffB); PG8_STAGE(PG8_SA(1, 0), cur.a + kstep, vaC[0]); PG8_STAGE(PG8_SB(1, 1), cur.b1 + kstep, voffB);
    PG8_WAIT_V(6); PG8_BAR;
    for (;;) {
        const bool has_next = S.get(ui + 1, nxt);
        if (has_next) {
#pragma unroll
            for (int h = 0; h < 2; ++h)
#pragma unroll
                for (int i = 0; i < 2; ++i) vaN[h][i] = S.aoff(nxt, h, Rr[i], Cc[i]);
        } else {
            nxt = cur;
#pragma unroll
            for (int h = 0; h < 2; ++h)
#pragma unroll
                for (int i = 0; i < 2; ++i) vaN[h][i] = vaC[h][i];
        }
        for (int t = 0; t < nt; t += 2) {
            const bool last = (t == nt - 2);
            const char* a1 = cur.a + (size_t)(t + 1) * kstep;
            const char* a2 = last ? nxt.a : cur.a + (size_t)(t + 2) * kstep;
            const char* b20 = last ? nxt.b0 : cur.b0 + (size_t)(t + 2) * kstep;
            const char* b21 = last ? nxt.b1 : cur.b1 + (size_t)(t + 2) * kstep;
            const char* a3 = a2 + kstep; const char* b30 = b20 + kstep; const char* b31 = b21 + kstep;
            unsigned v2[2][2];
#pragma unroll
            for (int h = 0; h < 2; ++h)
#pragma unroll
                for (int i = 0; i < 2; ++i) v2[h][i] = last ? vaN[h][i] : vaC[h][i];
            PG8_LDB(B0, 0, 0); PG8_LDB(B1, 0, 1); PG8_SCHED; PG8_LDA(At, 0, 0); PG8_STAGE(PG8_SA(1, 1), a1, vaC[1]);
            PG8_WAIT_V(8); PG8_WAIT_L(0); PG8_BAR; PG8_MMA(0, 0, At, B0); PG8_MMA(0, 1, At, B1); PG8_BAR; PG8_SCHED;
            PG8_LDA(At, 0, 1); PG8_STAGE(PG8_SB(0, 0), b20, voffB); PG8_STAGE(PG8_SB(0, 1), b21, voffB); PG8_STAGE(PG8_SA(0, 0), a2, v2[0]);
            PG8_WAIT_V(8); PG8_WAIT_L(0); PG8_BAR; PG8_MMA(1, 0, At, B0); PG8_MMA(1, 1, At, B1); PG8_BAR; PG8_SCHED;
            PG8_LDB(B0, 1, 0); PG8_LDB(B1, 1, 1); PG8_SCHED; PG8_LDA(At, 1, 0); PG8_STAGE(PG8_SA(0, 1), a2, v2[1]);
            PG8_WAIT_V(8); PG8_WAIT_L(0); PG8_BAR; PG8_MMA(0, 0, At, B0); PG8_MMA(0, 1, At, B1); PG8_BAR; PG8_SCHED;
            PG8_LDA(At, 1, 1); PG8_STAGE(PG8_SB(1, 0), b30, voffB); PG8_STAGE(PG8_SB(1, 1), b31, voffB); PG8_STAGE(PG8_SA(1, 0), a3, v2[0]);
            PG8_WAIT_V(8); PG8_WAIT_L(0); PG8_BAR; PG8_MMA(1, 0, At, B0); PG8_MMA(1, 1, At, B1); PG8_BAR; PG8_SCHED;
        }
        if (wr == 0) PG8_BAR;
        E(acc, cur, wr, wc, fr, fq);
        if (!has_next) break;
#pragma unroll
        for (int a = 0; a < 2; ++a)
#pragma unroll
            for (int b = 0; b < 2; ++b)
#pragma unroll
                for (int m = 0; m < 4; ++m)
#pragma unroll
                    for (int n = 0; n < 2; ++n) acc[a][b][m][n] = (f32x4){0.f, 0.f, 0.f, 0.f};
        cur = nxt; ++ui;
#pragma unroll
        for (int h = 0; h < 2; ++h)
#pragma unroll
            for (int i = 0; i < 2; ++i) vaC[h][i] = vaN[h][i];
        if (wr == 1) PG8_BAR;
    }
    PG8_WAIT_V(0);
    PG8_BAR;
#undef PG8_SA
#undef PG8_SB
#undef PG8_STAGE
#undef PG8_LDA
#undef PG8_LDB
#undef PG8_MMA
#undef PG8_WAIT_V
#undef PG8_WAIT_L
#undef PG8_BAR
#undef PG8_SCHED
}

template <int NP  , int HDELTA  , bool GATHER>
struct SchedMoeF {
    const char* A; const float* W; const int* tile_e; const int* rowtok; int nT, nN, G, c;
    __device__ __forceinline__ bool get(int i, UnitF& u) const {
        const long L = (long)i * G + c; const int NU = nT * nN; if (L >= NU) return false;
        const int q = (int)L >> (nN == 16 ? 4 : 3); const int inf = __builtin_amdgcn_readfirstlane(tile_e[q]);
        const int e = inf & 31, first = (inf >> 5) & 255, ne = (inf >> 13) & 255, nvl = ((inf >> 21) & 255) + 1;
        const int Lw = (int)L - first * nN, per = 8 * ne; const int chunk = (Lw >= per) ? 1 : 0; const int rem = Lw - chunk * per;
        int j = 0;
#pragma unroll
        for (int k = 1; k < 8; ++k) j += (rem >= k * ne) ? 1 : 0;
        int T = first + (rem - j * ne), nt = chunk * 8 + j;
        T = __builtin_amdgcn_readfirstlane(T); nt = __builtin_amdgcn_readfirstlane(nt);
        u.pm = T; u.pn = nt; u.e = e; u.nv = (T == first + ne - 1) ? nvl : BM;
        u.a = GATHER ? A : A + (size_t)T * BM * KD * 2;
        u.b = (const char*)(W + (size_t)e * 2048 * NP + (size_t)nt * (HDELTA == 512 ? 256 : 128));
        return true;
    }
    __device__ __forceinline__ unsigned aoff(const UnitF& u, int h, int R, int C) const { const int row = GATHER ? rowtok[u.pm * BM + h * HALF + R] : h * HALF + R; return (unsigned)((row * KD + C) * 2); }
};
typedef short s16x4_t __attribute__((ext_vector_type(4)));
__device__ __forceinline__ s16x4_t tr16(const LAS unsigned char* p) { return __builtin_bit_cast(s16x4_t, __builtin_amdgcn_ds_read_tr16_b64_v4i16((LAS s16x4_t*)p)); }
__device__ __forceinline__ void glds16s(const char* sbase, unsigned voff, unsigned lds_dst) { unsigned keep;
    asm volatile("s_mov_b32 %0, m0\n\ts_mov_b32 m0, %2\n\ts_nop 2\n\tglobal_load_lds_dwordx4 %1, %3\n\ts_mov_b32 m0, %0" : "=&s"(keep) : "v"(voff), "s"(lds_dst), "s"(sbase) : "memory"); }

__device__ __forceinline__ void glds4s(const char* sbase, unsigned voff, unsigned lds_dst) { unsigned keep;
    asm volatile("s_mov_b32 %0, m0\n\ts_mov_b32 m0, %2\n\ts_nop 2\n\tglobal_load_lds_dword %1, %3\n\ts_mov_b32 m0, %0" : "=&s"(keep) : "v"(voff), "s"(lds_dst), "s"(sbase) : "memory"); }

template <class Epi, class Sched, int NP, int HDELTA, bool GATHER, bool WAITA = false>
__device__ __forceinline__ void gemm_phase_fb(LAS unsigned char* lds, const Sched& S, const Epi& E, const unsigned* ready = nullptr, unsigned need = 0u) {
    static_assert(Epi::PERM, "the B image's column-slot permutation assumes a PERM epilogue");
    const int tid = threadIdx.x, wid = __builtin_amdgcn_readfirstlane(tid >> 6), lane = tid & 63, wr = wid >> 2, wc = wid & 3;
    constexpr int nt = NKT;
    constexpr size_t kstep = (size_t)(BK * 2);
    constexpr size_t BKT = (size_t)64 * NP * 4;
    constexpr size_t BR8 = (size_t)8 * NP * 4;
    const unsigned lds0 = (unsigned)__builtin_amdgcn_readfirstlane((unsigned)(size_t)lds);
    const unsigned ldsw = lds0 + (unsigned)wid * 1024u;
    const int aoff = lds_byte(wr * 64 + (lane & 15), (lane >> 4) * 8);
    const int bh = lane >> 5, c4 = lane & 31;
    const unsigned blane = (unsigned)(bh * HDELTA + wid * NP * 4 + c4 * 16);
    const int s4 = (c4 & ~7) + 4 * (c4 & 1) + ((c4 & 7) >> 1), ch16 = s4 >> 1, sub = s4 & 1;
    const int X0 = ((wid & 3) << 2) | (wid >> 2);
    const unsigned bw0 = (unsigned)(4 * HTB + bh * HTB + 256 * wid + 16 * (ch16 ^ X0) + 8 * sub);
    unsigned radr[2];
    { const int g = lane >> 4, q = (lane & 15) >> 2, p = lane & 3;
#pragma unroll
      for (int t = 0; t < 2; ++t) { const int row = 8 * g + 4 * t + q, X = ((row & 3) << 2) | ((row >> 2) & 3), ch = 2 * (2 * wc) + (p >> 1); radr[t] = (unsigned)(4 * HTB + 256 * row + 16 * (ch ^ X) + 8 * (p & 1)); } }
#define FB_SA(b, h) (((b) * 2 + (h)) * HTB)
#define FB_SB(b, h) (((b) * 2 + (h)) * HTB)
#define FB_STAGE(bufoff, sbase, voff) do { _Pragma("unroll") for (int _i = 0; _i < 2; ++_i) glds16s((sbase), (voff)[_i], ldsw + (unsigned)(bufoff) + _i * 8192u); } while (0)
#define FB_STAGEH(bufoff, sbase, vv, h) do { if constexpr (GATHER) { FB_STAGE(bufoff, sbase, (vv)[h]); } else { FB_STAGE(bufoff, (sbase) + (size_t)(h) * HALF * KD * 2, (vv)[0]); } } while (0)
#define FB_LDA(dst, b, h) do { _Pragma("unroll") for (int m = 0; m < 4; ++m) _Pragma("unroll") for (int k = 0; k < 2; ++k) dst[m][k] = *(const LAS bf16x8*)(lds + FB_SA(b, h) + aoff + m * 2048 + k * 1024); } while (0)
#define FB_LDB(dst, b, h) do { _Pragma("unroll") for (int n = 0; n < 2; ++n) _Pragma("unroll") for (int k = 0; k < 2; ++k) { \
        const s16x4_t lo_ = tr16(lds + FB_SB(b, h) + (radr[0] ^ (n ? 32u : 0u)) + k * 8192), hi_ = tr16(lds + FB_SB(b, h) + (radr[1] ^ (n ? 32u : 0u)) + k * 8192); \
        dst[n][k] = (bf16x8){lo_[0], lo_[1], lo_[2], lo_[3], hi_[0], hi_[1], hi_[2], hi_[3]}; } } while (0)
#define FB_BLOAD(LD, bsrc, hr, rj) do { _Pragma("unroll") for (int _i = 0; _i < 4; ++_i) { const char* sb_ = (const char*)(bsrc) + (size_t)((4 * (hr) + _i + (rj)) & 7) * BR8; \
        asm volatile("s_nop 4\n\tglobal_load_dwordx4 %0, %1, %2 sc0" : "=v"(LD[_i]) : "v"(blane), "s"(sb_) : "memory"); } } while (0)
#define FB_BWAIT(LD, n) asm volatile("s_waitcnt vmcnt(" #n ")" : "+v"(LD[0]), "+v"(LD[1]), "+v"(LD[2]), "+v"(LD[3]) :: "memory")
#define FB_BCW(LD, b, hr, rj) do { _Pragma("unroll") for (int _i = 0; _i < 4; ++_i) { u32x2 w_; w_.x = cvt_pk_bf16(LD[_i].x, LD[_i].y); w_.y = cvt_pk_bf16(LD[_i].z, LD[_i].w); \
        *(LAS u32x2*)(lds + FB_SB(b, 0) + ((_i & 1) ? (bw0 ^ 32u) : bw0) + 2048 * ((4 * (hr) + _i + (rj)) & 7)) = w_; } } while (0)
#define FB_BSTEP(LD, wb, whr, wrj, nsrc, nhr, nrj, nw) do { FB_BWAIT(LD, nw); FB_BCW(LD, wb, whr, wrj); FB_BLOAD(LD, nsrc, nhr, nrj); } while (0)
#define FB_BCONS(LD, wb, whr, wrj, nw) do { FB_BWAIT(LD, nw); FB_BCW(LD, wb, whr, wrj); } while (0)
#define FB_MMA(ai, bj, At, Bt) do { __builtin_amdgcn_s_setprio(1); _Pragma("unroll") for (int m = 0; m < 4; ++m) _Pragma("unroll") for (int n = 0; n < 2; ++n) _Pragma("unroll") for (int k = 0; k < 2; ++k) \
        acc[ai][bj][m][n] = __builtin_amdgcn_mfma_f32_16x16x32_bf16(Bt[n][k], At[m][k], acc[ai][bj][m][n], 0, 0, 0); __builtin_amdgcn_s_setprio(0); } while (0)
#define FB_WAIT_V(n) asm volatile("s_waitcnt vmcnt(" #n ")" ::: "memory")
#define FB_WAIT_L(n) asm volatile("s_waitcnt lgkmcnt(" #n ")" ::: "memory")
#define FB_BAR __builtin_amdgcn_s_barrier()
#define FB_SCHED __builtin_amdgcn_sched_barrier(0)
#define FB_AWAIT(T) do { if constexpr (WAITA) { if (wid == 0) { unsigned sp_ = 0; \
        while ((unsigned)__builtin_amdgcn_readfirstlane(__hip_atomic_load(ready + 64 * (T), __ATOMIC_RELAXED, __HIP_MEMORY_SCOPE_AGENT)) < need) { __builtin_amdgcn_s_sleep(2); if (++sp_ > (1u << 22)) break; } \
        __builtin_amdgcn_fence(__ATOMIC_ACQUIRE, "agent"); asm volatile("s_waitcnt vmcnt(0)" ::: "memory"); } \
        asm volatile("" ::: "memory"); __builtin_amdgcn_s_barrier(); asm volatile("" ::: "memory"); } } while (0)
#define FB_BIAS(u) do { int tq_ = threadIdx.x; asm volatile("" : "+v"(tq_)); glds4s(uni(E.bias_base()), E.bias_off((u), wc, tq_ & 63), lds0 + (unsigned)BIAS_OFF + (unsigned)wid * 256u); } while (0)
    UnitF cur, nxt; int ui = 0;
    if (!S.get(0, cur)) return;
    FB_AWAIT(cur.pm);
    FB_BIAS(cur);
    unsigned vaC[2][2];
    { int tq = threadIdx.x; asm volatile("" : "+v"(tq));
#pragma unroll
      for (int i = 0; i < 2; ++i) { int R_, C_; stage_rc(tq * 16 + i * 8192, R_, C_);
#pragma unroll
        for (int h = 0; h < 2; ++h) vaC[h][i] = S.aoff(cur, h, R_, C_); } }
    f32x4 acc[2][2][4][2];
#pragma unroll
    for (int a = 0; a < 2; ++a)
#pragma unroll
        for (int b = 0; b < 2; ++b)
#pragma unroll
            for (int m = 0; m < 4; ++m)
#pragma unroll
                for (int n = 0; n < 2; ++n) acc[a][b][m][n] = (f32x4){0.f, 0.f, 0.f, 0.f};
    bf16x8 At[4][2], B0[2][2], B1[2][2];
    f32x4 ldX[4], ldY[4];
    { const char* a0 = uni(cur.a); const char* bb = uni(cur.b);
    FB_STAGEH(FB_SA(0, 0), a0, vaC, 0); FB_STAGEH(FB_SA(0, 1), a0, vaC, 1); FB_STAGEH(FB_SA(1, 0), a0 + kstep, vaC, 0);
    const int j0 = 2 * (cur.pm & 3);
    FB_BLOAD(ldY, bb, 0, j0); FB_BLOAD(ldX, bb, 1, j0);
    FB_BSTEP(ldY, 0, 0, j0, bb + BKT, 0, j0, 4);
    FB_BSTEP(ldX, 0, 1, j0, bb + BKT, 1, j0, 4);
    FB_BSTEP(ldY, 1, 0, j0, bb + 2 * BKT, 0, j0, 4); }
    FB_WAIT_V(0); FB_WAIT_L(0);
    if (wr == 1) FB_BAR;
    FB_BAR;
    for (;;) {
        const bool has_next = S.get(ui + 1, nxt);
        if (!has_next) nxt = cur;
        if (ui > 0) FB_BIAS(cur);
        if constexpr (GATHER) {
            if (has_next) { int tq = threadIdx.x; asm volatile("" : "+v"(tq));
                int R0, C0, R1, C1; stage_rc(tq * 16, R0, C0); stage_rc(tq * 16 + 8192, R1, C1);
                const char* rtb = uni((const char*)(S.rowtok + nxt.pm * BM)); const unsigned sd = lds0 + (unsigned)VAN_OFF + (unsigned)wid * 1024u;
                glds4s(rtb, (unsigned)(R0 * 4), sd); glds4s(rtb, (unsigned)(R1 * 4), sd + 256u); glds4s(rtb, (unsigned)((HALF + R0) * 4), sd + 512u); glds4s(rtb, (unsigned)((HALF + R1) * 4), sd + 768u); }
        }
        const char* ca = uni(cur.a); const char* cb = uni(cur.b); const char* na = uni(nxt.a); const char* nb = uni(nxt.b);
        const int jc = 2 * (cur.pm & 3), jn = 2 * (nxt.pm & 3);
        const bool full = __builtin_amdgcn_readfirstlane(cur.nv) > HALF;
        for (int t = 0; t < nt; t += 2) {
            const bool last = (t == nt - 2);
            if (last && has_next) FB_AWAIT(nxt.pm);
            const char* a1 = ca + (size_t)(t + 1) * kstep;
            const char* a2 = last ? na : ca + (size_t)(t + 2) * kstep;
            const char* a3 = a2 + kstep;
            const char* b2 = last ? nb : cb + (size_t)(t + 2) * BKT;
            const char* b3 = b2 + BKT;
            const char* b4 = (t + 4 < nt) ? cb + (size_t)(t + 4) * BKT : nb + (size_t)(t + 4 - nt) * BKT;
            const int j2 = last ? jn : jc, j4 = (t + 4 < nt) ? jc : jn;
            FB_BCONS(ldX, 1, 1, jc, 6);
            FB_LDB(B0, 0, 0); FB_LDB(B1, 0, 1); FB_SCHED; FB_LDA(At, 0, 0); FB_STAGEH(FB_SA(1, 1), a1, vaC, 1);
            if constexpr (GATHER) { if (last && has_next) { int tq = threadIdx.x; asm volatile("" : "+v"(tq));
                int R0, C0, R1, C1; stage_rc(tq * 16, R0, C0); stage_rc(tq * 16 + 8192, R1, C1);
                const LAS unsigned* sp = (const LAS unsigned*)(lds + VAN_OFF + wid * 1024) + (tq & 63);
                vaC[0][0] = (sp[0] * KD + C0) * 2u; vaC[0][1] = (sp[64] * KD + C1) * 2u; vaC[1][0] = (sp[128] * KD + C0) * 2u; vaC[1][1] = (sp[192] * KD + C1) * 2u; } }
            FB_WAIT_V(8); FB_WAIT_L(0); FB_BAR; FB_MMA(0, 0, At, B0); FB_BLOAD(ldX, b2, 1, j2); FB_MMA(0, 1, At, B1); FB_BAR; FB_SCHED;
            FB_BCONS(ldY, 0, 0, j2, 6);
            if (full) FB_LDA(At, 0, 1); FB_STAGEH(FB_SA(0, 0), a2, vaC, 0);
            FB_WAIT_V(8); FB_WAIT_L(0); FB_BAR; if (full) FB_MMA(1, 0, At, B0); FB_BLOAD(ldY, b3, 0, j2); if (full) FB_MMA(1, 1, At, B1); FB_BAR; FB_SCHED;
            FB_BCONS(ldX, 0, 1, j2, 6);
            FB_LDB(B0, 1, 0); FB_LDB(B1, 1, 1); FB_SCHED; FB_LDA(At, 1, 0); FB_STAGEH(FB_SA(0, 1), a2, vaC, 1);
            FB_WAIT_V(8); FB_WAIT_L(0); FB_BAR; FB_MMA(0, 0, At, B0); FB_BLOAD(ldX, b3, 1, j2); FB_MMA(0, 1, At, B1); FB_BAR; FB_SCHED;
            FB_BCONS(ldY, 1, 0, j2, 6);
            if (full) FB_LDA(At, 1, 1); FB_STAGEH(FB_SA(1, 0), a3, vaC, 0);
            FB_WAIT_V(8); FB_WAIT_L(0); FB_BAR; if (full) FB_MMA(1, 0, At, B0); FB_BLOAD(ldY, b4, 0, j4); if (full) FB_MMA(1, 1, At, B1); FB_BAR; FB_SCHED;
        }
        if (wr == 0) FB_BAR;
        { Unit ue; ue.a = nullptr; ue.b0 = nullptr; ue.b1 = nullptr; ue.pm = cur.pm; ue.pn = cur.pn; ue.e = cur.e | (cur.nv << 8);
          int tq = threadIdx.x; asm volatile("" : "+v"(tq)); E(acc, ue, wr, wc, tq & 15, (tq & 63) >> 4, (const LAS float*)(lds + BIAS_OFF + wid * 256)); }
        if (!has_next) break;
#pragma unroll
        for (int a = 0; a < 2; ++a)
#pragma unroll
            for (int b = 0; b < 2; ++b)
#pragma unroll
                for (int m = 0; m < 4; ++m)
#pragma unroll
                    for (int n = 0; n < 2; ++n) acc[a][b][m][n] = (f32x4){0.f, 0.f, 0.f, 0.f};
        cur = nxt; ++ui;
        if (wr == 1) FB_BAR;
    }
    FB_WAIT_V(0);
    FB_BAR;
#undef FB_SA
#undef FB_SB
#undef FB_STAGE
#undef FB_STAGEH
#undef FB_BIAS
#undef FB_LDA
#undef FB_LDB
#undef FB_BLOAD
#undef FB_BWRITE
#undef FB_BCW
#undef FB_BWAIT
#undef FB_BSTEP
#undef FB_BCONS
#undef FB_MMA
#undef FB_WAIT_V
#undef FB_WAIT_L
#undef FB_BAR
#undef FB_SCHED
#undef FB_AWAIT
}
}

namespace attn_body {
using bf16 = __hip_bfloat16;
using s16x4 = __attribute__((ext_vector_type(4))) short;
constexpr int PQ = NPROJP, PO = 2048;
constexpr int NW = 8, QBLK = 32, QB = QBLK * NW, KVBLK = 64;
__device__ __forceinline__ int crow(int r, int hi) { return (r & 3) + 8 * (r >> 2) + 4 * hi; }
#define SBAR() __builtin_amdgcn_sched_barrier(0)
__device__ __forceinline__ void cmask(f32x16& p0, f32x16& p1, int jb, int qrel, int hi) {
  const float NEG = -INFINITY; int d = qrel - (64 * jb + 4 * hi); asm volatile("" : "+v"(d));
  #pragma unroll
  for (int r = 0; r < 16; ++r) { const int cc = (r & 3) + 8 * (r >> 2); if (cc > d) p0[r] = NEG; if (cc + 32 > d) p1[r] = NEG; }
}
constexpr int NSLOT = 3, SLOTB = 8192;
constexpr int LDS_K = 0, LDS_V = NSLOT * SLOTB, LDS_WS = 2 * NSLOT * SLOTB, LDS_OST = LDS_WS + NW * 64 * 4, LDS_BYTES_A = LDS_OST + NW * 4096;
__device__ __forceinline__ void glds16(const void* sbase, unsigned voff, unsigned lds_dst) { unsigned keep;
  asm volatile("s_mov_b32 %0, m0\n\ts_mov_b32 m0, %2\n\ts_nop 0\n\tglobal_load_lds_dwordx4 %1, %3\n\ts_mov_b32 m0, %0" : "=&s"(keep) : "v"(voff), "s"(lds_dst), "s"(sbase) : "memory"); }
__device__ __forceinline__ float max3f(float a, float b, float c) { float r; asm("v_max3_f32 %0, %1, %2, %3" : "=v"(r) : "v"(a), "v"(b), "v"(c)); return r; }
__device__ __forceinline__ float max2f(float a, float b) { float r; asm("v_max_f32_e32 %0, %1, %2" : "=v"(r) : "v"(a), "v"(b)); return r; }
__device__ __forceinline__ float fadd_s(float a, float b) { float r; asm("v_add_f32_e32 %0, %1, %2" : "=v"(r) : "v"(a), "v"(b)); return r; }
__device__ __forceinline__ float fsub_s(float a, float b) { float r; asm("v_sub_f32_e32 %0, %1, %2" : "=v"(r) : "v"(a), "v"(b)); return r; }
typedef float f32x2_t __attribute__((ext_vector_type(2))); typedef __bf16 bf16x2_t __attribute__((ext_vector_type(2)));
__device__ __forceinline__ unsigned cvtpk_s(float lo, float hi) { f32x2_t v = {lo, hi}; bf16x2_t b = __builtin_convertvector(v, bf16x2_t); return __builtin_bit_cast(unsigned, b); }
#define WAIT_BAR(N) asm volatile("s_waitcnt vmcnt(" #N ") lgkmcnt(0)\n\ts_barrier" ::: "memory")
__device__ __forceinline__ void qkt(f32x16& p0, f32x16& p1, const char* Kslot, const bf16x8* qr, const f32x16& negm, int r32, int hi) {
  const char* kb = Kslot + hi * 1024 + r32 * 16;
  #pragma unroll
  for (int d0 = 0; d0 < 4; ++d0) {
    const bf16x8 b0 = *reinterpret_cast<const bf16x8*>(kb + d0 * 2048);
    const bf16x8 b1 = *reinterpret_cast<const bf16x8*>(kb + d0 * 2048 + 512);
    if (d0 == 0) { p0 = __builtin_amdgcn_mfma_f32_32x32x16_bf16(b0, qr[0], negm, 0, 0, 0); p1 = __builtin_amdgcn_mfma_f32_32x32x16_bf16(b1, qr[0], negm, 0, 0, 0); }
    else { p0 = __builtin_amdgcn_mfma_f32_32x32x16_bf16(b0, qr[d0], p0, 0, 0, 0); p1 = __builtin_amdgcn_mfma_f32_32x32x16_bf16(b1, qr[d0], p1, 0, 0, 0); } }
}
typedef __attribute__((address_space(3))) const char* lds_cptr;
typedef short v4i16_t __attribute__((ext_vector_type(4)));
__device__ __forceinline__ void kload8(bf16x8* kf, lds_cptr kp) {
  kf[0] = *(const __attribute__((address_space(3))) bf16x8*)(kp);        kf[1] = *(const __attribute__((address_space(3))) bf16x8*)(kp + 512);
  kf[2] = *(const __attribute__((address_space(3))) bf16x8*)(kp + 2048); kf[3] = *(const __attribute__((address_space(3))) bf16x8*)(kp + 2560);
  kf[4] = *(const __attribute__((address_space(3))) bf16x8*)(kp + 4096); kf[5] = *(const __attribute__((address_space(3))) bf16x8*)(kp + 4608);
  kf[6] = *(const __attribute__((address_space(3))) bf16x8*)(kp + 6144); kf[7] = *(const __attribute__((address_space(3))) bf16x8*)(kp + 6656);
}
__device__ __forceinline__ void kload2(bf16x8* kf, lds_cptr kp, int j) { kf[2 * j] = *(const __attribute__((address_space(3))) bf16x8*)(kp + j * 2048); kf[2 * j + 1] = *(const __attribute__((address_space(3))) bf16x8*)(kp + j * 2048 + 512); }
__device__ __forceinline__ s16x4 vtr(lds_cptr p) { return __builtin_bit_cast(s16x4, __builtin_amdgcn_ds_read_tr16_b64_v4i16((__attribute__((address_space(3))) v4i16_t*)p)); }
__device__ __forceinline__ float rowmax(const f32x16& p0, const f32x16& p1) {
  float a = max3f(p0[0], p0[1], p1[0]), b = max3f(p0[2], p0[3], p1[1]); a = max3f(a, p1[2], p1[3]);
  #pragma unroll
  for (int r = 4; r < 16; r += 4) { a = max3f(a, p0[r], p0[r + 1]); b = max3f(b, p0[r + 2], p0[r + 3]); a = max3f(a, p1[r], p1[r + 1]); b = max3f(b, p1[r + 2], p1[r + 3]); }
  const float m = max2f(a, b);
  auto rr = __builtin_amdgcn_permlane32_swap(__float_as_uint(m), __float_as_uint(m), false, false);
  return max2f(__uint_as_float(rr[0]), __uint_as_float(rr[1]));
}
__device__ __forceinline__ void pv(f32x16* o, int vb, bf16x8 pa0, bf16x8 pa1, bf16x8 pa2, bf16x8 pa3) {
  #pragma unroll
  for (int d0 = 0; d0 < 2; ++d0) { s16x4 lo[4], hi[4];
    #pragma unroll
    for (int ks = 0; ks < 4; ++ks) {
      asm volatile("ds_read_b64_tr_b16 %0,%1 offset:%c2" : "=&v"(lo[ks]) : "v"(vb), "i"(d0 * 4096 + ks * 1024) : "memory");
      asm volatile("ds_read_b64_tr_b16 %0,%1 offset:%c2" : "=&v"(hi[ks]) : "v"(vb), "i"(d0 * 4096 + ks * 1024 + 512) : "memory"); }
    asm volatile("s_waitcnt lgkmcnt(0)" ::: "memory"); SBAR();
    #define PK(k) (bf16x8){lo[k][0], lo[k][1], lo[k][2], lo[k][3], hi[k][0], hi[k][1], hi[k][2], hi[k][3]}
    o[d0] = __builtin_amdgcn_mfma_f32_32x32x16_bf16(pa0, PK(0), o[d0], 0, 0, 0);
    o[d0] = __builtin_amdgcn_mfma_f32_32x32x16_bf16(pa1, PK(1), o[d0], 0, 0, 0);
    o[d0] = __builtin_amdgcn_mfma_f32_32x32x16_bf16(pa2, PK(2), o[d0], 0, 0, 0);
    o[d0] = __builtin_amdgcn_mfma_f32_32x32x16_bf16(pa3, PK(3), o[d0], 0, 0, 0);
    #undef PK
  }
}
#define ATTN_STORE16(p, v) (*(u32x4*)(p) = (v))
template <int THRL> __device__ __forceinline__ void attn_unit(long rowbase, int qb, const bf16* Qh, const bf16* __restrict__ Kh0, const bf16* __restrict__ Vh0, bf16* Oh, char* shm) {
  const int tid = threadIdx.x, lane = tid & 63, r32 = lane & 31, hi = lane >> 5; const int wid = __builtin_amdgcn_readfirstlane(tid >> 6);
  const int q0 = qb * QB;
  const bf16* Qw = Qh + (rowbase + q0 + wid * QBLK) * PQ;
  const bf16* Kh = Kh0 + rowbase * PQ, *Vh = Vh0 + rowbase * PQ;
  const unsigned lds0 = (unsigned)(uintptr_t)shm;
  float* wsf = (float*)(shm + LDS_WS) + wid * 64;
  const unsigned koff = (unsigned)((lane * PQ + wid * 8) * 2);
  const unsigned voff = (unsigned)(((16 * (wid & 3) + (lane >> 2)) * PQ + (wid >> 2) * 32 + (lane & 3) * 8) * 2);
  const unsigned kdst = lds0 + LDS_K + wid * 1024, vdst = lds0 + LDS_V + wid * 1024;
  #define DMA_K(t, slot) glds16((const char*)Kh + (size_t)(t) * (KVBLK * PQ * 2), koff, (unsigned)__builtin_amdgcn_readfirstlane(kdst + (slot)))
  #define DMA_V(t, slot) glds16((const char*)Vh + (size_t)(t) * (KVBLK * PQ * 2), voff, (unsigned)__builtin_amdgcn_readfirstlane(vdst + (slot)))
  const int vb0 = (int)(lds0 + LDS_V) + ((lane >> 4) & 1) * 32 + (lane & 3) * 8 + (4 * hi + ((lane & 15) >> 2)) * 64;
  const char* Kbase = shm + LDS_K; bf16x8 kf[8];
  const lds_cptr shm3 = (lds_cptr)shm; const lds_cptr kp0 = shm3 + LDS_K + hi * 1024 + r32 * 16; const lds_cptr vp0 = shm3 + LDS_V + ((lane >> 4) & 1) * 32 + (lane & 3) * 8 + (4 * hi + ((lane & 15) >> 2)) * 64;
  const int NT = (q0 + QB) / KVBLK;
  DMA_K(0, 0); DMA_V(0, 0); DMA_K(1, SLOTB);
  bf16x8 qr[4];
  #pragma unroll
  for (int d0 = 0; d0 < 4; ++d0) qr[d0] = *reinterpret_cast<const bf16x8*>(&Qw[(long)r32 * PQ + d0 * 16 + hi * 8]);
  float mhat = 0.f, l_reg = 0.f; f32x16 o[2]; o[0] = f32x16{}; o[1] = f32x16{}; asm volatile("" : "+v"(o[0]), "+v"(o[1])); f32x16 negm = f32x16{}; asm volatile("" : "+v"(negm));
  const int qrel = wid * QBLK + r32;
  #define CMASK(P0, P1, t) do { int jb_ = (t) - (NT - 4); if (jb_ >= 0) cmask(P0, P1, jb_, qrel, hi); } while (0)
  bool resc = false;
  #define START(P0, P1) do { const float rm = rowmax(P0, P1); resc = false; \
    { const float dl = rm; mhat = fadd_s(mhat, dl); \
      _Pragma("unroll") for (int r = 0; r < 16; ++r) { P0[r] = fsub_s(P0[r], dl); P1[r] = fsub_s(P1[r], dl); } \
      _Pragma("unroll") for (int r = 0; r < 16; ++r) negm[r] = -mhat; asm volatile("" : "+v"(negm)); } \
    _Pragma("unroll") for (int r = 0; r < 16; ++r) P0[r] = __builtin_amdgcn_exp2f(P0[r]); } while (0)
  #define RESC() do { if (resc) { asm volatile("s_waitcnt lgkmcnt(0)" ::: "memory"); \
      _Pragma("unroll") for (int d_ = 0; d_ < 2; ++d_) _Pragma("unroll") for (int r = 0; r < 16; ++r) o[d_][r] *= wsf[crow(r, hi)]; } } while (0)
  f32x16 pA0, pA1, pB0, pB1;
  int sl_prev = 0, sl_cur = 0, sl_next = SLOTB;
  #define ROT() do { sl_prev = sl_cur; sl_cur = sl_next; sl_next = (sl_next == (NSLOT - 1) * SLOTB) ? 0 : sl_next + SLOTB; } while (0)
  DMA_K(2, 2 * SLOTB);
  WAIT_BAR(3);
  qkt(pA0, pA1, Kbase, qr, negm, r32, hi); asm volatile("s_nop 15\n\ts_nop 7" : "+v"(pA0), "+v"(pA1)); CMASK(pA0, pA1, 0);
  START(pA0, pA1);
  _Pragma("unroll") for (int r = 0; r < 16; ++r) pA1[r] = __builtin_amdgcn_exp2f(pA1[r]);
  WAIT_BAR(0);
  DMA_K(3, 0); DMA_V(1, SLOTB);
  ROT();
  kload8(kf, kp0 + sl_cur);
  WAIT_BAR(2);
  s16x4 vlo[8], vhi[8]; u32x4 pw0, pw1, pw2, pw3;
  #define PKW(P, B) cvtpk_s(P[B], P[B + 1])
  #define PAF(k) __builtin_bit_cast(bf16x8, pw##k)
  #define VFR(i) (bf16x8){vlo[i][0], vlo[i][1], vlo[i][2], vlo[i][3], vhi[i][0], vhi[i][1], vhi[i][2], vhi[i][3]}
  #define PIN(x) asm volatile("" : "+v"(x))
  #define MX3(a, b, c) __builtin_fmaxf(__builtin_fmaxf((a), (b)), (c))
  #define GAPA(MF, A0, A1, A2, A3, W0, W1, PW) do { MF; sacc += A0; sacc += A1; sacc += A2; sacc += A3; PIN(sacc); W0; W1; PIN(PW); SBAR(); } while (0)
  #define EX(v) __builtin_amdgcn_exp2f(v)
  #define GAPB(MF, X, B) do { MF; X[B] = EX(X[B]); X[B + 1] = EX(X[B + 1]); X[B + 2] = EX(X[B + 2]); X[B + 3] = EX(X[B + 3]); PIN(X); SBAR(); } while (0)
  #define VRD(i) do { vlo[i] = vtr(vp_ + (((i) >> 2) * 4096 + ((i) & 3) * 1024)); vhi[i] = vtr(vp_ + (((i) >> 2) * 4096 + ((i) & 3) * 1024 + 512)); } while (0)
  #define KRD(G, j) do { if (G) { kload2(kf, kp0 + sl_next, j); SBAR(); } } while (0)
  #define STEP(C0, C1, P0, P1, t, GK, GV, GL) do { SBAR(); \
    const lds_cptr vp_ = vp0 + sl_prev; \
    VRD(0); SBAR(); float sacc = (P0[0] + P0[1]); \
    GAPA(C0 = __builtin_amdgcn_mfma_f32_32x32x16_bf16(kf[0], qr[0], negm, 0, 0, 0), P0[2], P0[3], P0[4], P0[5],     pw0[0] = PKW(P0, 0), pw0[1] = PKW(P0, 2), pw0); \
    VRD(4); SBAR(); GAPA(C1 = __builtin_amdgcn_mfma_f32_32x32x16_bf16(kf[1], qr[0], negm, 0, 0, 0), P0[6], P0[7], P0[8], P0[9],     pw0[2] = PKW(P0, 4), pw0[3] = PKW(P0, 6), pw0); \
    VRD(1); SBAR(); GAPA(C0 = __builtin_amdgcn_mfma_f32_32x32x16_bf16(kf[2], qr[1], C0, 0, 0, 0),   P0[10], P0[11], P0[12], P0[13], pw1[0] = PKW(P0, 8), pw1[1] = PKW(P0, 10), pw1); \
    VRD(5); SBAR(); GAPA(C1 = __builtin_amdgcn_mfma_f32_32x32x16_bf16(kf[3], qr[1], C1, 0, 0, 0),   P0[14], P0[15], P1[0], P1[1],   pw1[2] = PKW(P0, 12), pw1[3] = PKW(P0, 14), pw1); \
    VRD(2); SBAR(); GAPA(C0 = __builtin_amdgcn_mfma_f32_32x32x16_bf16(kf[4], qr[2], C0, 0, 0, 0),   P1[2], P1[3], P1[4], P1[5],     pw2[0] = PKW(P1, 0), pw2[1] = PKW(P1, 2), pw2); \
    VRD(6); SBAR(); GAPA(C1 = __builtin_amdgcn_mfma_f32_32x32x16_bf16(kf[5], qr[2], C1, 0, 0, 0),   P1[6], P1[7], P1[8], P1[9],     pw2[2] = PKW(P1, 4), pw2[3] = PKW(P1, 6), pw2); \
    VRD(3); SBAR(); GAPA(C0 = __builtin_amdgcn_mfma_f32_32x32x16_bf16(kf[6], qr[3], C0, 0, 0, 0),   P1[10], P1[11], P1[12], P1[13], pw3[0] = PKW(P1, 8), pw3[1] = PKW(P1, 10), pw3); \
    VRD(7); SBAR(); GAPA(C1 = __builtin_amdgcn_mfma_f32_32x32x16_bf16(kf[7], qr[3], C1, 0, 0, 0),   P1[14], P1[15], 0.f, 0.f,       pw3[2] = PKW(P1, 12), pw3[3] = PKW(P1, 14), pw3); \
    l_reg += sacc; \
    if (GK) { DMA_K((t) + 3, sl_cur); } if (GV) { DMA_V((t) + 1, sl_next); } \
    CMASK(C0, C1, t); \
    { float a = MX3(C0[0], C0[1], C1[0]), b = MX3(C0[2], C0[3], C1[1]); a = MX3(a, C1[2], C1[3]); \
      _Pragma("unroll") for (int r = 4; r < 16; r += 4) { a = MX3(a, C0[r], C0[r + 1]); b = MX3(b, C0[r + 2], C0[r + 3]); a = MX3(a, C1[r], C1[r + 1]); b = MX3(b, C1[r + 2], C1[r + 3]); } \
      float rm = __builtin_fmaxf(a, b); { auto rr = __builtin_amdgcn_permlane32_swap(__float_as_uint(rm), __float_as_uint(rm), false, false); rm = __builtin_fmaxf(__uint_as_float(rr[0]), __uint_as_float(rr[1])); } \
      resc = false; \
      if (__builtin_expect(__any(rm > (float)THRL), 0)) { const float dl = __builtin_fmaxf(rm, 0.f); mhat += dl; \
        _Pragma("unroll") for (int r = 0; r < 16; ++r) { C0[r] -= dl; C1[r] -= dl; } \
        _Pragma("unroll") for (int r = 0; r < 16; ++r) negm[r] = -mhat; asm volatile("" : "+v"(negm)); \
        const float f = __builtin_amdgcn_exp2f(-dl); l_reg *= f; if (hi == 0) wsf[r32] = f; resc = true; } } \
    SBAR(); \
    GAPB(o[0] = __builtin_amdgcn_mfma_f32_32x32x16_bf16(PAF(0), VFR(0), o[0], 0, 0, 0), C0, 0); \
    GAPB(o[1] = __builtin_amdgcn_mfma_f32_32x32x16_bf16(PAF(0), VFR(4), o[1], 0, 0, 0), C0, 4); \
    KRD(GL, 0); GAPB(o[0] = __builtin_amdgcn_mfma_f32_32x32x16_bf16(PAF(1), VFR(1), o[0], 0, 0, 0), C0, 8); \
    KRD(GL, 1); GAPB(o[1] = __builtin_amdgcn_mfma_f32_32x32x16_bf16(PAF(1), VFR(5), o[1], 0, 0, 0), C0, 12); \
    KRD(GL, 2); GAPB(o[0] = __builtin_amdgcn_mfma_f32_32x32x16_bf16(PAF(2), VFR(2), o[0], 0, 0, 0), C1, 0); \
    KRD(GL, 3); GAPB(o[1] = __builtin_amdgcn_mfma_f32_32x32x16_bf16(PAF(2), VFR(6), o[1], 0, 0, 0), C1, 4); \
    GAPB(o[0] = __builtin_amdgcn_mfma_f32_32x32x16_bf16(PAF(3), VFR(3), o[0], 0, 0, 0), C1, 8); \
    GAPB(o[1] = __builtin_amdgcn_mfma_f32_32x32x16_bf16(PAF(3), VFR(7), o[1], 0, 0, 0), C1, 12); \
    } while (0)
  int t = 1;
  #undef CMASK
  #define CMASK(P0, P1, t) do {} while (0)
  for (; t + 5 < NT; t += 2) {
    STEP(pB0, pB1, pA0, pA1, t, true, true, true);     WAIT_BAR(2); RESC(); ROT();
    STEP(pA0, pA1, pB0, pB1, t + 1, true, true, true); WAIT_BAR(2); RESC(); ROT();
  }
  #undef CMASK
  #define CMASK(P0, P1, t) do { int jb_ = (t) - (NT - 4); if (jb_ >= 0) cmask(P0, P1, jb_, qrel, hi); } while (0)
  #define ENDW(tt) do { if ((tt) + 3 < NT) { WAIT_BAR(2); } else if ((tt) + 2 < NT) { WAIT_BAR(1); } else { WAIT_BAR(0); } } while (0)
  for (; t + 1 < NT; t += 2) {
    STEP(pB0, pB1, pA0, pA1, t, (t + 3 < NT), (t + 1 < NT), (t + 1 < NT));         ENDW(t);     RESC(); ROT();
    STEP(pA0, pA1, pB0, pB1, t + 1, (t + 4 < NT), (t + 2 < NT), (t + 2 < NT));     ENDW(t + 1); RESC(); ROT();
  }
  STEP(pB0, pB1, pA0, pA1, NT - 1, false, false, false); RESC();
  { float sacc = pB0[0] + pB0[1]; _Pragma("unroll") for (int r = 2; r < 16; ++r) sacc += pB0[r]; _Pragma("unroll") for (int r = 0; r < 16; ++r) sacc += pB1[r]; l_reg += sacc;
    pw0 = (u32x4){PKW(pB0, 0), PKW(pB0, 2), PKW(pB0, 4), PKW(pB0, 6)}; pw1 = (u32x4){PKW(pB0, 8), PKW(pB0, 10), PKW(pB0, 12), PKW(pB0, 14)}; pw2 = (u32x4){PKW(pB1, 0), PKW(pB1, 2), PKW(pB1, 4), PKW(pB1, 6)}; pw3 = (u32x4){PKW(pB1, 8), PKW(pB1, 10), PKW(pB1, 12), PKW(pB1, 14)};
    SBAR(); pv(o, vb0 + sl_cur, PAF(0), PAF(1), PAF(2), PAF(3)); }
  #undef PKW
  #undef PAF
  #undef VFR
  #undef PIN
  #undef MX3
  #undef GAPA
  #undef GAPB
  #undef EX
  #undef VRD
  #undef KRD
  #undef STEP
  #undef ENDW
  { auto rr = __builtin_amdgcn_permlane32_swap(__float_as_uint(l_reg), __float_as_uint(l_reg), false, false); l_reg = __uint_as_float(rr[0]) + __uint_as_float(rr[1]); }
  if (hi == 0) wsf[32 + r32] = l_reg; asm volatile("s_waitcnt lgkmcnt(0)" ::: "memory");
  float rli[16];
  #pragma unroll
  for (int r = 0; r < 16; ++r) rli[r] = __builtin_amdgcn_rcpf(wsf[32 + crow(r, hi)]);
  bf16* Ow = Oh + (rowbase + q0 + wid * QBLK) * PO;
  { bf16* stg = (bf16*)(shm + LDS_OST) + wid * 2048;
    #pragma unroll
    for (int r = 0; r < 16; ++r) { const int orow = crow(r, hi);
      #pragma unroll
      for (int d0 = 0; d0 < 2; ++d0) stg[orow * 64 + d0 * 32 + r32] = __float2bfloat16(o[d0][r] * rli[r]); }
    asm volatile("s_waitcnt lgkmcnt(0)" ::: "memory");
    #pragma unroll
    for (int i = 0; i < 4; ++i) { const int row = i * 8 + (lane >> 3), ch = lane & 7; const u32x4 v = *(const u32x4*)(stg + row * 64 + ch * 8); ATTN_STORE16(Ow + (long)row * PO + ch * 8, v); } }
  asm volatile("s_waitcnt lgkmcnt(0)\n\ts_barrier" ::: "memory");
  #undef DMA_K
  #undef DMA_V
  #undef CMASK
  #undef START
  #undef RESC
  #undef ROT
}
template <int THRL> __device__ __forceinline__ void attn_unit128(long rowbase, int qb, const bf16* Qh, const bf16* __restrict__ Kh0, const bf16* __restrict__ Vh0, bf16* Oh, char* shm) {
  int tid = threadIdx.x; asm volatile("" : "+v"(tid));
  const int lane = tid & 63, r32 = lane & 31, hi = lane >> 5; const int wid = __builtin_amdgcn_readfirstlane(tid >> 6);
  const int q0 = qb * QB;
  const bf16* Qw = Qh + (rowbase + q0 + wid * QBLK) * PQ;
  const bf16* Kh = Kh0 + rowbase * PQ, *Vh = Vh0 + rowbase * PQ;
  const unsigned lds0 = (unsigned)(uintptr_t)shm;
  constexpr int LDS_WS2 = LDS_V + NSLOT * 2 * SLOTB, LDS_OST2 = LDS_WS2 + NW * 64 * 4;
  float* wsf = (float*)(shm + LDS_WS2) + wid * 64;
  const unsigned koff = (unsigned)((lane * PQ + wid * 8) * 2);
  const unsigned voff = (unsigned)(((16 * (wid & 3) + (lane >> 2)) * PQ + (wid >> 2) * 32 + (lane & 3) * 8) * 2);
  const unsigned kdst = lds0 + LDS_K + wid * 1024, vdst = lds0 + LDS_V + wid * 1024;
  #define DMA_K(t, slot) glds16((const char*)Kh + (size_t)(t) * (KVBLK * PQ * 2), koff, (unsigned)__builtin_amdgcn_readfirstlane(kdst + (slot)))
  #define DMA_V(t, slot) do { glds16((const char*)Vh + (size_t)(t) * (KVBLK * PQ * 2), voff, (unsigned)__builtin_amdgcn_readfirstlane(vdst + 2 * (slot))); \
    glds16((const char*)Vh + (size_t)(t) * (KVBLK * PQ * 2) + 128, voff, (unsigned)__builtin_amdgcn_readfirstlane(vdst + 2 * (slot) + 8192)); } while (0)
  const int vb0 = (int)(lds0 + LDS_V) + ((lane >> 4) & 1) * 32 + (lane & 3) * 8 + (4 * hi + ((lane & 15) >> 2)) * 64;
  const char* Kbase = shm + LDS_K; bf16x8 kf[8];
  const lds_cptr shm3 = (lds_cptr)shm; const lds_cptr kp0 = shm3 + LDS_K + hi * 1024 + r32 * 16; const lds_cptr vp0 = shm3 + LDS_V + ((lane >> 4) & 1) * 32 + (lane & 3) * 8 + (4 * hi + ((lane & 15) >> 2)) * 64;
  const int NT = (q0 + QB) / KVBLK;
  DMA_K(0, 0); DMA_V(0, 0); DMA_K(1, SLOTB);
  const lds_cptr qp0 = shm3 + LDS_OST2 + wid * 4096 + lane * 16;
  {
  #pragma unroll
  for (int d0 = 0; d0 < 4; ++d0) { const bf16x8 qv = *reinterpret_cast<const bf16x8*>(&Qw[(long)r32 * PQ + d0 * 16 + hi * 8]); *(__attribute__((address_space(3))) bf16x8*)(shm3 + LDS_OST2 + wid * 4096 + d0 * 1024 + lane * 16) = qv; }
  asm volatile("s_waitcnt lgkmcnt(0)" ::: "memory");
  }
  #define QR(d0) (*(const __attribute__((address_space(3))) bf16x8*)(qp0 + (d0) * 1024))
  float mhat = 0.f, l_reg = 0.f; f32x16 o[4]; o[0] = f32x16{}; o[1] = f32x16{}; o[2] = f32x16{}; o[3] = f32x16{}; asm volatile("" : "+v"(o[0]), "+v"(o[1]), "+v"(o[2]), "+v"(o[3]));
  const int qrel = wid * QBLK + r32;
  #define CMASK(P0, P1, t) do { int jb_ = (t) - (NT - 4); if (jb_ >= 0) cmask(P0, P1, jb_, qrel, hi); } while (0)
  bool resc = false;
  #define START(P0, P1) do { const float rm = rowmax(P0, P1); resc = false; \
    { const float dl = rm; mhat = fadd_s(mhat, dl); \
      _Pragma("unroll") for (int r = 0; r < 16; ++r) { P0[r] = fsub_s(P0[r], dl); P1[r] = fsub_s(P1[r], dl); } } \
    _Pragma("unroll") for (int r = 0; r < 16; ++r) P0[r] = __builtin_amdgcn_exp2f(P0[r]); } while (0)
  #define RESC() do { if (resc) { asm volatile("s_waitcnt lgkmcnt(0)" ::: "memory"); \
      _Pragma("unroll") for (int d_ = 0; d_ < 4; ++d_) _Pragma("unroll") for (int r = 0; r < 16; ++r) o[d_][r] *= wsf[crow(r, hi)]; } } while (0)
  f32x16 pA0, pA1, pB0, pB1;
  int sl_prev = 0, sl_cur = 0, sl_next = SLOTB;
  #define ROT() do { sl_prev = sl_cur; sl_cur = sl_next; sl_next = (sl_next == (NSLOT - 1) * SLOTB) ? 0 : sl_next + SLOTB; } while (0)
  DMA_K(2, 2 * SLOTB);
  WAIT_BAR(4);
  { bf16x8 qr_[4] = {QR(0), QR(1), QR(2), QR(3)}; qkt(pA0, pA1, Kbase, qr_, f32x16{}, r32, hi); } asm volatile("s_nop 15\n\ts_nop 7" : "+v"(pA0), "+v"(pA1)); CMASK(pA0, pA1, 0);
  START(pA0, pA1);
  _Pragma("unroll") for (int r = 0; r < 16; ++r) pA1[r] = __builtin_amdgcn_exp2f(pA1[r]);
  WAIT_BAR(0);
  DMA_K(3, 0); DMA_V(1, SLOTB);
  ROT();
  kload8(kf, kp0 + sl_cur);
  WAIT_BAR(3);
  s16x4 vlo[8], vhi[8]; u32x4 pw0, pw1, pw2, pw3;
  #define PKW(P, B) cvtpk_s(P[B], P[B + 1])
  #define PAF(k) __builtin_bit_cast(bf16x8, pw##k)
  #define VFR(i) (bf16x8){vlo[i][0], vlo[i][1], vlo[i][2], vlo[i][3], vhi[i][0], vhi[i][1], vhi[i][2], vhi[i][3]}
  #define PIN(x) asm volatile("" : "+v"(x))
  #define MX3(a, b, c) __builtin_fmaxf(__builtin_fmaxf((a), (b)), (c))
  #define GAPA(MF, A0, A1, A2, A3, W0, W1, PW) do { MF; sacc += A0; sacc += A1; sacc += A2; sacc += A3; PIN(sacc); W0; W1; PIN(PW); SBAR(); } while (0)
  #define EX(v) __builtin_amdgcn_exp2f(v)
  #define GAPB(MF, X, B) do { MF; X[B] = EX(X[B]); X[B + 1] = EX(X[B + 1]); X[B + 2] = EX(X[B + 2]); X[B + 3] = EX(X[B + 3]); PIN(X); SBAR(); } while (0)
  #define GAPC(MF, X, B, RD) do { MF; X[B] = EX(X[B]); X[B + 1] = EX(X[B + 1]); PIN(X); RD; SBAR(); } while (0)
  #define VRD(i) do { vlo[i] = vtr(vp_ + (((i) >> 2) * 4096 + ((i) & 3) * 1024)); vhi[i] = vtr(vp_ + (((i) >> 2) * 4096 + ((i) & 3) * 1024 + 512)); } while (0)
  #define VRD2(i) do { vlo[i] = vtr(vp_ + (8192 + ((i) >> 2) * 4096 + ((i) & 3) * 1024)); vhi[i] = vtr(vp_ + (8192 + ((i) >> 2) * 4096 + ((i) & 3) * 1024 + 512)); } while (0)
  #define KRD(G, j) do { if (G) { kload2(kf, kp0 + sl_next, j); SBAR(); } } while (0)
  #define STEP(C0, C1, P0, P1, t, GK, GV, GL) do { SBAR(); \
    const lds_cptr vp_ = vp0 + 2 * sl_prev; \
    VRD(0); SBAR(); float sacc = (P0[0] + P0[1]); \
    GAPA(C0 = __builtin_amdgcn_mfma_f32_32x32x16_bf16(kf[0], QR(0), f32x16{}, 0, 0, 0), P0[2], P0[3], P0[4], P0[5],     pw0[0] = PKW(P0, 0), pw0[1] = PKW(P0, 2), pw0); \
    VRD(4); SBAR(); GAPA(C1 = __builtin_amdgcn_mfma_f32_32x32x16_bf16(kf[1], QR(0), f32x16{}, 0, 0, 0), P0[6], P0[7], P0[8], P0[9],     pw0[2] = PKW(P0, 4), pw0[3] = PKW(P0, 6), pw0); \
    VRD(1); SBAR(); GAPA(C0 = __builtin_amdgcn_mfma_f32_32x32x16_bf16(kf[2], QR(1), C0, 0, 0, 0),   P0[10], P0[11], P0[12], P0[13], pw1[0] = PKW(P0, 8), pw1[1] = PKW(P0, 10), pw1); \
    VRD(5); SBAR(); GAPA(C1 = __builtin_amdgcn_mfma_f32_32x32x16_bf16(kf[3], QR(1), C1, 0, 0, 0),   P0[14], P0[15], P1[0], P1[1],   pw1[2] = PKW(P0, 12), pw1[3] = PKW(P0, 14), pw1); \
    VRD(2); SBAR(); GAPA(C0 = __builtin_amdgcn_mfma_f32_32x32x16_bf16(kf[4], QR(2), C0, 0, 0, 0),   P1[2], P1[3], P1[4], P1[5],     pw2[0] = PKW(P1, 0), pw2[1] = PKW(P1, 2), pw2); \
    VRD(6); SBAR(); GAPA(C1 = __builtin_amdgcn_mfma_f32_32x32x16_bf16(kf[5], QR(2), C1, 0, 0, 0),   P1[6], P1[7], P1[8], P1[9],     pw2[2] = PKW(P1, 4), pw2[3] = PKW(P1, 6), pw2); \
    VRD(3); SBAR(); GAPA(C0 = __builtin_amdgcn_mfma_f32_32x32x16_bf16(kf[6], QR(3), C0, 0, 0, 0),   P1[10], P1[11], P1[12], P1[13], pw3[0] = PKW(P1, 8), pw3[1] = PKW(P1, 10), pw3); \
    VRD(7); SBAR(); GAPA(C1 = __builtin_amdgcn_mfma_f32_32x32x16_bf16(kf[7], QR(3), C1, 0, 0, 0),   P1[14], P1[15], 0.f, 0.f,       pw3[2] = PKW(P1, 12), pw3[3] = PKW(P1, 14), pw3); \
    l_reg += sacc; \
    _Pragma("unroll") for (int r = 0; r < 16; ++r) { C0[r] -= mhat; C1[r] -= mhat; } \
    if (GK) { DMA_K((t) + 3, sl_cur); } if (GV) { DMA_V((t) + 1, sl_next); } \
    CMASK(C0, C1, t); \
    { float a = MX3(C0[0], C0[1], C1[0]), b = MX3(C0[2], C0[3], C1[1]); a = MX3(a, C1[2], C1[3]); \
      _Pragma("unroll") for (int r = 4; r < 16; r += 4) { a = MX3(a, C0[r], C0[r + 1]); b = MX3(b, C0[r + 2], C0[r + 3]); a = MX3(a, C1[r], C1[r + 1]); b = MX3(b, C1[r + 2], C1[r + 3]); } \
      float rm = __builtin_fmaxf(a, b); { auto rr = __builtin_amdgcn_permlane32_swap(__float_as_uint(rm), __float_as_uint(rm), false, false); rm = __builtin_fmaxf(__uint_as_float(rr[0]), __uint_as_float(rr[1])); } \
      resc = false; \
      if (__builtin_expect(__any(rm > (float)THRL), 0)) { const float dl = __builtin_fmaxf(rm, 0.f); mhat += dl; \
        _Pragma("unroll") for (int r = 0; r < 16; ++r) { C0[r] -= dl; C1[r] -= dl; } \
        const float f = __builtin_amdgcn_exp2f(-dl); l_reg *= f; if (hi == 0) wsf[r32] = f; resc = true; } } \
    SBAR(); \
    GAPC(o[0] = __builtin_amdgcn_mfma_f32_32x32x16_bf16(PAF(0), VFR(0), o[0], 0, 0, 0), C0, 0, VRD2(0)); \
    GAPC(o[1] = __builtin_amdgcn_mfma_f32_32x32x16_bf16(PAF(0), VFR(4), o[1], 0, 0, 0), C0, 2, VRD2(4)); \
    KRD(GL, 0); GAPC(o[0] = __builtin_amdgcn_mfma_f32_32x32x16_bf16(PAF(1), VFR(1), o[0], 0, 0, 0), C0, 4, VRD2(1)); \
    KRD(GL, 1); GAPC(o[1] = __builtin_amdgcn_mfma_f32_32x32x16_bf16(PAF(1), VFR(5), o[1], 0, 0, 0), C0, 6, VRD2(5)); \
    KRD(GL, 2); GAPC(o[0] = __builtin_amdgcn_mfma_f32_32x32x16_bf16(PAF(2), VFR(2), o[0], 0, 0, 0), C0, 8, VRD2(2)); \
    KRD(GL, 3); GAPC(o[1] = __builtin_amdgcn_mfma_f32_32x32x16_bf16(PAF(2), VFR(6), o[1], 0, 0, 0), C0, 10, VRD2(6)); \
    GAPC(o[0] = __builtin_amdgcn_mfma_f32_32x32x16_bf16(PAF(3), VFR(3), o[0], 0, 0, 0), C0, 12, VRD2(3)); \
    GAPC(o[1] = __builtin_amdgcn_mfma_f32_32x32x16_bf16(PAF(3), VFR(7), o[1], 0, 0, 0), C0, 14, VRD2(7)); \
    GAPC(o[2] = __builtin_amdgcn_mfma_f32_32x32x16_bf16(PAF(0), VFR(0), o[2], 0, 0, 0), C1, 0, (void)0); \
    GAPC(o[3] = __builtin_amdgcn_mfma_f32_32x32x16_bf16(PAF(0), VFR(4), o[3], 0, 0, 0), C1, 2, (void)0); \
    GAPC(o[2] = __builtin_amdgcn_mfma_f32_32x32x16_bf16(PAF(1), VFR(1), o[2], 0, 0, 0), C1, 4, (void)0); \
    GAPC(o[3] = __builtin_amdgcn_mfma_f32_32x32x16_bf16(PAF(1), VFR(5), o[3], 0, 0, 0), C1, 6, (void)0); \
    GAPC(o[2] = __builtin_amdgcn_mfma_f32_32x32x16_bf16(PAF(2), VFR(2), o[2], 0, 0, 0), C1, 8, (void)0); \
    GAPC(o[3] = __builtin_amdgcn_mfma_f32_32x32x16_bf16(PAF(2), VFR(6), o[3], 0, 0, 0), C1, 10, (void)0); \
    GAPC(o[2] = __builtin_amdgcn_mfma_f32_32x32x16_bf16(PAF(3), VFR(3), o[2], 0, 0, 0), C1, 12, (void)0); \
    GAPC(o[3] = __builtin_amdgcn_mfma_f32_32x32x16_bf16(PAF(3), VFR(7), o[3], 0, 0, 0), C1, 14, (void)0); \
    } while (0)
  int t = 1;
  #undef CMASK
  #define CMASK(P0, P1, t) do {} while (0)
  for (; t + 5 < NT; t += 2) {
    STEP(pB0, pB1, pA0, pA1, t, true, true, true);     WAIT_BAR(3); RESC(); ROT();
    STEP(pA0, pA1, pB0, pB1, t + 1, true, true, true); WAIT_BAR(3); RESC(); ROT();
  }
  #undef CMASK
  #define CMASK(P0, P1, t) do { int jb_ = (t) - (NT - 4); if (jb_ >= 0) cmask(P0, P1, jb_, qrel, hi); } while (0)
  #define ENDW(tt) do { if ((tt) + 3 < NT) { WAIT_BAR(3); } else if ((tt) + 2 < NT) { WAIT_BAR(2); } else { WAIT_BAR(0); } } while (0)
  for (; t + 1 < NT; t += 2) {
    STEP(pB0, pB1, pA0, pA1, t, (t + 3 < NT), (t + 1 < NT), (t + 1 < NT));         ENDW(t);     RESC(); ROT();
    STEP(pA0, pA1, pB0, pB1, t + 1, (t + 4 < NT), (t + 2 < NT), (t + 2 < NT));     ENDW(t + 1); RESC(); ROT();
  }
  STEP(pB0, pB1, pA0, pA1, NT - 1, false, false, false); RESC();
  { float sacc = pB0[0] + pB0[1]; _Pragma("unroll") for (int r = 2; r < 16; ++r) sacc += pB0[r]; _Pragma("unroll") for (int r = 0; r < 16; ++r) sacc += pB1[r]; l_reg += sacc;
    pw0 = (u32x4){PKW(pB0, 0), PKW(pB0, 2), PKW(pB0, 4), PKW(pB0, 6)}; pw1 = (u32x4){PKW(pB0, 8), PKW(pB0, 10), PKW(pB0, 12), PKW(pB0, 14)}; pw2 = (u32x4){PKW(pB1, 0), PKW(pB1, 2), PKW(pB1, 4), PKW(pB1, 6)}; pw3 = (u32x4){PKW(pB1, 8), PKW(pB1, 10), PKW(pB1, 12), PKW(pB1, 14)};
    SBAR(); pv(o, vb0 + 2 * sl_cur, PAF(0), PAF(1), PAF(2), PAF(3)); pv(o + 2, vb0 + 2 * sl_cur + 8192, PAF(0), PAF(1), PAF(2), PAF(3)); }
  #undef PKW
  #undef PAF
  #undef VFR
  #undef PIN
  #undef MX3
  #undef GAPA
  #undef GAPB
  #undef GAPC
  #undef EX
  #undef VRD
  #undef VRD2
  #undef KRD
  #undef STEP
  #undef ENDW
  { auto rr = __builtin_amdgcn_permlane32_swap(__float_as_uint(l_reg), __float_as_uint(l_reg), false, false); l_reg = __uint_as_float(rr[0]) + __uint_as_float(rr[1]); }
  if (hi == 0) wsf[32 + r32] = l_reg; asm volatile("s_waitcnt lgkmcnt(0)" ::: "memory");
  float rli[16];
  #pragma unroll
  for (int r = 0; r < 16; ++r) rli[r] = __builtin_amdgcn_rcpf(wsf[32 + crow(r, hi)]);
  bf16* Ow = Oh + (rowbase + q0 + wid * QBLK) * PO;
  { bf16* stg = (bf16*)(shm + LDS_OST2) + wid * 2048;
    int te_ = threadIdx.x; asm volatile("" : "+v"(te_)); const int lane = te_ & 63;
    #pragma unroll
    for (int hv = 0; hv < 2; ++hv) {
      #pragma unroll
      for (int r = 0; r < 16; ++r) { const int orow = crow(r, hi);
        #pragma unroll
        for (int d0 = 0; d0 < 2; ++d0) stg[orow * 64 + d0 * 32 + r32] = __float2bfloat16(o[2 * hv + d0][r] * rli[r]); }
      asm volatile("s_waitcnt lgkmcnt(0)" ::: "memory");
      #pragma unroll
      for (int i = 0; i < 4; ++i) { const int row = i * 8 + (lane >> 3), ch = lane & 7; const u32x4 v = *(const u32x4*)(stg + row * 64 + ch * 8); ATTN_STORE16(Ow + (long)row * PO + hv * 64 + ch * 8, v); }
      asm volatile("s_waitcnt lgkmcnt(0)" ::: "memory");
    } }
  asm volatile("s_waitcnt lgkmcnt(0)\n\ts_barrier" ::: "memory");
  #undef QR
  #undef DMA_K
  #undef DMA_V
  #undef CMASK
  #undef START
  #undef RESC
  #undef ROT
}
__device__ __forceinline__ void attn_phase128(char* lds, const bf16_t* proj, bf16_t* att, int G, int vcu) {
  for (int i = 0;; ++i) {
    const int L = i * G + vcu; if (L >= 512) break;
    const int k = L >> 8, w = L & 255, ph = w >> 2, sq = w & 3;
    const int qb = (k == 0) ? (7 - sq) : sq;
    const int b = ph >> 4, rem = ph & 15, h = rem >> 1, c = rem & 1;
    const bf16* P = (const bf16*)proj;
    attn_unit128<8>((long)b * SEQ, qb, P + C_Q + (2 * h + c) * 64, P + C_K + (2 * h + c) * 64, P + C_V + h * 128, (bf16*)att + c * 1024 + h * 128, lds);
  }
}

__device__ __forceinline__ void attn_phase(char* lds, const bf16_t* proj, bf16_t* att, int G, int vcu) {
  for (int i = 0;; ++i) {
    const int L = i * G + vcu; if (L >= 1024) break;
    const int k = L >> 8, w = L & 255, ph = w >> 1, set = w & 1;
    const int qb = (k == 0) ? (7 - set) : (k == 1) ? set : (k == 2) ? (4 + set) : (3 - set);
    const int b = ph >> 5, rem = ph & 31, h = rem >> 2, c = (rem >> 1) & 1, vh = rem & 1;
    const bf16* P = (const bf16*)proj;
    attn_unit<8>((long)b * SEQ, qb, P + C_Q + (2 * h + c) * 64, P + C_K + (2 * h + c) * 64, P + C_V + h * 128 + vh * 64, (bf16*)att + c * 1024 + h * 128 + vh * 64, lds);
  }
}
#undef SBAR
#undef WAIT_BAR
}

#define XB_TMO      128
#define XB_XCNT(j)  (256  + 64 * (j))
#define XB_XSUB(j)  (1280 + 64 * (j))
#define XB_XGEN(j)  (2304 + 64 * (j))
#define XB_TOP      3328
#define XB_TOPGEN   3392
#define XCD_BAR_WORDS 3456
#define XB_SPIN_CAP (1u << 18)
__device__ __forceinline__ unsigned xb_ld(unsigned* p)              { return __hip_atomic_load(p, __ATOMIC_RELAXED, __HIP_MEMORY_SCOPE_AGENT); }
__device__ __forceinline__ unsigned xb_add(unsigned* p, unsigned v) { return __hip_atomic_fetch_add(p, v, __ATOMIC_RELAXED, __HIP_MEMORY_SCOPE_AGENT); }
__device__ __forceinline__ unsigned xb_xcc_id() { return (unsigned)__builtin_amdgcn_s_getreg((3 << 11) | 20) & 0xFu; }
#define XB_SPIN(cond, bar) do { unsigned _sp = 0; while (cond) { __builtin_amdgcn_s_sleep(1); \
    if ((++_sp & 255u) == 0u) { if (xb_ld(&(bar)[XB_TMO])) break; if (_sp > XB_SPIN_CAP) { atomicAdd(&(bar)[XB_TMO], 1u); break; } } } } while (0)
struct XcdBarrier { unsigned* bar; unsigned x; volatile LAS unsigned* st; };
__device__ __forceinline__ XcdBarrier xcd_barrier_post(unsigned* bar, volatile LAS unsigned* st) {
    XcdBarrier b; b.bar = bar; b.x = xb_xcc_id(); b.st = st;
    if (threadIdx.x == 0) (void)xb_add(&bar[XB_XCNT(b.x)], 1u);
    return b;
}
__device__ __forceinline__ void xcd_barrier_complete(unsigned* bar, unsigned x, unsigned& nloc, unsigned& nx) {
    const unsigned G = gridDim.x * gridDim.y * gridDim.z;
    unsigned sum, cnt, mine, sp = 0u;
    for (;;) {
        sum = 0u; cnt = 0u; mine = 0u;
#pragma unroll
        for (unsigned j = 0; j < 16; ++j) { const unsigned c = xb_ld(&bar[XB_XCNT(j)]); sum += c; cnt += (c > 0u) ? 1u : 0u; mine = (j == x) ? c : mine; }
        if (sum == G) break;
        __builtin_amdgcn_s_sleep(1);
        if ((++sp & 255u) == 0u) { if (xb_ld(&bar[XB_TMO])) break; if (sp > XB_SPIN_CAP) { atomicAdd(&bar[XB_TMO], 1u); break; } }
    }
    nloc = mine > 0u ? mine : 1u; nx = cnt > 0u ? cnt : 1u;
}
__device__ __forceinline__ void xcd_barrier(const XcdBarrier& b) {
    asm volatile("s_waitcnt vmcnt(0)" ::: "memory");
    __syncthreads();
    if (threadIdx.x == 0) {
        unsigned* bar = b.bar;
        __builtin_amdgcn_s_waitcnt(0);
        unsigned nloc = b.st[0], nx = b.st[1];
        if (nloc == 0u) { xcd_barrier_complete(bar, b.x, nloc, nx); b.st[0] = nloc; b.st[1] = nx; }
        const unsigned old = xb_add(&bar[XB_XSUB(b.x)], 1u);
        const unsigned gen = old / nloc;
        if (old + 1u == (gen + 1u) * nloc) {
            __builtin_amdgcn_fence(__ATOMIC_RELEASE, "agent");
            asm volatile("s_waitcnt vmcnt(0)" ::: "memory");
            const unsigned og = xb_add(&bar[XB_TOP], 1u);
            const unsigned tg = og / nx;
            if (og + 1u == (tg + 1u) * nx) xb_add(&bar[XB_TOPGEN], 1u);
            else XB_SPIN(xb_ld(&bar[XB_TOPGEN]) == tg, bar);
            __builtin_amdgcn_fence(__ATOMIC_ACQUIRE, "agent");
            xb_add(&bar[XB_XGEN(b.x)], 1u);
            asm volatile("s_waitcnt vmcnt(0)" ::: "memory");
        } else {
            XB_SPIN(xb_ld(&bar[XB_XGEN(b.x)]) == gen, bar);
            __builtin_amdgcn_fence(__ATOMIC_ACQUIRE, "agent");
            asm volatile("s_waitcnt vmcnt(0)" ::: "memory");
        }
    }
    __syncthreads();
}

struct Ptrs {
    const float* in[24]; float* out; unsigned char* ws;
};
__device__ __forceinline__ void p0_transpose_item(const float* W, int K, int N, int Nvalid, bf16_t* WT, LAS float* scr, int item, int nblk, int lane) {
    const int kb = item / nblk, nb = item % nblk, k0 = 64 * kb, n0 = 32 * nb;
    const int nn = n0 + (lane & 31); const bool ok = nn < Nvalid;
    float v[32];
#pragma unroll
    for (int i = 0; i < 32; ++i) { const int kk = 2 * i + (lane >> 5); v[i] = ok ? W[(size_t)(k0 + kk) * N + nn] : 0.f; }
#pragma unroll
    for (int i = 0; i < 32; ++i) { const int kk = 2 * i + (lane >> 5); scr[kk * 33 + (lane & 31)] = v[i]; }
    LDS_WAIT(); asm volatile("" ::: "memory");
    const int c = lane & 7;
#pragma unroll
    for (int j = 0; j < 4; ++j) { const int n = (lane >> 3) + 8 * j; const LAS float* s = scr + (8 * c) * 33 + n;
        u32x4 o; o.x = cvt_pk_bf16(s[0 * 33], s[1 * 33]); o.y = cvt_pk_bf16(s[2 * 33], s[3 * 33]); o.z = cvt_pk_bf16(s[4 * 33], s[5 * 33]); o.w = cvt_pk_bf16(s[6 * 33], s[7 * 33]);
        *(u32x4*)(WT + (size_t)(n0 + n) * K + k0 + 8 * c) = o; }
    LDS_WAIT(); asm volatile("" ::: "memory");
}
__device__ __forceinline__ void p0_prologue(const Ptrs& P, LAS unsigned char* lds, int gw, int NGW, int wave) {
    int tq_ = threadIdx.x; asm volatile("" : "+v"(tq_)); const int lane = tq_ & 63;
    LAS float* scr = (LAS float*)(lds + wave * 16384);
    unsigned char* ws = P.ws;
    constexpr int I_IN = 32 * (NPROJP / 32);
    for (int it = gw; it < I_IN; it += NGW) p0_transpose_item(P.in[3], DM, NPROJ, NPROJ, (bf16_t*)(ws + WS_WIN), scr, it, NPROJP / 32, lane);
    const float* x = P.in[0]; const float* nw = P.in[2]; bf16_t* XN = (bf16_t*)(ws + WS_XN);
    for (int m = gw; m < NTOK; m += NGW) {
        const f32x4* xr = (const f32x4*)(x + (size_t)m * DM) + lane; f32x4 v[8]; float s = 0.f;
#pragma unroll
        for (int j = 0; j < 8; ++j) { v[j] = xr[64 * j]; s += (v[j].x * v[j].x + v[j].y * v[j].y) + (v[j].z * v[j].z + v[j].w * v[j].w); }
        const float rstd = 1.0f / sqrtf(wave_sum(s) * (1.f / DM) + EPS);
        u32x2* o8 = (u32x2*)(XN + (size_t)m * DM) + lane;
#pragma unroll
        for (int j = 0; j < 8; ++j) { const f32x4 w = ((const f32x4*)nw)[lane + 64 * j]; u32x2 o; o.x = cvt_pk_bf16(v[j].x * rstd * w.x, v[j].y * rstd * w.y); o.y = cvt_pk_bf16(v[j].z * rstd * w.z, v[j].w * rstd * w.w); o8[64 * j] = o; }
    }
    const int* pos = (const int*)P.in[1]; float* rope = (float*)(ws + WS_ROPE);
    for (int idx = gw * 64 + lane; idx < NTOK * 8; idx += NGW * 64) {
        const int t = idx >> 3, i = idx & 7;
        const float inv = powf(500000.0f, -(float)(2 * i) / 16.0f);
        const float ang = (float)pos[t] * inv;
        rope[t * 16 + i] = (float)cos((double)ang); rope[t * 16 + 8 + i] = (float)sin((double)ang);
    }
}

__device__ __forceinline__ void wout_tail(const Ptrs& P, LAS unsigned char* lds, int rank, int nblk, int wave) {
    int tq_ = threadIdx.x; asm volatile("" : "+v"(tq_)); const int lane = tq_ & 63;
    LAS float* scr = (LAS float*)(lds + wave * 16384);
    for (int it = rank * NWAVES + wave; it < 32 * 64; it += nblk * NWAVES) p0_transpose_item(P.in[15], DM, DM, DM, (bf16_t*)(P.ws + WS_WOUT), scr, it, 64, lane);
}
constexpr int SP = 272;
constexpr int L_BN = 0, L_CN = 128 * SP, L_BT = 2 * 128 * SP, L_XT = 3 * 128 * SP, L_DT = L_XT + 64 * SP, L_CSV = L_DT + 512, L_DA = L_CSV + 512;
static_assert(L_DA + 512 <= RING_BYTES, "ssd lds");
static_assert(VAN_OFF + 512 * 16 <= BIAS_OFF && BIAS_OFF + 2048 <= LDS_BYTES, "lds map");
__device__ __forceinline__ int crow16(int r, int hi) { return (r & 3) + 8 * (r >> 2) + 4 * hi; }
template <bool SWA, bool SWB>
__device__ __forceinline__ f32x16 mm32_k128(const LAS unsigned char* As, int m0, const LAS unsigned char* Bs, int n0, int r32, int hi) {
    f32x16 acc = f32x16{};
    const int ra = m0 + r32, rbw = n0 + r32, xa = SWA ? ((ra >> 3) & 15) : 0, xb = SWB ? ((rbw >> 3) & 15) : 0;
#pragma unroll
    for (int k0 = 0; k0 < 128; k0 += 16) {
        const int kc = (k0 >> 3) + hi;
        const bf16x8 a = *(const LAS bf16x8*)(As + ra * SP + ((kc ^ xa) << 4));
        const bf16x8 b = *(const LAS bf16x8*)(Bs + rbw * SP + ((kc ^ xb) << 4));
        acc = __builtin_amdgcn_mfma_f32_32x32x16_bf16(a, b, acc, 0, 0, 0);
    }
    return acc;
}
constexpr int LA_BN = 0, LA_CN = 128 * SP, LA_BT = 2 * 128 * SP, LA_XT1 = LA_CN, LA_XT2 = LA_CN + 64 * SP, LA_DT = 3 * 128 * SP, LA_CSV = LA_DT + 2048, LA_TMP = LA_CSV + 2048;
static_assert(LA_TMP + 64 <= RING_BYTES, "ssd-a lds");
__device__ __forceinline__ void ssd_a_unit(const Ptrs& P, LAS unsigned char* lds, int b, int c, int g, int hh) {
    int tid = threadIdx.x; asm volatile("" : "+v"(tid));
    const int lane = tid & 63, wid = __builtin_amdgcn_readfirstlane(tid >> 6), r32 = lane & 31, hi = lane >> 5;
    unsigned char* ws = P.ws;
    const bf16_t* proj = (const bf16_t*)(ws + WS_PROJ);
    const float* dtraw = (const float*)(ws + WS_DTRAW);
    float* CS = (float*)(ws + WS_CS);
    const float* conv_w = P.in[9]; const float* conv_b = P.in[10];
    bf16_t* XCONV = (bf16_t*)(ws + WS_XCONV); bf16_t* CCONV = (bf16_t*)(ws + WS_CCONV);
    const int row0 = b * SEQ + c * 128, h0 = g * 8 + hh * 4;
    LAS float* sDT = (LAS float*)(lds + LA_DT); LAS float* sCS = (LAS float*)(lds + LA_CSV); LAS float* sTMP = (LAS float*)(lds + LA_TMP);
    const int hq = wid >> 1, stp = tid & 127;
    const float raw_q = dtraw[(size_t)(row0 + stp) * 16 + h0 + hq];
    if (tid < 384) {
        const int rb = tid >> 5, grp = tid & 31;
        const int ch = grp < 16 ? 1024 + g * 128 + 8 * grp : 1280 + g * 128 + 8 * (grp - 16);
        const int l0 = rb * 11, nrow = (l0 + 11 <= 128) ? 11 : 128 - l0;
        u32x4 v[14];
#pragma unroll
        for (int j = 0; j < 14; ++j) {
            const int ls = c * 128 + l0 - 3 + j;
            v[j] = (ls >= 0 && j < nrow + 3) ? *(const u32x4*)(proj + (size_t)(b * SEQ + ls) * NPROJP + C_XBC + ch) : (u32x4){0u, 0u, 0u, 0u};
        }
        f32x4 w[4][2];
#pragma unroll
        for (int j = 0; j < 4; ++j) { w[j][0] = *(const f32x4*)(conv_w + j * 1536 + ch); w[j][1] = *(const f32x4*)(conv_w + j * 1536 + ch + 4); }
        const f32x4 cb0 = *(const f32x4*)(conv_b + ch), cb1 = *(const f32x4*)(conv_b + ch + 4);
#pragma unroll
        for (int r = 0; r < 11; ++r) {
            if (r < nrow) {
                const int l = l0 + r;
                float a[8] = {cb0.x, cb0.y, cb0.z, cb0.w, cb1.x, cb1.y, cb1.z, cb1.w};
#pragma unroll
                for (int j = 0; j < 4; ++j) {
                    const u32x4 x = v[r + j];
                    a[0] += w[j][0].x * bf_lo(x.x); a[1] += w[j][0].y * bf_hi(x.x); a[2] += w[j][0].z * bf_lo(x.y); a[3] += w[j][0].w * bf_hi(x.y);
                    a[4] += w[j][1].x * bf_lo(x.z); a[5] += w[j][1].y * bf_hi(x.z); a[6] += w[j][1].z * bf_lo(x.w); a[7] += w[j][1].w * bf_hi(x.w);
                }
#pragma unroll
                for (int q = 0; q < 8; ++q) a[q] = a[q] * sigmoidf_(a[q]);
                u32x4 pk; pk.x = cvt_pk_bf16(a[0], a[1]); pk.y = cvt_pk_bf16(a[2], a[3]); pk.z = cvt_pk_bf16(a[4], a[5]); pk.w = cvt_pk_bf16(a[6], a[7]);
                if (grp < 16) {
                    const int n0 = 8 * grp;
                    *(LAS u32x4*)(lds + LA_BN + l * SP + n0 * 2) = pk;
                    const unsigned tb = (unsigned)(LA_BT + n0 * SP + (((l >> 3) ^ grp) << 4) + (l & 7) * 2);
                    *(LAS bf16_t*)(lds + tb + 0 * SP) = (bf16_t)(pk.x & 0xffffu); *(LAS bf16_t*)(lds + tb + 1 * SP) = (bf16_t)(pk.x >> 16);
                    *(LAS bf16_t*)(lds + tb + 2 * SP) = (bf16_t)(pk.y & 0xffffu); *(LAS bf16_t*)(lds + tb + 3 * SP) = (bf16_t)(pk.y >> 16);
                    *(LAS bf16_t*)(lds + tb + 4 * SP) = (bf16_t)(pk.z & 0xffffu); *(LAS bf16_t*)(lds + tb + 5 * SP) = (bf16_t)(pk.z >> 16);
                    *(LAS bf16_t*)(lds + tb + 6 * SP) = (bf16_t)(pk.w & 0xffffu); *(LAS bf16_t*)(lds + tb + 7 * SP) = (bf16_t)(pk.w >> 16);
                } else {
                    const int n0 = 8 * (grp - 16);
                    *(LAS u32x4*)(lds + LA_CN + l * SP + n0 * 2) = pk;
                    if (hh == 0) *(u32x4*)(CCONV + (size_t)(row0 + l) * 256 + g * 128 + n0) = pk;
                }
            }
        }
    }
    __syncthreads();
    f32x16 cbt[2];
#pragma unroll
    for (int q = 0; q < 2; ++q) { const int t = wid * 2 + q, mi = t >> 2, ni = t & 3; cbt[q] = mm32_k128<false, false>(lds + LA_CN, 32 * mi, lds + LA_BN, 32 * ni, r32, hi); }
    {
        const int h = h0 + hq;
        const float raw = raw_q + P.in[11][h];
        const float dtv = raw > 20.f ? raw : log1pf(expf(raw));
        float s_ = dtv * (-expf(P.in[12][h]));
#pragma unroll
        for (int o = 1; o < 64; o <<= 1) { const float t = __shfl_up(s_, o); if (lane >= o) s_ += t; }
        if ((tid & 127) == 63) sTMP[hq] = s_;
        __syncthreads();
        if (tid & 64) s_ += sTMP[hq];
        sDT[hq * 128 + stp] = dtv; sCS[hq * 128 + stp] = s_; CS[(size_t)(row0 + stp) * 16 + h] = s_;
        __syncthreads();
    }
#pragma unroll 1
    for (int i = 0; i < 4; ++i) {
        const int h = h0 + i;
        const int l2 = tid >> 3, grp = tid & 7, chx = h * 64 + 8 * grp, lx = 2 * l2;
        u32x4 xv[5];
#pragma unroll
        for (int j = 0; j < 5; ++j) { const int ls = c * 128 + lx - 3 + j; xv[j] = (ls >= 0) ? *(const u32x4*)(proj + (size_t)(b * SEQ + ls) * NPROJP + C_XBC + chx) : (u32x4){0u, 0u, 0u, 0u}; }
        LAS float* sDTh = sDT + i * 128; LAS float* sCSh = sCS + i * 128;
        const float cs_last = sCSh[127];
        {
            f32x4 w[4][2];
#pragma unroll
            for (int j = 0; j < 4; ++j) { w[j][0] = *(const f32x4*)(conv_w + j * 1536 + chx); w[j][1] = *(const f32x4*)(conv_w + j * 1536 + chx + 4); }
            const f32x4 cb0 = *(const f32x4*)(conv_b + chx), cb1 = *(const f32x4*)(conv_b + chx + 4);
#pragma unroll
            for (int r = 0; r < 2; ++r) {
                const int l = lx + r;
                float a[8] = {cb0.x, cb0.y, cb0.z, cb0.w, cb1.x, cb1.y, cb1.z, cb1.w};
#pragma unroll
                for (int j = 0; j < 4; ++j) {
                    const u32x4 x = xv[r + j];
                    a[0] += w[j][0].x * bf_lo(x.x); a[1] += w[j][0].y * bf_hi(x.x); a[2] += w[j][0].z * bf_lo(x.y); a[3] += w[j][0].w * bf_hi(x.y);
                    a[4] += w[j][1].x * bf_lo(x.z); a[5] += w[j][1].y * bf_hi(x.z); a[6] += w[j][1].z * bf_lo(x.w); a[7] += w[j][1].w * bf_hi(x.w);
                }
#pragma unroll
                for (int q = 0; q < 8; ++q) a[q] = a[q] * sigmoidf_(a[q]);
                u32x4 pk; pk.x = cvt_pk_bf16(a[0], a[1]); pk.y = cvt_pk_bf16(a[2], a[3]); pk.z = cvt_pk_bf16(a[4], a[5]); pk.w = cvt_pk_bf16(a[6], a[7]);
                *(u32x4*)(XCONV + (size_t)(row0 + l) * 1024 + chx) = pk;
                const float dt = sDTh[l], dw = dt * fexp(cs_last - sCSh[l]);
                const unsigned tb = (unsigned)((8 * grp) * SP + (((l >> 3) ^ grp) << 4) + (l & 7) * 2);
#pragma unroll
                for (int q = 0; q < 8; q += 2) {
                    const unsigned p1 = cvt_pk_bf16(a[q] * dt, a[q + 1] * dt), p2 = cvt_pk_bf16(a[q] * dw, a[q + 1] * dw);
                    *(LAS bf16_t*)(lds + LA_XT1 + tb + q * SP) = (bf16_t)(p1 & 0xffffu); *(LAS bf16_t*)(lds + LA_XT1 + tb + (q + 1) * SP) = (bf16_t)(p1 >> 16);
                    *(LAS bf16_t*)(lds + LA_XT2 + tb + q * SP) = (bf16_t)(p2 & 0xffffu); *(LAS bf16_t*)(lds + LA_XT2 + tb + (q + 1) * SP) = (bf16_t)(p2 >> 16);
                }
            }
        }
#pragma unroll
        for (int q = 0; q < 2; ++q) {
            const int t = wid * 2 + q, mi = t >> 2, ni = t & 3; const int s_ = 32 * ni + r32; const float css = sCSh[s_];
#pragma unroll
            for (int r = 0; r < 16; ++r) { const int l = 32 * mi + crow16(r, hi); const float m = (s_ <= l) ? cbt[q][r] * fexp(sCSh[l] - css) : 0.f; *(LAS bf16_t*)(lds + LA_BN + l * SP + s_ * 2) = f2bf(m); }
        }
        __syncthreads();
        {
            const int mi = wid >> 2, ni = wid & 3;
            const f32x16 acc = mm32_k128<true, true>(lds + LA_XT2, 32 * mi, lds + LA_BT, 32 * ni, r32, hi);
            bf16_t* st = (bf16_t*)(ws + WS_STATES) + ((size_t)((b * 16 + c) * 16 + h)) * 8192;
#pragma unroll
            for (int r = 0; r < 16; ++r) st[(32 * mi + crow16(r, hi)) * 128 + 32 * ni + r32] = f2bf(acc[r]);
        }
        {
            const int mi = wid >> 1, ni = wid & 1;
            const f32x16 acc = mm32_k128<false, true>(lds + LA_BN, 32 * mi, lds + LA_XT1, 32 * ni, r32, hi);
            bf16_t* yd = (bf16_t*)(ws + WS_YDIAG);
#pragma unroll
            for (int r = 0; r < 16; ++r) yd[(size_t)(row0 + 32 * mi + crow16(r, hi)) * 1024 + h * 64 + 32 * ni + r32] = f2bf(acc[r]);
        }
        __syncthreads();
    }
}
__device__ __forceinline__ void ssd_scan(const Ptrs& P, int gtid, int nthr) {
    const bf16_t* st = (const bf16_t*)(P.ws + WS_STATES); const float* CS = (const float*)(P.ws + WS_CS); bf16_t* stin = (bf16_t*)(P.ws + WS_STIN);
    for (int e4 = gtid; e4 < NB * 16 * 2048; e4 += nthr) {
        const int bh = e4 >> 11, off = e4 & 2047, b = bh >> 4, h = bh & 15;
        f32x4 sv[16]; float dec[16];
#pragma unroll
        for (int c = 0; c < 16; ++c) { const u32x2 w_ = *((const u32x2*)(st + ((size_t)((b * 16 + c) * 16 + h)) * 8192) + off); sv[c] = (f32x4){bf_lo(w_.x), bf_hi(w_.x), bf_lo(w_.y), bf_hi(w_.y)}; dec[c] = CS[(size_t)(b * SEQ + c * 128 + 127) * 16 + h]; }
        f32x4 carry = (f32x4){0.f, 0.f, 0.f, 0.f};
#pragma unroll
        for (int c = 0; c < 16; ++c) {
            { u32x2 pk; pk.x = cvt_pk_bf16(carry.x, carry.y); pk.y = cvt_pk_bf16(carry.z, carry.w); *((u32x2*)(stin + ((size_t)((b * 16 + c) * 16 + h)) * 8192) + off) = pk; }
            carry = carry * fexp(dec[c]) + sv[c];
        }
    }
}
constexpr int L2_CS = 0, L2_PV = 64 * SP, L2_Y = L2_PV + 2 * 64 * SP, YP = 1040;
static_assert(L2_Y + 64 * YP <= RING_BYTES, "ssd-c lds");
__device__ __forceinline__ void ssd_c_unit(const Ptrs& P, LAS unsigned char* lds, int b, int c, int g, int rh) {
    int tid = threadIdx.x; asm volatile("" : "+v"(tid));
    const int lane = tid & 63, wid = __builtin_amdgcn_readfirstlane(tid >> 6), r32 = lane & 31, hi = lane >> 5;
    unsigned char* ws = P.ws;
    const int row0 = b * SEQ + c * 128 + rh * 64;
    const bf16_t* CCONV = (const bf16_t*)(ws + WS_CCONV); const bf16_t* XCONV = (const bf16_t*)(ws + WS_XCONV); const bf16_t* proj = (const bf16_t*)(ws + WS_PROJ);
    const bf16_t* stin = (const bf16_t*)(ws + WS_STIN); const float* CS = (const float*)(ws + WS_CS); const bf16_t* yd = (const bf16_t*)(ws + WS_YDIAG);
    bf16_t* CAT = (bf16_t*)(ws + WS_CAT);
    for (int q = tid; q < 64 * 16; q += 512) { const int l = q >> 4, n8 = q & 15; *(LAS u32x4*)(lds + L2_CS + l * SP + n8 * 16) = *(const u32x4*)(CCONV + (size_t)(row0 + l) * 256 + g * 128 + n8 * 8); }
    const int hw = wid >> 2, tile = wid & 3, mi = tile >> 1, ni = tile & 1;
    for (int hp = 0; hp < 4; ++hp) {
        __syncthreads();
        const int h0 = g * 8 + 2 * hp;
        const int h = h0 + hw;
        const unsigned rowA = (unsigned)(row0 + 32 * mi + 4 * hi), col = (unsigned)(h * 64 + 32 * ni + r32);
        float e_cs[16]; bf16_t e_yd[16], e_xc[16], e_z[16];
#pragma unroll
        for (int r = 0; r < 16; ++r) { const unsigned row = rowA + 8 * (r >> 2) + (r & 3);
            e_yd[r] = yd[row * 1024u + col]; e_cs[r] = CS[row * 16u + (unsigned)h]; e_xc[r] = XCONV[row * 1024u + col]; e_z[r] = proj[row * (unsigned)NPROJP + (unsigned)C_Z + col]; }
#pragma unroll
        for (int q = 0; q < 4; ++q) {
            const int idx = tid + 512 * q, hh = idx >> 10, rem = idx & 1023, p = rem >> 4, n8 = rem & 15;
            const u32x4 pk = *(const u32x4*)(stin + ((size_t)((b * 16 + c) * 16 + h0 + hh)) * 8192 + p * 128 + n8 * 8);
            *(LAS u32x4*)(lds + L2_PV + (hh * 64 + p) * SP + n8 * 16) = pk;
        }
        __syncthreads();
        const f32x16 acc = mm32_k128<false, false>(lds + L2_CS, 32 * mi, lds + L2_PV + hw * 64 * SP, 32 * ni, r32, hi);
        const float dsk = P.in[13][h];
        const unsigned ybase = (unsigned)(L2_Y + (32 * mi + 4 * hi) * YP + ((2 * hp + hw) * 64 + 32 * ni + r32) * 2);
#pragma unroll
        for (int r = 0; r < 16; ++r) {
            float y = acc[r] * fexp(e_cs[r]) + bf2f(e_yd[r]) + dsk * bf2f(e_xc[r]);
            const float z = bf2f(e_z[r]);
            y *= z * sigmoidf_(z);
            *(LAS bf16_t*)(lds + ybase + (8 * (r >> 2) + (r & 3)) * YP) = f2bf(y);
        }
    }
    __syncthreads();
    const float* nw = P.in[14] + g * 512 + 8 * lane;
    const f32x4 nw0 = *(const f32x4*)nw, nw1 = *(const f32x4*)(nw + 4);
    for (int i = 0; i < 8; ++i) {
        const int ll = wid * 8 + i;
        const u32x4 v = *(const LAS u32x4*)(lds + L2_Y + ll * YP + lane * 16);
        float a[8] = {bf_lo(v.x), bf_hi(v.x), bf_lo(v.y), bf_hi(v.y), bf_lo(v.z), bf_hi(v.z), bf_lo(v.w), bf_hi(v.w)};
        float ss = 0.f;
#pragma unroll
        for (int k = 0; k < 8; ++k) ss += a[k] * a[k];
        const float rstd = rsqrtf_(wave_sum(ss) * (1.f / 512.f) + EPS);
        u32x4 o; o.x = cvt_pk_bf16(a[0] * rstd * nw0.x, a[1] * rstd * nw0.y); o.y = cvt_pk_bf16(a[2] * rstd * nw0.z, a[3] * rstd * nw0.w);
        o.z = cvt_pk_bf16(a[4] * rstd * nw1.x, a[5] * rstd * nw1.y); o.w = cvt_pk_bf16(a[6] * rstd * nw1.z, a[7] * rstd * nw1.w);
        *(u32x4*)(CAT + (size_t)(row0 + ll) * DM + 1024 + g * 512 + 8 * lane) = o;
    }
    __syncthreads();
}
__device__ __forceinline__ void attn_post(const Ptrs& P, int gw, int NGW) {
    int tq_ = threadIdx.x; asm volatile("" : "+v"(tq_)); const int lane = tq_ & 63;
    float d1 = 0.f, d2 = 0.f;
    for (int i = 0; i < 64; ++i) { d1 += P.in[4][i] * P.in[5][i]; d2 += P.in[6][i] * P.in[7][i]; }
    const float lam = expf(d1) - expf(d2) + LAM_INIT;
    const bf16_t* ATT = (const bf16_t*)(P.ws + WS_ATT); bf16_t* CAT = (bf16_t*)(P.ws + WS_CAT);
    const float* sw = P.in[8] + (lane & 7) * 16;
    float swv[16];
#pragma unroll
    for (int i = 0; i < 16; ++i) swv[i] = sw[i] * (1.0f - LAM_INIT);
    for (int t0 = gw; t0 < NTOK; t0 += 4 * NGW) {
        u32x4 ld[4][4];
#pragma unroll
        for (int k = 0; k < 4; ++k) { const int t = t0 + k * NGW; if (t < NTOK) {
            const u32x4* p0 = (const u32x4*)(ATT + (size_t)t * 2048 + lane * 16); const u32x4* p1 = (const u32x4*)(ATT + (size_t)t * 2048 + 1024 + lane * 16);
            ld[k][0] = p0[0]; ld[k][1] = p0[1]; ld[k][2] = p1[0]; ld[k][3] = p1[1]; } }
#pragma unroll
        for (int k = 0; k < 4; ++k) { const int t = t0 + k * NGW; if (t < NTOK) {
            const u32x4 a0 = ld[k][0], a1 = ld[k][1], b0 = ld[k][2], b1 = ld[k][3];
            float a[16];
            a[0] = bf_lo(a0.x) - lam * bf_lo(b0.x); a[1] = bf_hi(a0.x) - lam * bf_hi(b0.x); a[2] = bf_lo(a0.y) - lam * bf_lo(b0.y); a[3] = bf_hi(a0.y) - lam * bf_hi(b0.y);
            a[4] = bf_lo(a0.z) - lam * bf_lo(b0.z); a[5] = bf_hi(a0.z) - lam * bf_hi(b0.z); a[6] = bf_lo(a0.w) - lam * bf_lo(b0.w); a[7] = bf_hi(a0.w) - lam * bf_hi(b0.w);
            a[8] = bf_lo(a1.x) - lam * bf_lo(b1.x); a[9] = bf_hi(a1.x) - lam * bf_hi(b1.x); a[10] = bf_lo(a1.y) - lam * bf_lo(b1.y); a[11] = bf_hi(a1.y) - lam * bf_hi(b1.y);
            a[12] = bf_lo(a1.z) - lam * bf_lo(b1.z); a[13] = bf_hi(a1.z) - lam * bf_hi(b1.z); a[14] = bf_lo(a1.w) - lam * bf_lo(b1.w); a[15] = bf_hi(a1.w) - lam * bf_hi(b1.w);
            float ss = 0.f;
#pragma unroll
            for (int i = 0; i < 16; ++i) ss += a[i] * a[i];
            ss += __shfl_xor(ss, 1); ss += __shfl_xor(ss, 2); ss += __shfl_xor(ss, 4);
            const float rstd = rsqrtf_(ss * (1.f / 128.f) + EPS);
            float o[16];
#pragma unroll
            for (int i = 0; i < 16; ++i) o[i] = a[i] * rstd * swv[i];
            u32x4 w0, w1;
            w0.x = cvt_pk_bf16(o[0], o[1]); w0.y = cvt_pk_bf16(o[2], o[3]); w0.z = cvt_pk_bf16(o[4], o[5]); w0.w = cvt_pk_bf16(o[6], o[7]);
            w1.x = cvt_pk_bf16(o[8], o[9]); w1.y = cvt_pk_bf16(o[10], o[11]); w1.z = cvt_pk_bf16(o[12], o[13]); w1.w = cvt_pk_bf16(o[14], o[15]);
            u32x4* op = (u32x4*)(CAT + (size_t)t * DM + lane * 16); op[0] = w0; op[1] = w1; } }
    }
}
constexpr int R_RED = 0, R_SSQ = 8 * 4096, R_LOG = R_SSQ + 8 * 128, R_RSTD = R_LOG + 4096;
__device__ __forceinline__ void router_tile(const Ptrs& P, LAS unsigned char* lds, int tile) {
    int tid = threadIdx.x; asm volatile("" : "+v"(tid));
    const int lane = tid & 63, wid = __builtin_amdgcn_readfirstlane(tid >> 6), tt = lane & 31, kk = lane >> 5;
    unsigned char* ws = P.ws;
    const bf16_t* X1 = (const bf16_t*)(ws + WS_X1); bf16_t* H2 = (bf16_t*)(ws + WS_H2);
    const float* nw = P.in[16]; const float* rw = P.in[17]; const float* rb = P.in[18];
    int* TOPE = (int*)(ws + WS_ROUTE + RT_TOPE); float* TOPG = (float*)(ws + WS_ROUTE + RT_TOPG); int* LRANK = (int*)(ws + WS_ROUTE + RT_LRANK); int* HIST = (int*)(ws + WS_ROUTE + RT_HIST);
    LAS int* lhist = (LAS int*)(lds + LHIST_OFF);
    LAS float* red = (LAS float*)(lds + R_RED); LAS float* ssqp = (LAS float*)(lds + R_SSQ); LAS float* slog = (LAS float*)(lds + R_LOG); LAS float* srstd = (LAS float*)(lds + R_RSTD);
    const int t0 = tile * 32;
    if (tid < 32) lhist[tid] = 0;
    {
        f32x16 acc = f32x16{}; float ssq = 0.f;
        const int r32 = tt, hi = kk;
        const bf16_t* xp = X1 + (size_t)(t0 + r32) * DM + wid * 256 + 8 * hi;
        const float* wp = rw + (size_t)(wid * 256 + 8 * hi) * 32 + r32;
        const float* np = nw + wid * 256 + 8 * hi;
#pragma unroll 4
        for (int i = 0; i < 16; ++i) {
            const u32x4 xa = *(const u32x4*)(xp + 16 * i);
            const f32x4 n0 = *(const f32x4*)(np + 16 * i), n1 = *(const f32x4*)(np + 16 * i + 4);
            float w[8];
#pragma unroll
            for (int jx = 0; jx < 8; ++jx) w[jx] = wp[(16 * i + jx) * 32];
            w[0] *= n0.x; w[1] *= n0.y; w[2] *= n0.z; w[3] *= n0.w; w[4] *= n1.x; w[5] *= n1.y; w[6] *= n1.z; w[7] *= n1.w;
            u32x4 wh, wl;
            wh.x = cvt_pk_bf16(w[0], w[1]); wh.y = cvt_pk_bf16(w[2], w[3]); wh.z = cvt_pk_bf16(w[4], w[5]); wh.w = cvt_pk_bf16(w[6], w[7]);
            wl.x = cvt_pk_bf16(w[0] - bf_lo(wh.x), w[1] - bf_hi(wh.x)); wl.y = cvt_pk_bf16(w[2] - bf_lo(wh.y), w[3] - bf_hi(wh.y));
            wl.z = cvt_pk_bf16(w[4] - bf_lo(wh.z), w[5] - bf_hi(wh.z)); wl.w = cvt_pk_bf16(w[6] - bf_lo(wh.w), w[7] - bf_hi(wh.w));
            const bf16x8 af = __builtin_bit_cast(bf16x8, xa);
            acc = __builtin_amdgcn_mfma_f32_32x32x16_bf16(af, __builtin_bit_cast(bf16x8, wh), acc, 0, 0, 0);
            acc = __builtin_amdgcn_mfma_f32_32x32x16_bf16(af, __builtin_bit_cast(bf16x8, wl), acc, 0, 0, 0);
            const float x0 = bf_lo(xa.x), x1 = bf_hi(xa.x), x2 = bf_lo(xa.y), x3 = bf_hi(xa.y), x4 = bf_lo(xa.z), x5 = bf_hi(xa.z), x6 = bf_lo(xa.w), x7 = bf_hi(xa.w);
            ssq += ((x0 * x0 + x1 * x1) + (x2 * x2 + x3 * x3)) + ((x4 * x4 + x5 * x5) + (x6 * x6 + x7 * x7));
        }
        ssq += __shfl_xor(ssq, 32);
        if (kk == 0) ssqp[wid * 32 + tt] = ssq;
#pragma unroll
        for (int r = 0; r < 16; ++r) red[wid * 1024 + crow16(r, kk) * 32 + tt] = acc[r];
    }
    u32x2 xb[4][8]; f32x4 wv[8];
#pragma unroll
    for (int q = 0; q < 8; ++q) wv[q] = ((const f32x4*)nw)[lane + 64 * q];
#pragma unroll
    for (int r = 0; r < 4; ++r)
#pragma unroll
        for (int q = 0; q < 8; ++q) xb[r][q] = ((const u32x2*)(X1 + (size_t)(t0 + wid * 4 + r) * DM))[lane + 64 * q];
    __syncthreads();
    if (tid < 32) { float s = 0.f;
#pragma unroll
        for (int w = 0; w < 8; ++w) s += ssqp[w * 32 + tid];
        srstd[tid] = rsqrtf_(s * (1.f / DM) + EPS); }
    __syncthreads();
    for (int q = tid; q < 1024; q += 512) { float s = 0.f;
#pragma unroll
        for (int w = 0; w < 8; ++w) s += red[w * 1024 + q];
        slog[q] = s * srstd[q >> 5] + rb[q & 31]; }
    __syncthreads();
#pragma unroll
    for (int it = 0; it < 2; ++it) {
        const int tl = wid * 4 + it * 2 + kk, t = t0 + tl;
        float v = slog[tl * 32 + tt];
        float tv[4]; int te[4];
#pragma unroll
        for (int j = 0; j < 4; ++j) {
            float bv = v; int be = tt;
#pragma unroll
            for (int o = 1; o < 32; o <<= 1) { const float ov = __shfl_xor(bv, o); const int oe = __shfl_xor(be, o); const bool take = (ov > bv) || (ov == bv && oe < be); bv = take ? ov : bv; be = take ? oe : be; }
            tv[j] = bv; te[j] = be; if (tt == be) v = -INFINITY;
        }
        const float e1 = fexp(tv[1] - tv[0]), e2 = fexp(tv[2] - tv[0]), e3 = fexp(tv[3] - tv[0]); const float inv = 1.f / (1.f + e1 + e2 + e3);
        if (tt < 4) {
            const int ej = tt == 0 ? te[0] : tt == 1 ? te[1] : tt == 2 ? te[2] : te[3];
            const float gj = (tt == 0 ? 1.f : tt == 1 ? e1 : tt == 2 ? e2 : e3) * inv;
            const int lr = atomicAdd((int*)(lhist + ej), 1);
            TOPE[t * 4 + tt] = ej; TOPG[t * 4 + tt] = gj; LRANK[t * 4 + tt] = lr;
        }
    }
    {
#pragma unroll
        for (int r = 0; r < 4; ++r) {
            const int tl = wid * 4 + r; const float rs = srstd[tl];
            u32x2* o8 = (u32x2*)(H2 + (size_t)(t0 + tl) * DM) + lane;
#pragma unroll
            for (int q = 0; q < 8; ++q) { const f32x4 x = (f32x4){bf_lo(xb[r][q].x), bf_hi(xb[r][q].x), bf_lo(xb[r][q].y), bf_hi(xb[r][q].y)}; u32x2 o; o.x = cvt_pk_bf16(x.x * rs * wv[q].x, x.y * rs * wv[q].y); o.y = cvt_pk_bf16(x.z * rs * wv[q].z, x.w * rs * wv[q].w); o8[64 * q] = o; }
        }
    }
    __syncthreads();
    if (tid < 32) HIST[tile * 32 + tid] = lhist[tid];
    __syncthreads();
}
__device__ __forceinline__ void route_positions(const Ptrs& P, LAS unsigned char* lds, int tile) {
    unsigned char* ws = P.ws; const int tid = threadIdx.x;
    const int* HIST = (const int*)(ws + WS_ROUTE + RT_HIST); const int* TOPE = (const int*)(ws + WS_ROUTE + RT_TOPE); const int* LRANK = (const int*)(ws + WS_ROUTE + RT_LRANK);
    int* TOKPOS = (int*)(ws + WS_ROUTE + RT_TOKPOS); int* META = (int*)(ws + WS_ROUTE + RT_META); int* ROWTOK = (int*)(ws + WS_ROUTE + RT_ROWTOK);
    LAS int* sh = (LAS int*)lds;
    LAS int* stot = sh + 8192; LAS int* sbase = stot + 32; LAS int* sseg = sbase + 32;
    int e_pre = 0, lr_pre = 0; if (tid < 128) { e_pre = TOPE[(tile * 32 + (tid >> 2)) * 4 + (tid & 3)]; lr_pre = LRANK[(tile * 32 + (tid >> 2)) * 4 + (tid & 3)]; }
    __syncthreads();
    for (int i = tid; i < 8192; i += 512) sh[i] = HIST[i];
    __syncthreads();
    if (tid < 32) { int tot = 0, base = 0; for (int i = 0; i < 256; ++i) { const int v = sh[i * 32 + tid]; if (i < tile) base += v; tot += v; } stot[tid] = tot; sbase[tid] = base; }
    __syncthreads();
    if (tid == 0) { int s = 0; for (int e = 0; e < 32; ++e) { sseg[e] = s; s += (stot[e] + 255) & ~255; } sseg[32] = s; }
    __syncthreads();
    if (tid < 128) { const int t = tile * 32 + (tid >> 2), j = tid & 3; const int e = e_pre; const int pos = sseg[e] + sbase[e] + lr_pre; ROWTOK[pos] = t; TOKPOS[t * 4 + j] = pos; }
    if (tile < 32) { const int e = tile; for (int p = stot[e] + tid; p < ((stot[e] + 255) & ~255); p += 512) ROWTOK[sseg[e] + p] = ZROW; }
    if (tile == 32) for (int i = tid; i < 1024; i += 512) ((unsigned*)(ws + WS_ZROW))[i] = 0u;
    if (tile == 0) {
        if (tid < 33) META[META_SEG + tid] = sseg[tid];
        if (tid == 0) META[META_NT] = sseg[32] >> 8;
        if (tid < 32) { const int e = tid, first = sseg[e] >> 8, ne = (sseg[e + 1] >> 8) - first; for (int T = first; T < first + ne; ++T) META[META_TILE_E + T] = e | (first << 5) | (ne << 13) | ((stot[e] - (ne - 1) * 256 - 1) << 21); }
    }
    __syncthreads();
}
__device__ __forceinline__ void final_rows(const Ptrs& P, int gw, int NGW) {
    int tq_ = threadIdx.x; asm volatile("" : "+v"(tq_)); const int lane = tq_ & 63;
    unsigned char* ws = P.ws;
    const bf16_t* X1 = (const bf16_t*)(ws + WS_X1); const bf16_t* YS = (const bf16_t*)(ws + WS_YS);
    const int* TOKPOS = (const int*)(ws + WS_ROUTE + RT_TOKPOS); const float* TOPG = (const float*)(ws + WS_ROUTE + RT_TOPG);
    const float* nw = P.in[23];
    f32x4 nwv[8];
#pragma unroll
    for (int q = 0; q < 8; ++q) nwv[q] = ((const f32x4*)nw)[lane + 64 * q];
    for (int t = gw; t < NTOK; t += NGW) {
        f32x4 v[8];
#pragma unroll
        for (int q = 0; q < 8; ++q) { const u32x2 xb = ((const u32x2*)(X1 + (size_t)t * DM))[lane + 64 * q]; v[q] = (f32x4){bf_lo(xb.x), bf_hi(xb.x), bf_lo(xb.y), bf_hi(xb.y)}; }
#pragma unroll
        for (int j = 0; j < 4; ++j) {
            const int pos = TOKPOS[t * 4 + j]; const float gj = TOPG[t * 4 + j];
            const u32x2* yr = (const u32x2*)(YS + (size_t)pos * DM);
#pragma unroll
            for (int q = 0; q < 8; ++q) { const u32x2 y = yr[lane + 64 * q]; v[q].x += gj * bf_lo(y.x); v[q].y += gj * bf_hi(y.x); v[q].z += gj * bf_lo(y.y); v[q].w += gj * bf_hi(y.y); }
        }
        float s = 0.f;
#pragma unroll
        for (int q = 0; q < 8; ++q) s += (v[q].x * v[q].x + v[q].y * v[q].y) + (v[q].z * v[q].z + v[q].w * v[q].w);
        const float rstd = 1.0f / sqrtf(wave_sum(s) * (1.f / DM) + EPS);
#pragma unroll
        for (int q = 0; q < 8; ++q) ((f32x4*)(P.out + (size_t)t * DM))[lane + 64 * q] = v[q] * rstd * nwv[q];
    }
}

constexpr int NPHASE = 12;
struct Args { Ptrs p; int ph_lo, ph_hi; };
__global__ void __launch_bounds__(NWAVES * 64, 2) hybrid_fwd(Args args) {
    extern __shared__ __attribute__((aligned(16))) unsigned char lds_raw[];
    LAS unsigned char* lds = (LAS unsigned char*)lds_raw;
    const int tid = threadIdx.x, wave = __builtin_amdgcn_readfirstlane(tid >> 6);
    const int G = gridDim.x; const int bx = blockIdx.x; const int vcu = (G % 8 == 0) ? (bx % 8) * (G / 8) + bx / 8 : bx;
    const Ptrs& P = args.p; unsigned char* ws = P.ws;
    unsigned* ctl = (unsigned*)(ws + WS_CTL);
    for (int u = tid; u < (LDS_BYTES - LDSCTL_OFF) / 4; u += NWAVES * 64) ((LAS unsigned*)(lds + LDSCTL_OFF))[u] = 0u;
    __syncthreads();
    volatile LAS unsigned* MISC = (volatile LAS unsigned*)(lds + MISC_OFF);
    XcdBarrier bar; bar.bar = ctl + CW_BAR; bar.x = 0; bar.st = nullptr;
    if (MK_N_LAUNCHES == 1) bar = xcd_barrier_post(ctl + CW_BAR, MISC + 8);
#define GRID_BAR() do { if (MK_N_LAUNCHES == 1) xcd_barrier(bar); } while (0)
    const int lo = args.ph_lo, hi_ = args.ph_hi;
#ifndef PHASE_MASK
#define PHASE_MASK 0xFFFF
#endif
#define IN(k) (((PHASE_MASK >> (k)) & 1) && lo <= (k) && (k) < hi_)
#define BOTH(k) (IN(k) && IN((k) + 1))
    const int gw = vcu * NWAVES + wave, NGW = G * NWAVES;

    if (IN(0)) { p0_prologue(P, lds, gw, NGW, wave); if (BOTH(0)) GRID_BAR(); }
    if (IN(1)) {
        pg8::SchedDense S; S.init(ws + WS_XN, ws + WS_WIN, NTOK, NPROJP, G, bx);
        pg8::EpiProj E{(bf16_t*)(ws + WS_PROJ), (float*)(ws + WS_DTRAW), (const float*)(ws + WS_ROPE)};
        pg8::gemm_phase<pg8::EpiProj, pg8::SchedDense>(lds, S, E);
        { const int nu = S.nwg, full = nu / G, rem = nu - full * G;
          __syncthreads();
          if (rem == 0) wout_tail(P, lds, bx, G, wave); else if (bx >= rem) wout_tail(P, lds, bx - rem, G - rem, wave); }
        if (BOTH(1)) GRID_BAR();
    }
    if (IN(2)) {
        attn_body::attn_phase128((char*)lds_raw, (const bf16_t*)(ws + WS_PROJ), (bf16_t*)(ws + WS_ATT), G, vcu);
        __syncthreads();
    }
    if (IN(11)) {
        for (int u = vcu; u < NB * 16 * 2 * 2; u += G) { const int hh = u & 1, g = (u >> 1) & 1, c = (u >> 2) & 15, b = u >> 6; ssd_a_unit(P, lds, b, c, g, hh); }
        GRID_BAR();
    }
    if (IN(3)) { ssd_scan(P, vcu * 512 + tid, G * 512); if (BOTH(3)) GRID_BAR(); }
    if (IN(4)) {
#ifndef NO_SSDC
        for (int u = vcu; u < NB * 16 * 2 * 2; u += G) { const int rh = u & 1, g = (u >> 1) & 1, c = (u >> 2) & 15, b = u >> 6; ssd_c_unit(P, lds, b, c, g, rh); }
#endif
#ifndef NO_APOST
        attn_post(P, gw, NGW);
#endif
        if (BOTH(4)) GRID_BAR();
    }
    if (IN(5)) {
        pg8::SchedDense S; S.init(ws + WS_CAT, ws + WS_WOUT, NTOK, DM, G, bx);
        pg8::EpiRes E{P.in[0], (bf16_t*)(ws + WS_X1), DM};
        pg8::gemm_phase<pg8::EpiRes, pg8::SchedDense>(lds, S, E);
        if (BOTH(5)) GRID_BAR();
    }
    if (IN(6)) { for (int tile = vcu; tile < 256; tile += G) router_tile(P, lds, tile); if (BOTH(6)) GRID_BAR(); }
    if (IN(7)) { for (int tile = vcu; tile < 256; tile += G) route_positions(P, lds, tile); if (BOTH(7)) GRID_BAR(); }
    if (IN(8)) {
        const int* META = (const int*)(ws + WS_ROUTE + RT_META);
        typedef pg8::SchedMoeF<4096, 8192, true> SG;
        SG S; S.A = (const char*)(ws + WS_H2); S.W = P.in[19]; S.tile_e = META + META_TILE_E; S.rowtok = (const int*)(ws + WS_ROUTE + RT_ROWTOK);
        S.nT = META[META_NT]; S.nN = 16; S.G = G; S.c = vcu;
        pg8::EpiGate E{(bf16_t*)(ws + WS_ACT), P.in[20], ctl + CW_TCNT};
        pg8::gemm_phase_fb<pg8::EpiGate, SG, 4096, 8192, true>(lds, S, E);
        if (MK_N_LAUNCHES != 1 && BOTH(8)) GRID_BAR();
    }
    if (IN(9)) {
        const int* META = (const int*)(ws + WS_ROUTE + RT_META);
        typedef pg8::SchedMoeF<2048, 512, false> SD;
        SD S; S.A = (const char*)(ws + WS_ACT); S.W = P.in[21]; S.tile_e = META + META_TILE_E; S.rowtok = nullptr;
        S.nT = META[META_NT]; S.nN = 8; S.G = G;
        { const int r8 = ((S.nT * 16) % G) & ~31; S.c = (MK_N_LAUNCHES == 1) ? (vcu - r8 + G) % G : vcu; }
        pg8::EpiDown E{(bf16_t*)(ws + WS_YS), P.in[22]};
        pg8::gemm_phase_fb<pg8::EpiDown, SD, 2048, 512, false, MK_N_LAUNCHES == 1>(lds, S, E, ctl + CW_TCNT, 128u);
        if (BOTH(9)) GRID_BAR();
    }
    if (IN(10)) { final_rows(P, gw, NGW); }
#undef IN
#undef BOTH
#undef GRID_BAR
}

extern "C" void kernel_launch(void* const* d_in, const int* in_sizes, int n_in, void* d_out, int out_size, void* d_ws, size_t ws_size, hipStream_t stream) {
    static int grid = 0;
    if (grid == 0) {
        if (n_in != 24 || out_size != NTOK * DM || ws_size < WS_END) { fprintf(stderr, "kernel_launch: unexpected shapes (n_in %d, out %d, ws %zu)\n", n_in, out_size, ws_size); grid = -1; return; }
        int dev = 0, cus = 0, per_cu = 0;
        if (hipGetDevice(&dev) != hipSuccess || hipDeviceGetAttribute(&cus, hipDeviceAttributeMultiprocessorCount, dev) != hipSuccess) { grid = -1; return; }
        if (hipFuncSetAttribute((const void*)hybrid_fwd, hipFuncAttributeMaxDynamicSharedMemorySize, LDS_BYTES) != hipSuccess) { fprintf(stderr, "kernel_launch: hipFuncSetAttribute failed\n"); grid = -1; return; }
        if (hipOccupancyMaxActiveBlocksPerMultiprocessor(&per_cu, (const void*)hybrid_fwd, NWAVES * 64, LDS_BYTES) != hipSuccess || per_cu < 1) { fprintf(stderr, "kernel_launch: occupancy query says %d\n", per_cu); }
        (void)hipGetLastError();
        grid = cus;
    }
    if (grid < 0) return;
    (void)hipMemsetAsync((char*)d_ws + WS_CTL, 0, CTL_ZERO_BYTES, stream);
    Args a{};
    for (int i = 0; i < 24; ++i) a.p.in[i] = (const float*)d_in[i];
    a.p.out = (float*)d_out; a.p.ws = (unsigned char*)d_ws;
    if (MK_N_LAUNCHES == 1) {
        a.ph_lo = 0; a.ph_hi = NPHASE;
        hipLaunchKernelGGL(hybrid_fwd, dim3(grid), dim3(NWAVES * 64), LDS_BYTES, stream, a);
    } else {
        static const int order[NPHASE] = {0, 1, 2, 11, 3, 4, 5, 6, 7, 8, 9, 10};
        for (int q = 0; q < NPHASE; ++q) {
            const int ph = order[q];
            a.ph_lo = ph; a.ph_hi = ph + 1; hipLaunchKernelGGL(hybrid_fwd, dim3(grid), dim3(NWAVES * 64), LDS_BYTES, stream, a);
#if defined(PROBE_PHASE)
            if (ph == PROBE_PHASE) hipLaunchKernelGGL(hybrid_fwd, dim3(grid), dim3(NWAVES * 64), LDS_BYTES, stream, a);
#endif
        }
    }
}
```
